# Optimizing an MI355X kernel written in HIP

```python
import jax, jax.numpy as jnp
from jax import lax
import numpy as np

D_MODEL = 1024
BATCH = 16
SEQ = 4096
DEPTH = 1

HEAD_DIM = 64
ATTN_WIDTH = D_MODEL // 2
POOL_WIDTH = D_MODEL - ATTN_WIDTH
MIX_WIDTH = ATTN_WIDTH + POOL_WIDTH
N_Q_HEADS = ATTN_WIDTH // HEAD_DIM
GQA_GROUP = 4
N_KV_HEADS = N_Q_HEADS // GQA_GROUP
KV_WIDTH = N_KV_HEADS * HEAD_DIM
IN_PROJ_WIDTH = ATTN_WIDTH + 2 * KV_WIDTH + POOL_WIDTH
WINDOW = 128
ATTN_BLOCK = 128
ROPE_THETA = 500000.0
ROPE_DIM = HEAD_DIM // 4
POOL_WINDOWS = (2, 4, 8, 16)
N_POOL_GROUPS = len(POOL_WINDOWS)
POOL_GROUP_WIDTH = POOL_WIDTH // N_POOL_GROUPS
N_EXPERTS = 32
TOP_K = 4
D_FF = D_MODEL
SWIGLU_LIMIT = 7.0
SWIGLU_ALPHA = 1.702
EXPERT_BLOCK = 256
NORM_EPS = 1e-5
QK_NORM_EPS = 1e-6
NEG_INF = -1e30

kernel_name = 'hymba_swa_sink_pool_moe_layer'


def rms_norm(x, w, eps):
    xf = x.astype(jnp.float32)
    y = xf * lax.rsqrt(jnp.mean(xf * xf, axis=-1, keepdims=True) + eps)
    return (y * w.astype(jnp.float32)).astype(x.dtype)


def partial_rope(x, cos, sin):
    half = ROPE_DIM // 2
    r = x[..., :ROPE_DIM].astype(jnp.float32)
    x1, x2 = r[..., :half], r[..., half:]
    rot = jnp.concatenate([x1 * cos - x2 * sin, x2 * cos + x1 * sin], axis=-1).astype(x.dtype)
    return jnp.concatenate([rot, x[..., ROPE_DIM:]], axis=-1)


def sliding_window_attention(q, k, v, sinks):
    B, S, Hkv, G, D = q.shape
    n_blocks = S // ATTN_BLOCK
    pad = ((0, 0), (ATTN_BLOCK, 0), (0, 0), (0, 0))
    kp = jnp.pad(k, pad)
    vp = jnp.pad(v, pad)
    qi = jnp.arange(ATTN_BLOCK)[:, None]
    kj = jnp.arange(2 * ATTN_BLOCK)[None, :]
    band = (kj <= qi + ATTN_BLOCK) & (kj > qi + ATTN_BLOCK - WINDOW)
    sink = sinks.astype(jnp.float32).reshape(1, Hkv, G, 1, 1)
    scale = HEAD_DIM ** -0.5

    def one_block(i):
        start = i * ATTN_BLOCK
        qb = lax.dynamic_slice_in_dim(q, start, ATTN_BLOCK, axis=1)
        kb = lax.dynamic_slice_in_dim(kp, start, 2 * ATTN_BLOCK, axis=1)
        vb = lax.dynamic_slice_in_dim(vp, start, 2 * ATTN_BLOCK, axis=1)
        s = jnp.einsum('bqhgd,bkhd->bhgqk', qb, kb).astype(jnp.float32) * scale
        valid = band & (start - ATTN_BLOCK + kj >= 0)
        s = jnp.where(valid, s, NEG_INF)
        sink_col = jnp.broadcast_to(sink, s.shape[:-1] + (1,))
        probs = jax.nn.softmax(jnp.concatenate([s, sink_col], axis=-1), axis=-1)[..., :-1]
        return jnp.einsum('bhgqk,bkhd->bqhgd', probs.astype(vb.dtype), vb)

    out = lax.map(one_block, jnp.arange(n_blocks))
    out = jnp.moveaxis(out, 0, 1)
    return out.reshape(B, S, Hkv * G * D)


def multiscale_pool(u, pool_w, pool_scale):
    B, S, _ = u.shape
    uf = u.astype(jnp.float32).reshape(B, S, N_POOL_GROUPS, POOL_GROUP_WIDTH)
    csum = jnp.cumsum(uf, axis=1)
    pos1 = jnp.arange(S) + 1
    groups = []
    for g, w in enumerate(POOL_WINDOWS):
        c = csum[:, :, g]
        lagged = jnp.pad(c[:, :S - w], ((0, 0), (w, 0), (0, 0)))
        count = jnp.minimum(pos1, w).astype(jnp.float32)[None, :, None]
        groups.append((c - lagged) / count - uf[:, :, g])
    pooled = jnp.stack(groups, axis=2)
    mixed = jnp.einsum('bsgc,gcd->bsgd', pooled, pool_w.astype(jnp.float32))
    return (mixed.reshape(B, S, POOL_WIDTH) * pool_scale.astype(jnp.float32)).astype(u.dtype)


def moe_ffn(h, w_router, b_router, w_gu, b_gu, w_down, b_down):
    T = h.shape[0]
    n_assign = T * TOP_K
    logits = (h @ w_router).astype(jnp.float32) + b_router.astype(jnp.float32)
    top_v, top_i = lax.top_k(logits, TOP_K)
    gates = jax.nn.softmax(top_v, axis=-1)
    e_flat = top_i.reshape(-1)
    g_flat = gates.reshape(-1)
    tok_flat = jnp.arange(n_assign, dtype=jnp.int32) // TOP_K
    order = jnp.argsort(e_flat)
    e_sorted = e_flat[order]
    counts = jnp.bincount(e_flat, length=N_EXPERTS)
    start = jnp.cumsum(counts) - counts
    padded = ((counts + EXPERT_BLOCK - 1) // EXPERT_BLOCK) * EXPERT_BLOCK
    pend = jnp.cumsum(padded)
    pstart = pend - padded
    slot = pstart[e_sorted] + (jnp.arange(n_assign) - start[e_sorted])
    n_slots = -(-n_assign // EXPERT_BLOCK) * EXPERT_BLOCK + N_EXPERTS * EXPERT_BLOCK
    n_blk = n_slots // EXPERT_BLOCK
    slot_tok = jnp.zeros((n_slots,), jnp.int32).at[slot].set(tok_flat[order])
    slot_gate = jnp.zeros((n_slots,), jnp.float32).at[slot].set(g_flat[order])
    blk_start = jnp.arange(n_blk, dtype=pend.dtype) * EXPERT_BLOCK
    blk_expert = jnp.minimum(jnp.searchsorted(pend, blk_start, side='right'), N_EXPERTS - 1)

    def expert_block(args):
        e, toks, gw = args
        xb = h[toks]
        gu = xb @ w_gu[e] + b_gu[e]
        gate = jnp.minimum(gu[:, :D_FF], SWIGLU_LIMIT)
        up = jnp.clip(gu[:, D_FF:], -SWIGLU_LIMIT, SWIGLU_LIMIT)
        act = gate * jax.nn.sigmoid(gate * SWIGLU_ALPHA) * (up + 1.0)
        y = act @ w_down[e] + b_down[e]
        return (y * gw[:, None]).astype(h.dtype)

    y = lax.map(expert_block, (blk_expert,
                               slot_tok.reshape(n_blk, EXPERT_BLOCK),
                               slot_gate.reshape(n_blk, EXPERT_BLOCK)))
    return jax.ops.segment_sum(y.reshape(n_slots, -1), slot_tok, num_segments=T)


def setup_inputs(seed: int = 0) -> dict:
    key = jax.random.key(seed)
    ks = jax.random.split(key, 18)
    f32 = jnp.float32
    nrm = lambda k, shape, s: jax.random.normal(k, shape, f32) * s
    x = jax.random.normal(ks[0], (BATCH, SEQ, D_MODEL), f32)
    offsets = jax.random.randint(ks[1], (BATCH, 1), 0, SEQ, dtype=jnp.int32)
    positions = offsets + jnp.arange(SEQ, dtype=jnp.int32)[None, :]
    return {
        'x': x,
        'positions': positions,
        'norm1_w': 1.0 + nrm(ks[2], (D_MODEL,), 0.02),
        'w_in': nrm(ks[3], (D_MODEL, IN_PROJ_WIDTH), D_MODEL ** -0.5),
        'q_norm_w': 1.0 + nrm(ks[4], (HEAD_DIM,), 0.02),
        'k_norm_w': 1.0 + nrm(ks[5], (HEAD_DIM,), 0.02),
        'sinks': nrm(ks[6], (N_Q_HEADS,), 0.5),
        'pool_w': nrm(ks[7], (N_POOL_GROUPS, POOL_GROUP_WIDTH, POOL_GROUP_WIDTH), POOL_GROUP_WIDTH ** -0.5),
        'pool_scale': 1.0 + nrm(ks[8], (POOL_WIDTH,), 0.1),
        'w_out': nrm(ks[9], (MIX_WIDTH, D_MODEL), MIX_WIDTH ** -0.5),
        'norm2_w': 1.0 + nrm(ks[10], (D_MODEL,), 0.02),
        'w_router': nrm(ks[11], (D_MODEL, N_EXPERTS), D_MODEL ** -0.5),
        'b_router': nrm(ks[12], (N_EXPERTS,), 0.01),
        'w_gu': nrm(ks[13], (N_EXPERTS, D_MODEL, 2 * D_FF), D_MODEL ** -0.5),
        'b_gu': nrm(ks[14], (N_EXPERTS, 2 * D_FF), 0.02),
        'w_down': nrm(ks[15], (N_EXPERTS, D_FF, D_MODEL), D_FF ** -0.5),
        'b_down': nrm(ks[16], (N_EXPERTS, D_MODEL), 0.02),
    }


def reference(x, positions, norm1_w, w_in, q_norm_w, k_norm_w, sinks, pool_w, pool_scale,
              w_out, norm2_w, w_router, b_router, w_gu, b_gu, w_down, b_down):
    B, S, _ = x.shape
    inv_freq = ROPE_THETA ** (-jnp.arange(0, ROPE_DIM, 2, dtype=jnp.float32) / ROPE_DIM)
    ang = positions.astype(jnp.float32)[..., None] * inv_freq
    cos = jnp.cos(ang)[:, :, None, :]
    sin = jnp.sin(ang)[:, :, None, :]

    h = x
    for _ in range(DEPTH):
        n = rms_norm(h, norm1_w, NORM_EPS)
        proj = n @ w_in
        q = proj[..., :ATTN_WIDTH].reshape(B, S, N_Q_HEADS, HEAD_DIM)
        k = proj[..., ATTN_WIDTH:ATTN_WIDTH + KV_WIDTH].reshape(B, S, N_KV_HEADS, HEAD_DIM)
        v = proj[..., ATTN_WIDTH + KV_WIDTH:ATTN_WIDTH + 2 * KV_WIDTH].reshape(B, S, N_KV_HEADS, HEAD_DIM)
        u = proj[..., ATTN_WIDTH + 2 * KV_WIDTH:]
        q = partial_rope(rms_norm(q, q_norm_w, QK_NORM_EPS), cos, sin)
        k = partial_rope(rms_norm(k, k_norm_w, QK_NORM_EPS), cos, sin)
        q = q.reshape(B, S, N_KV_HEADS, GQA_GROUP, HEAD_DIM)
        attn_out = sliding_window_attention(q, k, v, sinks)
        pool_out = multiscale_pool(u, pool_w, pool_scale)
        mixed = jnp.concatenate([attn_out, pool_out.astype(attn_out.dtype)], axis=-1)
        h = h + mixed @ w_out
        n2 = rms_norm(h, norm2_w, NORM_EPS).reshape(B * S, D_MODEL)
        h = h + moe_ffn(n2, w_router, b_router, w_gu, b_gu, w_down, b_down).reshape(B, S, D_MODEL)
    return h
```

```cpp
#include <hip/hip_runtime.h>
#include <cstdio>
#include <cstdint>
#include <cmath>

#ifndef MK_N_LAUNCHES
#define MK_N_LAUNCHES 11
#endif

#define LAS __attribute__((address_space(3)))
#define GAS __attribute__((address_space(1)))
typedef unsigned short bf16_t;
typedef short bf16x8 __attribute__((ext_vector_type(8)));
typedef short s16x4 __attribute__((ext_vector_type(4)));
typedef float f32x4 __attribute__((ext_vector_type(4)));
typedef float f32x2 __attribute__((ext_vector_type(2)));
typedef float f32x16 __attribute__((ext_vector_type(16)));
typedef unsigned u32x4 __attribute__((ext_vector_type(4)));
typedef unsigned u32x2 __attribute__((ext_vector_type(2)));
typedef GAS unsigned gu32;

constexpr int NB = 16, SEQ = 4096, T = NB * SEQ, D = 1024, NIN = 1280, NE = 32, FF = 1024;
constexpr int THALF = T / 2;
constexpr int LIST_CAP = THALF;
constexpr float NORM_EPS = 1e-5f, QK_EPS = 1e-6f;
constexpr float LOG2E = 1.4426950408889634f;
constexpr float C2 = 0.125f * LOG2E;
constexpr int NWAVES = 8;
constexpr int NPH = 11;
constexpr int N_LAUNCHES = MK_N_LAUNCHES;

constexpr size_t MiB = 1u << 20;
constexpr size_t WS_CTL = 0, CTL_ZERO_BYTES = 1 * MiB;
constexpr size_t WS_WIN = 1 * MiB;
constexpr size_t WS_WOUT = 4 * MiB;
constexpr size_t WS_WR = 6 * MiB;
constexpr size_t WS_ROPE = 7 * MiB;
constexpr size_t WS_RS1 = 11 * MiB;
constexpr size_t WS_RS2 = 11 * MiB + 512 * 1024;
constexpr size_t WS_GATE = 12 * MiB;
constexpr size_t WS_LIST = 13 * MiB;
constexpr size_t WS_WGU = 22 * MiB;
constexpr size_t WS_WDN = 150 * MiB;
constexpr size_t WS_HB = 214 * MiB;
constexpr size_t WS_UB = 342 * MiB;
constexpr size_t WS_MIXED = 406 * MiB;
constexpr size_t WS_ACT = 342 * MiB;
constexpr size_t WS_Y = 614 * MiB;
constexpr size_t WS_END = 870 * MiB;
constexpr int ACT_SLOTS = THALF * 4 + NE * 256;
static_assert(WS_ACT + (size_t)ACT_SLOTS * 1024 * 2 <= WS_Y, "act");
constexpr size_t DO_XB = 0, DO_QB = 128 * MiB, DO_KB = 192 * MiB, DO_VB = 208 * MiB;
constexpr int CW_CNT = 64;
constexpr int CW_BAR = 4096;

constexpr int RING_BYTES = 131072;
constexpr int L_MISC = RING_BYTES;
constexpr int L_CNT = RING_BYTES + 512;
constexpr int L_PREF = RING_BYTES + 640;
constexpr int L_IDX = RING_BYTES + 1024;
constexpr int L_TINFO = RING_BYTES + 4096;
constexpr int L_RSCR = RING_BYTES + 8704;
constexpr int L_RH = RING_BYTES + 25600;
constexpr int L_UTAB = RING_BYTES + 26624;
constexpr int LDS_BYTES = RING_BYTES + 27648;

#define RLX_AGENT __ATOMIC_RELAXED, __HIP_MEMORY_SCOPE_AGENT
#define LDS_WAIT() asm volatile("s_waitcnt lgkmcnt(0)" ::: "memory")
#define VM_WAIT() asm volatile("s_waitcnt vmcnt(0)" ::: "memory")

__device__ __forceinline__ unsigned f2bf(float f) { unsigned u = __builtin_bit_cast(unsigned, f); return (u + 0x7fffu + ((u >> 16) & 1u)) >> 16; }
__device__ __forceinline__ unsigned pk2(float lo, float hi) { return f2bf(lo) | (f2bf(hi) << 16); }
__device__ __forceinline__ unsigned cvt_pk_bf16(float lo, float hi) { unsigned r; asm volatile("v_cvt_pk_bf16_f32 %0, %1, %2" : "=v"(r) : "v"(lo), "v"(hi)); return r; }
__device__ __forceinline__ float bf2f(unsigned short b) { return __builtin_bit_cast(float, (unsigned)b << 16); }

#define XB_TMO      128
#define XB_XCNT(j)  (256  + 64 * (j))
#define XB_XSUB(j)  (1280 + 64 * (j))
#define XB_XGEN(j)  (2304 + 64 * (j))
#define XB_TOP      3328
#define XB_TOPGEN   3392
#define XCD_BAR_WORDS 3456
#define XB_SPIN_CAP (1u << 23)
__device__ __forceinline__ unsigned xb_ld(unsigned* p)              { return __hip_atomic_load(p, __ATOMIC_RELAXED, __HIP_MEMORY_SCOPE_AGENT); }
__device__ __forceinline__ unsigned xb_add(unsigned* p, unsigned v) { return __hip_atomic_fetch_add(p, v, __ATOMIC_RELAXED, __HIP_MEMORY_SCOPE_AGENT); }
__device__ __forceinline__ unsigned xb_xcc_id() { return (unsigned)__builtin_amdgcn_s_getreg((3 << 11) | 20) & 0xFu; }
#define XB_SPIN(cond, bar) do { unsigned _sp = 0; while (cond) { __builtin_amdgcn_s_sleep(1); \
    if ((++_sp & 255u) == 0u) { if (xb_ld(&(bar)[XB_TMO])) break; if (_sp > XB_SPIN_CAP) { atomicAdd(&(bar)[XB_TMO], 1u); break; } } } } while (0)
struct XcdBarrier { unsigned* bar; unsigned x; volatile LAS unsigned* st; };
__device__ __forceinline__ XcdBarrier xcd_barrier_post(unsigned* bar, volatile LAS unsigned* st) {
    XcdBarrier b; b.bar = bar; b.x = xb_xcc_id(); b.st = st;
    if (threadIdx.x == 0) (void)xb_add(&bar[XB_XCNT(b.x)], 1u);
    return b;
}
__device__ __forceinline__ void xcd_barrier_complete(unsigned* bar, unsigned x, unsigned& nloc, unsigned& nx) {
    const unsigned G = gridDim.x * gridDim.y * gridDim.z;
    unsigned sum, cnt, mine, sp = 0u;
    for (;;) {
        sum = 0u; cnt = 0u; mine = 0u;
#pragma unroll
        for (unsigned j = 0; j < 16; ++j) { const unsigned c = xb_ld(&bar[XB_XCNT(j)]); sum += c; cnt += (c > 0u) ? 1u : 0u; mine = (j == x) ? c : mine; }
        if (sum == G) break;
        __builtin_amdgcn_s_sleep(1);
        if ((++sp & 255u) == 0u) { if (xb_ld(&bar[XB_TMO])) break; if (sp > XB_SPIN_CAP) { atomicAdd(&bar[XB_TMO], 1u); break; } }
    }
    nloc = mine > 0u ? mine : 1u; nx = cnt > 0u ? cnt : 1u;
}
__device__ __forceinline__ void xcd_barrier(const XcdBarrier& b) {
    asm volatile("s_waitcnt vmcnt(0)" ::: "memory");
    __syncthreads();
    if (threadIdx.x == 0) {
        unsigned* bar = b.bar;
        __builtin_amdgcn_s_waitcnt(0);
        unsigned nloc = b.st[0], nx = b.st[1];
        if (nloc == 0u) { xcd_barrier_complete(bar, b.x, nloc, nx); b.st[0] = nloc; b.st[1] = nx; }
        const unsigned old = xb_add(&bar[XB_XSUB(b.x)], 1u);
        const unsigned gen = old / nloc;
        if (old + 1u == (gen + 1u) * nloc) {
            __builtin_amdgcn_fence(__ATOMIC_RELEASE, "agent");
            asm volatile("s_waitcnt vmcnt(0)" ::: "memory");
            const unsigned og = xb_add(&bar[XB_TOP], 1u);
            const unsigned tg = og / nx;
            if (og + 1u == (tg + 1u) * nx) xb_add(&bar[XB_TOPGEN], 1u);
            else XB_SPIN(xb_ld(&bar[XB_TOPGEN]) == tg, bar);
            __builtin_amdgcn_fence(__ATOMIC_ACQUIRE, "agent");
            xb_add(&bar[XB_XGEN(b.x)], 1u);
            asm volatile("s_waitcnt vmcnt(0)" ::: "memory");
        } else {
            XB_SPIN(xb_ld(&bar[XB_XGEN(b.x)]) == gen, bar);
            __builtin_amdgcn_fence(__ATOMIC_ACQUIRE, "agent");
            asm volatile("s_waitcnt vmcnt(0)" ::: "memory");
        }
    }
    __syncthreads();
}

namespace pg8 {
constexpr int BM = 256, BK = 64, HALF = 128, HTB = HALF * BK * 2, NXCD = 8, WGM = 8;
__host__ __device__ __forceinline__ int lds_byte(int r, int c) { const int st = (r >> 4) * 2 + (c >> 5), rr = r & 15, cc = c & 31, ob = rr * 64 + cc * 2; return st * 1024 + (ob ^ (((ob >> 9) & 1) << 5)); }
__host__ __device__ __forceinline__ void stage_rc(int b, int& R, int& C) { const int st = b / 1024, sb = b % 1024, swz = sb ^ (((sb >> 9) & 1) << 5); R = (st >> 1) * 16 + swz / 64; C = (st & 1) * 32 + (swz % 64) / 2; }
__host__ __device__ __forceinline__ int perm32(int rho) { const int n = rho >> 4, i = rho & 15; return 8 * (i >> 2) + 4 * n + (i & 3); }

struct Unit { int pm, pn, bt, e, j, nvalid; };

__device__ __forceinline__ bool order_tile(int i, int nM, int nN, int G, int c, int& pm, int& pn) {
    const int nwg = nM * nN; const long L = (long)i * G + c; if (L >= nwg) return false;
    int wgid = (int)L; { const int q = nwg / NXCD, r = nwg % NXCD, xcd = wgid % NXCD, off = wgid / NXCD; wgid = (xcd < r ? xcd * (q + 1) : r * (q + 1) + (xcd - r) * q) + off; }
    const int nig = WGM * nN, gid = wgid / nig, fm = gid * WGM, gsz = (nM - fm) < WGM ? (nM - fm) : WGM;
    pm = fm + ((wgid % nig) % gsz); pn = (wgid % nig) / gsz; return true;
}
constexpr int MAX_UNITS = 64;
__device__ __forceinline__ int build_units(LAS int* tab, int nM, int nN, int G, int c, const LAS int* tinfo, const LAS int* cnt) {
    const int nwg = nM * nN; const int nU = (nwg > c) ? (nwg - c + G - 1) / G : 0;
    __syncthreads();
    const int i = threadIdx.x;
    if (i < nU && i < MAX_UNITS) { int pm = 0, pn = 0; order_tile(i, nM, nN, G, c, pm, pn);
        int e = 0, j = 0, nv = 256;
        if (tinfo) { const int ti = tinfo[pm]; e = ti & 255; j = ti >> 8; const int c_ = cnt[e] - 256 * j; nv = c_ < 256 ? c_ : 256; }
        tab[4 * i] = pm; tab[4 * i + 1] = pn; tab[4 * i + 2] = e * nN + pn; tab[4 * i + 3] = e | (j << 8) | (nv << 20); }
    __syncthreads();
    return nU < MAX_UNITS ? nU : MAX_UNITS;
}
struct TabOrder {
    const LAS int* tab; int nU; const int* list;
    __device__ __forceinline__ bool next(int i, Unit& u) const {
        if (i >= nU) return false;
        const int w3 = __builtin_amdgcn_readfirstlane(tab[4 * i + 3]);
        u.pm = __builtin_amdgcn_readfirstlane(tab[4 * i]); u.pn = __builtin_amdgcn_readfirstlane(tab[4 * i + 1]); u.bt = __builtin_amdgcn_readfirstlane(tab[4 * i + 2]);
        u.e = w3 & 255; u.j = (w3 >> 8) & 4095; u.nvalid = w3 >> 20; return true;
    }
    __device__ __forceinline__ const int* idx_src(const Unit& u) const { return list + (size_t)u.e * LIST_CAP + 256 * u.j; }
};

template <class Epi, class Sched, int AMODE, bool HAS_IDX, bool ALIGN_EPI = true>
__device__ __forceinline__ void gemm_phase(LAS unsigned char* lds, LAS int* idxring, const bf16_t* Ag, const bf16_t* Btg, const Sched& S, const Epi& E) {
    constexpr int K = 1024;
    const int tid = threadIdx.x, wid = __builtin_amdgcn_readfirstlane(tid >> 6), lane = tid & 63, wr = wid >> 2, wc = wid & 3, fr = lane & 15, fq = lane >> 4;
    const int nt = K / BK;
    unsigned voffB[2];
#pragma unroll
    for (int i = 0; i < 2; ++i) { int R, C; stage_rc(tid * 16 + i * 8192, R, C); const int Rb = Epi::PERM ? ((R & ~31) + perm32(R & 31)) : R; voffB[i] = (unsigned)(Rb * K + C) * 2u; }
    const size_t kstep = (size_t)(BK * 2);
    const size_t hstep = (size_t)HALF * K * 2;
    const size_t tstep = 2 * hstep;
    const unsigned ldsw = (unsigned)wid * 1024u;
    const int aoff = lds_byte(wr * 64 + fr, fq * 8), boff = lds_byte(wc * 32 + fr, fq * 8);
#define PG8_SA(b, h) (((b) * 2 + (h)) * HTB)
#define PG8_SB(b, h) ((4 + (b) * 2 + (h)) * HTB)
#define PG8_STAGE_B(bufoff, gbase) do { _Pragma("unroll") for (int _i = 0; _i < 2; ++_i) \
        __builtin_amdgcn_global_load_lds((const unsigned*)((const char*)(gbase) + voffB[_i]), (LAS unsigned*)(lds + (bufoff) + ldsw + _i * 8192), 16, 0, 0); } while (0)
#define PG8_STAGE_A(bufoff, kb, AO, h) do { _Pragma("unroll") for (int _i = 0; _i < 2; ++_i) \
        __builtin_amdgcn_global_load_lds((const unsigned*)((const char*)Ag + (kb) + (AO)[h][_i]), (LAS unsigned*)(lds + (bufoff) + ldsw + _i * 8192), 16, 0, 0); } while (0)
#define PG8_LDA(dst, b, h) do { _Pragma("unroll") for (int m = 0; m < 4; ++m) _Pragma("unroll") for (int k = 0; k < 2; ++k) dst[m][k] = *(const LAS bf16x8*)(lds + PG8_SA(b, h) + aoff + m * 2048 + k * 1024); } while (0)
#define PG8_LDB(dst, b, h) do { _Pragma("unroll") for (int n = 0; n < 2; ++n) _Pragma("unroll") for (int k = 0; k < 2; ++k) dst[n][k] = *(const LAS bf16x8*)(lds + PG8_SB(b, h) + boff + n * 2048 + k * 1024); } while (0)
#define PG8_MMA(ai, bj, At, Bt) do { __builtin_amdgcn_s_setprio(1); _Pragma("unroll") for (int m = 0; m < 4; ++m) _Pragma("unroll") for (int n = 0; n < 2; ++n) _Pragma("unroll") for (int k = 0; k < 2; ++k) \
        acc[ai][bj][m][n] = __builtin_amdgcn_mfma_f32_16x16x32_bf16(Bt[n][k], At[m][k], acc[ai][bj][m][n], 0, 0, 0); __builtin_amdgcn_s_setprio(0); } while (0)
#define PG8_WAIT_V(n) asm volatile("s_waitcnt vmcnt(" #n ")" ::: "memory")
#define PG8_WAIT_L(n) asm volatile("s_waitcnt lgkmcnt(" #n ")" ::: "memory")
#define PG8_BAR __builtin_amdgcn_s_barrier()
#define PG8_SCHED __builtin_amdgcn_sched_barrier(0)
#define PG8_AOFF(dst, U, islot) do { int _t = tid; asm volatile("" : "+v"(_t)); _Pragma("unroll") for (int _i = 0; _i < 2; ++_i) { int _R, _C; stage_rc(_t * 16 + _i * 8192, _R, _C); \
        _Pragma("unroll") for (int _h = 0; _h < 2; ++_h) { \
        int _row; if (AMODE == 0) _row = (U).pm * BM + _h * HALF + _R; else _row = idxring[(islot) * 256 + _h * HALF + _R] >> 2; \
        dst[_h][_i] = ((unsigned)_row * (unsigned)K + (unsigned)_C) * 2u; } } } while (0)
    Unit cur, nxt; int ui = 0, islot = 0;
    if (!S.next(0, cur)) return;
    if (HAS_IDX) {
        if (wid == 0) { __builtin_amdgcn_global_load_lds((const unsigned*)(S.idx_src(cur) + lane * 4), (LAS unsigned*)(idxring), 16, 0, 0); PG8_WAIT_V(0); }
        __syncthreads();
    }
    f32x4 acc[2][2][4][2];
#pragma unroll
    for (int a = 0; a < 2; ++a)
#pragma unroll
        for (int b = 0; b < 2; ++b)
#pragma unroll
            for (int m = 0; m < 4; ++m)
#pragma unroll
                for (int n = 0; n < 2; ++n) acc[a][b][m][n] = (f32x4){0.f, 0.f, 0.f, 0.f};
    bf16x8 At[4][2], B0[2][2], B1[2][2];
    unsigned ao[2][2];
    PG8_AOFF(ao, cur, 0);
    const char* cB = (const char*)Btg + (size_t)cur.bt * tstep;
    PG8_STAGE_B(PG8_SB(0, 0), cB); PG8_STAGE_B(PG8_SB(0, 1), cB + hstep); PG8_STAGE_A(PG8_SA(0, 0), 0, ao, 0); PG8_STAGE_A(PG8_SA(0, 1), 0, ao, 1);
    if (wr == 1) PG8_BAR;
    PG8_WAIT_V(2); PG8_BAR;
    PG8_STAGE_B(PG8_SB(1, 0), cB + kstep); PG8_STAGE_A(PG8_SA(1, 0), kstep, ao, 0); PG8_STAGE_B(PG8_SB(1, 1), cB + hstep + kstep);
    PG8_WAIT_V(6); PG8_BAR;
    for (;;) {
        const bool has_next = S.next(ui + 1, nxt);
        const int nslot = (islot == 2) ? 0 : islot + 1;
        if (HAS_IDX && has_next && wid == 0)
            __builtin_amdgcn_global_load_lds((const unsigned*)(S.idx_src(nxt) + lane * 4), (LAS unsigned*)(idxring + nslot * 256), 16, 0, 0);
        const char* nB = has_next ? (const char*)Btg + (size_t)nxt.bt * tstep : cB;
        for (int t = 0; t < nt; t += 2) {
            const bool last = (t == nt - 2);
            const size_t k1 = (size_t)(t + 1) * kstep;
            const size_t k2 = last ? 0 : (size_t)(t + 2) * kstep, k3 = k2 + kstep;
            const char* b2 = last ? nB : cB + (size_t)(t + 2) * kstep; const char* b3 = b2 + kstep;
            PG8_LDB(B0, 0, 0); PG8_LDB(B1, 0, 1); PG8_SCHED; PG8_LDA(At, 0, 0); PG8_STAGE_A(PG8_SA(1, 1), k1, ao, 1);
            if (last && has_next) { PG8_AOFF(ao, nxt, nslot); }
            PG8_WAIT_V(8); PG8_WAIT_L(0); PG8_BAR; PG8_MMA(0, 0, At, B0); PG8_MMA(0, 1, At, B1); PG8_BAR; PG8_SCHED;
            PG8_LDA(At, 0, 1); PG8_STAGE_B(PG8_SB(0, 0), b2); PG8_STAGE_B(PG8_SB(0, 1), b2 + hstep); PG8_STAGE_A(PG8_SA(0, 0), k2, ao, 0);
            PG8_WAIT_V(8); PG8_WAIT_L(0); PG8_BAR; PG8_MMA(1, 0, At, B0); PG8_MMA(1, 1, At, B1); PG8_BAR; PG8_SCHED;
            PG8_LDB(B0, 1, 0); PG8_LDB(B1, 1, 1); PG8_SCHED; PG8_LDA(At, 1, 0); PG8_STAGE_A(PG8_SA(0, 1), k2, ao, 1);
            PG8_WAIT_V(8); PG8_WAIT_L(0); PG8_BAR; PG8_MMA(0, 0, At, B0); PG8_MMA(0, 1, At, B1); PG8_BAR; PG8_SCHED;
            PG8_LDA(At, 1, 1); PG8_STAGE_B(PG8_SB(1, 0), b3); PG8_STAGE_B(PG8_SB(1, 1), b3 + hstep); PG8_STAGE_A(PG8_SA(1, 0), k3, ao, 0);
            PG8_WAIT_V(8); PG8_WAIT_L(0); PG8_BAR; PG8_MMA(1, 0, At, B0); PG8_MMA(1, 1, At, B1); PG8_BAR; PG8_SCHED;
        }
        if (ALIGN_EPI) { if (wr == 0) PG8_BAR; }
        E(acc, cur, wr, wc, fr, fq, (const LAS int*)(idxring + islot * 256));
        if (!has_next) break;
#pragma unroll
        for (int a = 0; a < 2; ++a)
#pragma unroll
            for (int b = 0; b < 2; ++b)
#pragma unroll
                for (int m = 0; m < 4; ++m)
#pragma unroll
                    for (int n = 0; n < 2; ++n) acc[a][b][m][n] = (f32x4){0.f, 0.f, 0.f, 0.f};
        cur = nxt; cB = nB; ++ui; islot = nslot;
        if (ALIGN_EPI) { if (wr == 1) PG8_BAR; }
    }
    PG8_WAIT_V(0);
    if (!ALIGN_EPI) { if (wr == 0) PG8_BAR; }
    PG8_BAR;
#undef PG8_SA
#undef PG8_SB
#undef PG8_STAGE_A
#undef PG8_STAGE_B
#undef PG8_LDA
#undef PG8_LDB
#undef PG8_MMA
#undef PG8_WAIT_V
#undef PG8_WAIT_L
#undef PG8_BAR
#undef PG8_SCHED
#undef PG8_AOFF
}

__device__ __forceinline__ u32x4 pack8(const f32x4 a, const f32x4 b) { u32x4 w; w.x = cvt_pk_bf16(a[0], a[1]); w.y = cvt_pk_bf16(a[2], a[3]); w.z = cvt_pk_bf16(b[0], b[1]); w.w = cvt_pk_bf16(b[2], b[3]); return w; }

struct EpiInProj {
    static constexpr bool PERM = true;
    bf16_t *Q, *Kb, *Vb, *U; const float *rs1, *rope, *qw, *kw;
    __device__ __forceinline__ void operator()(const f32x4 (&acc)[2][2][4][2], const Unit& u, int wr, int wc, int fr, int fq, const LAS int*) const {
        const int row0 = u.pm * BM + wr * 64 + fr;
        if (u.pn >= 3) {
#pragma unroll
            for (int ai = 0; ai < 2; ++ai)
#pragma unroll
                for (int m = 0; m < 4; ++m) { const int row = row0 + ai * HALF + m * 16; const float s = rs1[row];
                    bf16_t* rp = U + (size_t)row * 512 + (u.pn - 3) * 256 + wc * 32 + 8 * fq;
#pragma unroll
                    for (int bj = 0; bj < 2; ++bj) *(u32x4*)(rp + bj * HALF) = pack8(acc[ai][bj][m][0] * s, acc[ai][bj][m][1] * s); }
            return;
        }
        const bool isv = (u.pn == 2 && wc >= 2);
        bf16_t* dst; int ld; const float* w; float post;
        if (u.pn < 2) { dst = Q + (4 * u.pn + wc) * 64; ld = 512; w = qw; post = C2; }
        else if (wc < 2) { dst = Kb + wc * 64; ld = 128; w = kw; post = 1.f; }
        else { dst = Vb + (wc - 2) * 64; ld = 128; w = qw; post = 1.f; }
        f32x4 wv[2][2];
#pragma unroll
        for (int bj = 0; bj < 2; ++bj)
#pragma unroll
            for (int n = 0; n < 2; ++n) wv[bj][n] = *(const f32x4*)(w + 32 * bj + 8 * fq + 4 * n);
#pragma unroll
        for (int ai = 0; ai < 2; ++ai)
#pragma unroll
            for (int m = 0; m < 4; ++m) {
                const int row = row0 + ai * HALF + m * 16; const float s = rs1[row];
                f32x4 x[2][2];
#pragma unroll
                for (int bj = 0; bj < 2; ++bj)
#pragma unroll
                    for (int n = 0; n < 2; ++n) x[bj][n] = acc[ai][bj][m][n] * s;
                if (!isv) {
                    float ss = 0.f;
#pragma unroll
                    for (int bj = 0; bj < 2; ++bj)
#pragma unroll
                        for (int n = 0; n < 2; ++n) ss += (x[bj][n][0] * x[bj][n][0] + x[bj][n][1] * x[bj][n][1]) + (x[bj][n][2] * x[bj][n][2] + x[bj][n][3] * x[bj][n][3]);
                    ss += __shfl_xor(ss, 16); ss += __shfl_xor(ss, 32);
                    const float rn = 1.0f / sqrtf(ss * (1.0f / 64.0f) + QK_EPS);
#pragma unroll
                    for (int bj = 0; bj < 2; ++bj)
#pragma unroll
                        for (int n = 0; n < 2; ++n) x[bj][n] = x[bj][n] * rn * wv[bj][n];
                    const float* rp = rope + (size_t)row * 16;
#pragma unroll
                    for (int n = 0; n < 2; ++n) {
                        const f32x4 cs = *(const f32x4*)(rp + 4 * n), sn = *(const f32x4*)(rp + 8 + 4 * n);
                        f32x4 pr;
#pragma unroll
                        for (int c = 0; c < 4; ++c) pr[c] = __shfl_xor(x[0][n][c], 16);
                        const f32x4 r0 = x[0][n] * cs - pr * sn, r1 = x[0][n] * cs + pr * sn;
                        if (fq == 0) x[0][n] = r0; else if (fq == 1) x[0][n] = r1;
                    }
#pragma unroll
                    for (int bj = 0; bj < 2; ++bj)
#pragma unroll
                        for (int n = 0; n < 2; ++n) x[bj][n] = x[bj][n] * post;
                }
                bf16_t* op = dst + (size_t)row * ld + 8 * fq;
#pragma unroll
                for (int bj = 0; bj < 2; ++bj) *(u32x4*)(op + 32 * bj) = pack8(x[bj][0], x[bj][1]);
            }
    }
};
struct EpiOutProj {
    static constexpr bool PERM = true;
    const float* x; float* out; bf16_t* hb;
    __device__ __forceinline__ void operator()(const f32x4 (&acc)[2][2][4][2], const Unit& u, int wr, int wc, int fr, int fq, const LAS int*) const {
        const int row0 = u.pm * BM + wr * 64 + fr, col0 = u.pn * BM + wc * 32 + 8 * fq;
#pragma unroll
        for (int ai = 0; ai < 2; ++ai)
#pragma unroll
            for (int m = 0; m < 4; ++m) { const size_t off = (size_t)(row0 + ai * HALF + m * 16) * D + col0;
#pragma unroll
                for (int bj = 0; bj < 2; ++bj) { const f32x4 h0 = *(const f32x4*)(x + off + bj * HALF) + acc[ai][bj][m][0], h1 = *(const f32x4*)(x + off + bj * HALF + 4) + acc[ai][bj][m][1];
                    *(f32x4*)(out + off + bj * HALF) = h0; *(f32x4*)(out + off + bj * HALF + 4) = h1; *(u32x4*)(hb + off + bj * HALF) = pack8(h0, h1); } }
    }
};
struct EpiGU {
    static constexpr bool PERM = true;
    bf16_t* act; const float* rs2; const float* bgu;
    __device__ __forceinline__ void operator()(const f32x4 (&acc)[2][2][4][2], const Unit& u, int wr, int wc, int fr, int fq, const LAS int* idx) const {
        const int r0 = wr * 64 + fr, c0 = u.pn * 128 + wc * 32 + 8 * fq;
        const float* bp = bgu + (size_t)u.e * 2048 + c0;
        const f32x4 bg0 = *(const f32x4*)(bp), bg1 = *(const f32x4*)(bp + 4), bu0 = *(const f32x4*)(bp + 1024), bu1 = *(const f32x4*)(bp + 1028);
#pragma unroll
        for (int ai = 0; ai < 2; ++ai)
#pragma unroll
            for (int m = 0; m < 4; ++m) { const int r = r0 + ai * HALF + m * 16; const float s = rs2[idx[r] >> 2];
                f32x4 a[2];
#pragma unroll
                for (int n = 0; n < 2; ++n) { const f32x4 g = acc[ai][0][m][n] * s + (n ? bg1 : bg0), uu = acc[ai][1][m][n] * s + (n ? bu1 : bu0);
#pragma unroll
                    for (int c = 0; c < 4; ++c) { const float gc = fminf(g[c], 7.0f), uc = fminf(fmaxf(uu[c], -7.0f), 7.0f);
                        const float sg = __builtin_amdgcn_rcpf(1.0f + __builtin_amdgcn_exp2f(gc * (-1.702f * LOG2E))); a[n][c] = gc * sg * (uc + 1.0f); } }
                *(u32x4*)(act + (size_t)(u.pm * BM + r) * FF + c0) = pack8(a[0], a[1]); }
    }
};
struct EpiDown {
    static constexpr bool PERM = true;
    bf16_t* y; const float* gate; const float* bdn; int aid0;
    __device__ __forceinline__ void operator()(const f32x4 (&acc)[2][2][4][2], const Unit& u, int wr, int wc, int fr, int fq, const LAS int* idx) const {
        const int r0 = wr * 64 + fr, c0 = u.pn * BM + wc * 32 + 8 * fq;
        const float* bp = bdn + (size_t)u.e * D + c0;
        f32x4 bv[2][2];
#pragma unroll
        for (int bj = 0; bj < 2; ++bj)
#pragma unroll
            for (int n = 0; n < 2; ++n) bv[bj][n] = *(const f32x4*)(bp + bj * HALF + 4 * n);
#pragma unroll
        for (int ai = 0; ai < 2; ++ai)
#pragma unroll
            for (int m = 0; m < 4; ++m) { const int r = r0 + ai * HALF + m * 16;
                if (r < u.nvalid) { const int aid = idx[r]; const float g = gate[aid]; bf16_t* yp = y + (size_t)(aid - aid0) * D + c0;
#pragma unroll
                    for (int bj = 0; bj < 2; ++bj) *(u32x4*)(yp + bj * HALF) = pack8((acc[ai][bj][m][0] + bv[bj][0]) * g, (acc[ai][bj][m][1] + bv[bj][1]) * g); } }
    }
};
}

struct Frame {
    LAS unsigned char* lds;
    int tid, lane, wave, G, gw, NGW;
};

__device__ __forceinline__ float wave_sum(float v) {
#pragma unroll
    for (int o = 1; o < 64; o <<= 1) v += __shfl_xor(v, o);
    return v;
}

__device__ __forceinline__ void p0_transpose_item(const float* W, int ldw, int scol0, int k0, const float* ks, bf16_t* WT, int K, int drow0, LAS float* scr, int lane) {
#pragma unroll 8
    for (int i = 0; i < 32; ++i) { const int kk = 2 * i + (lane >> 5); float v = W[(size_t)(k0 + kk) * ldw + scol0 + (lane & 31)]; if (ks) v *= ks[k0 + kk]; scr[kk * 33 + (lane & 31)] = v; }
    LDS_WAIT(); asm volatile("" ::: "memory");
    const int c = lane & 7;
#pragma unroll
    for (int j = 0; j < 4; ++j) { const int n = (lane >> 3) + 8 * j; const LAS float* s = scr + (8 * c) * 33 + n;
        u32x4 o; o.x = pk2(s[0 * 33], s[1 * 33]); o.y = pk2(s[2 * 33], s[3 * 33]); o.z = pk2(s[4 * 33], s[5 * 33]); o.w = pk2(s[6 * 33], s[7 * 33]);
        *(GAS u32x4*)(WT + (size_t)(drow0 + n) * K + k0 + 8 * c) = o; }
    LDS_WAIT(); asm volatile("" ::: "memory");
}
__device__ __forceinline__ int win_src(int rho0) {
    const int pn = rho0 >> 8, within = rho0 & 255, bj = within >> 7, wc = (within & 127) >> 5;
    if (pn < 2) return 64 * (4 * pn + wc) + 32 * bj;
    if (pn == 2) return 512 + 64 * wc + 32 * bj;
    return rho0;
}

struct Args { const void* in[17]; float* out; unsigned char* ws; int ph_lo, ph_hi; float invf[8]; };

__device__ __forceinline__ int crow(int r, int hi) { return (r & 3) + 8 * (r >> 2) + 4 * hi; }
typedef short v4i16_t __attribute__((ext_vector_type(4)));
__device__ __forceinline__ s16x4 vtr(const LAS unsigned char* p) { return __builtin_bit_cast(s16x4, __builtin_amdgcn_ds_read_tr16_b64_v4i16((LAS v4i16_t*)p)); }

__device__ __forceinline__ void attn_unit(const Frame& F, int b, int kvh, int qblk, const bf16_t* Q, const bf16_t* Kb, const bf16_t* Vb, bf16_t* O, const float* sinks) {
    const int lane = F.lane, wid = F.wave, r32 = lane & 31, hi = lane >> 5;
    LAS unsigned char* lds = F.lds;
    const int s0 = qblk * 128; const long rowq0 = (long)b * SEQ + s0;
    {
        u32x4 kv[4], vv[4];
#pragma unroll
        for (int jt = 0; jt < 4; ++jt) {
            long rt = (long)b * SEQ + s0 - 128 + 64 * jt; if (qblk == 0 && jt < 2) rt = (long)b * SEQ;
            kv[jt] = *(const u32x4*)(Kb + (rt + lane) * 128 + kvh * 64 + wid * 8);
            vv[jt] = *(const u32x4*)(Vb + (rt + 16 * (wid & 3) + (lane >> 2)) * 128 + kvh * 64 + (wid >> 2) * 32 + (lane & 3) * 8);
        }
#pragma unroll
        for (int jt = 0; jt < 4; ++jt) { *(LAS u32x4*)(lds + jt * 8192 + wid * 1024 + lane * 16) = kv[jt]; *(LAS u32x4*)(lds + 32768 + jt * 8192 + wid * 1024 + lane * 16) = vv[jt]; }
    }
    __syncthreads();
    const int g = wid >> 1, rh = wid & 1, head = kvh * 4 + g, t0 = rh;
    const float sinkl = sinks[head] * LOG2E;
    LAS bf16_t* stg = (LAS bf16_t*)(lds + 65536) + wid * 2048;
    const int vboff = ((lane >> 4) & 1) * 32 + (lane & 3) * 8 + (4 * hi + ((lane & 15) >> 2)) * 64;
#pragma unroll 1
    for (int s = 0; s < 2; ++s) {
        const int q0 = 64 * rh + 32 * s;
        const bf16_t* Qw = Q + (size_t)(rowq0 + q0 + r32) * 512 + head * 64 + hi * 8;
        bf16x8 qr[4];
#pragma unroll
        for (int d0 = 0; d0 < 4; ++d0) qr[d0] = *(const bf16x8*)(Qw + d0 * 16);
        const int qi = q0 + r32; const int klo = (qblk == 0) ? (qi > 127 ? qi : 127) : qi;
        float mrun = sinkl, l = 1.0f;
        f32x16 o[2]; o[0] = f32x16{}; o[1] = f32x16{};
#pragma unroll 1
        for (int jt = 0; jt < 3; ++jt) {
            const LAS unsigned char* kb = lds + (t0 + jt) * 8192 + hi * 1024 + r32 * 16;
            f32x16 p0 = {}, p1 = {};
#pragma unroll
            for (int d0 = 0; d0 < 4; ++d0) {
                const bf16x8 k0 = *(const LAS bf16x8*)(kb + d0 * 2048), k1 = *(const LAS bf16x8*)(kb + d0 * 2048 + 512);
                p0 = __builtin_amdgcn_mfma_f32_32x32x16_bf16(k0, qr[d0], p0, 0, 0, 0);
                p1 = __builtin_amdgcn_mfma_f32_32x32x16_bf16(k1, qr[d0], p1, 0, 0, 0);
            }
            float mx = mrun; const int kbase = 64 * (t0 + jt);
#pragma unroll
            for (int r = 0; r < 16; ++r) { const int kj = kbase + crow(r, hi);
                const bool ok0 = (kj > klo) && (kj <= qi + 128), ok1 = (kj + 32 > klo) && (kj + 32 <= qi + 128);
                p0[r] = ok0 ? p0[r] : -INFINITY; p1[r] = ok1 ? p1[r] : -INFINITY; mx = fmaxf(mx, fmaxf(p0[r], p1[r])); }
            mx = fmaxf(mx, __shfl_xor(mx, 32));
            const float alpha = __builtin_amdgcn_exp2f(mrun - mx); mrun = mx;
            float ls = 0.f;
#pragma unroll
            for (int r = 0; r < 16; ++r) { p0[r] = __builtin_amdgcn_exp2f(p0[r] - mx); p1[r] = __builtin_amdgcn_exp2f(p1[r] - mx); ls += p0[r] + p1[r]; }
            ls += __shfl_xor(ls, 32);
            l = l * alpha + ls;
#pragma unroll
            for (int d0 = 0; d0 < 2; ++d0)
#pragma unroll
                for (int r = 0; r < 16; ++r) o[d0][r] *= alpha;
            const LAS unsigned char* vp = lds + 32768 + (t0 + jt) * 8192 + vboff;
#pragma unroll
            for (int ks = 0; ks < 4; ++ks) {
                const f32x16& P = (ks < 2) ? p0 : p1; const int rb = (ks & 1) * 8;
                u32x4 pw; pw.x = cvt_pk_bf16(P[rb + 0], P[rb + 1]); pw.y = cvt_pk_bf16(P[rb + 2], P[rb + 3]); pw.z = cvt_pk_bf16(P[rb + 4], P[rb + 5]); pw.w = cvt_pk_bf16(P[rb + 6], P[rb + 7]);
                const bf16x8 pb = __builtin_bit_cast(bf16x8, pw);
#pragma unroll
                for (int d0 = 0; d0 < 2; ++d0) {
                    const s16x4 lo = vtr(vp + d0 * 4096 + ks * 1024), hv = vtr(vp + d0 * 4096 + ks * 1024 + 512);
                    const bf16x8 vf = (bf16x8){lo[0], lo[1], lo[2], lo[3], hv[0], hv[1], hv[2], hv[3]};
                    o[d0] = __builtin_amdgcn_mfma_f32_32x32x16_bf16(vf, pb, o[d0], 0, 0, 0);
                }
            }
        }
        const float rl = 1.0f / l;
#pragma unroll
        for (int d0 = 0; d0 < 2; ++d0)
#pragma unroll
            for (int g4 = 0; g4 < 4; ++g4) { u32x2 w; w.x = cvt_pk_bf16(o[d0][4 * g4] * rl, o[d0][4 * g4 + 1] * rl); w.y = cvt_pk_bf16(o[d0][4 * g4 + 2] * rl, o[d0][4 * g4 + 3] * rl);
                *(LAS u32x2*)(stg + r32 * 64 + 32 * d0 + 8 * g4 + 4 * hi) = w; }
        LDS_WAIT();
        bf16_t* Ow = O + (size_t)(rowq0 + q0) * D + head * 64;
#pragma unroll
        for (int i = 0; i < 4; ++i) { const int row = i * 8 + (lane >> 3), ch = lane & 7; const u32x4 v = *(const LAS u32x4*)(stg + row * 64 + ch * 8); *(u32x4*)(Ow + (size_t)row * D + ch * 8) = v; }
        LDS_WAIT();
    }
    __syncthreads();
}

__global__ void __launch_bounds__(NWAVES * 64, 2) hymba_fwd(Args args) {
    extern __shared__ __attribute__((aligned(16))) unsigned char lds_raw[];
    Frame F;
    F.lds = (LAS unsigned char*)lds_raw;
    F.tid = threadIdx.x; F.lane = F.tid & 63; F.wave = __builtin_amdgcn_readfirstlane(F.tid >> 6);
    F.G = gridDim.x; F.gw = blockIdx.x * NWAVES + F.wave; F.NGW = F.G * NWAVES;
    volatile LAS unsigned* MISC = (volatile LAS unsigned*)(F.lds + L_MISC);
#define AS4 __attribute__((address_space(4)))
    const AS4 char* kbase = (const AS4 char*)__builtin_amdgcn_kernarg_segment_ptr();
#define KP_FRESH() const AS4 char* kp = kbase; asm volatile("" : "+s"(kp))
#define KIN(T, i) ((T)(*(const void* const AS4*)(kp + 8 * (i))))
#define KOUT() (*(float* const AS4*)(kp + 136))
#define KWS() (*(unsigned char* const AS4*)(kp + 144))
    gu32* ctl;
    { KP_FRESH(); ctl = (gu32*)(KWS() + WS_CTL); }
    for (int u = F.tid; u < 512 / 4; u += NWAVES * 64) ((LAS unsigned*)(F.lds + L_MISC))[u] = 0u;
    __syncthreads();
    XcdBarrier bar; bar.bar = (unsigned*)(ctl + CW_BAR); bar.x = 0; bar.st = nullptr;
    if (N_LAUNCHES == 1) bar = xcd_barrier_post((unsigned*)(ctl + CW_BAR), MISC + 8);
    int lo, hi; { KP_FRESH(); lo = *(const int AS4*)(kp + 152); hi = *(const int AS4*)(kp + 156); }
#define IN(k) (lo <= (k) && (k) < hi)
#define SEAM(k) do { if (IN(k) && IN((k) + 1)) xcd_barrier(bar); } while (0)
    LAS int* idxring = (LAS int*)(F.lds + L_IDX);
    LAS int* utab = (LAS int*)(F.lds + L_UTAB);

    if (IN(0)) {
        KP_FRESH(); unsigned char* ws = KWS(); float* out = KOUT();
        const float* x = KIN(const float*, 0); const int* positions = KIN(const int*, 1); const float* norm1_w = KIN(const float*, 2); const float* w_in = KIN(const float*, 3);
        const float* pool_w = KIN(const float*, 7); const float* pool_scale = KIN(const float*, 8); const float* w_out = KIN(const float*, 9); const float* norm2_w = KIN(const float*, 10);
        const float* w_router = KIN(const float*, 11); const float* w_gu = KIN(const float*, 13); const float* w_down = KIN(const float*, 15);
        bf16_t* WIN = (bf16_t*)(ws + WS_WIN); bf16_t* WOUT = (bf16_t*)(ws + WS_WOUT); float* WR = (float*)(ws + WS_WR); float* ROPE = (float*)(ws + WS_ROPE);
        float* RS1 = (float*)(ws + WS_RS1); int* LIST = (int*)(ws + WS_LIST); bf16_t* WGU = (bf16_t*)(ws + WS_WGU); bf16_t* WDN = (bf16_t*)(ws + WS_WDN);
        bf16_t* XB = (bf16_t*)((unsigned char*)out + DO_XB);
        LAS float* scr = (LAS float*)(F.lds + F.wave * 16384);
        constexpr int I_IN = 16 * 40, I_OUT = 8 * 32, I_GU = 32 * 16 * 64, I_DN = 32 * 16 * 32, NITEMS = I_IN + I_OUT + I_GU + I_DN;
        for (int it = F.gw; it < NITEMS; it += F.NGW) {
            int r = it;
            if (r < I_IN) { const int kb = r / 40, nb = r % 40; p0_transpose_item(w_in, NIN, win_src(32 * nb), 64 * kb, norm1_w, WIN, D, 32 * nb, scr, F.lane); continue; } r -= I_IN;
            if (r < I_OUT) { const int kb = r / 32, nb = r % 32; p0_transpose_item(w_out, D, 32 * nb, 64 * kb, nullptr, WOUT, D, 32 * nb, scr, F.lane); continue; } r -= I_OUT;
            if (r < I_GU) { const int e = r / 1024, q = r % 1024, kb = q / 64, nb = q % 64; const int rho0 = 32 * nb, pn = rho0 >> 8, rr = rho0 & 255;
                const int sc = (rr < 128) ? 128 * pn + rr : 1024 + 128 * pn + (rr - 128);
                p0_transpose_item(w_gu + (size_t)e * D * 2048, 2048, sc, 64 * kb, norm2_w, WGU + (size_t)e * 2048 * D, D, rho0, scr, F.lane); continue; } r -= I_GU;
            { const int e = r / 512, q = r % 512, kb = q / 32, nb = q % 32;
                p0_transpose_item(w_down + (size_t)e * FF * D, D, 32 * nb, 64 * kb, nullptr, WDN + (size_t)e * D * FF, FF, 32 * nb, scr, F.lane); }
        }
        for (int m = F.gw; m < T; m += F.NGW) {
            const GAS f32x4* xr = (const GAS f32x4*)(x + (size_t)m * D) + F.lane;
            f32x4 v[4]; float s2 = 0.f;
#pragma unroll
            for (int j = 0; j < 4; ++j) { v[j] = xr[64 * j]; s2 += (v[j].x * v[j].x + v[j].y * v[j].y) + (v[j].z * v[j].z + v[j].w * v[j].w); }
            s2 = wave_sum(s2);
            if (F.lane == 0) RS1[m] = 1.0f / sqrtf(s2 * (1.0f / D) + NORM_EPS);
            GAS unsigned long long* o8 = (GAS unsigned long long*)(XB + (size_t)m * D) + F.lane;
#pragma unroll
            for (int j = 0; j < 4; ++j) o8[64 * j] = (unsigned long long)pk2(v[j].x, v[j].y) | ((unsigned long long)pk2(v[j].z, v[j].w) << 32);
        }
        const int gt = blockIdx.x * (NWAVES * 64) + F.tid, NGT = F.G * NWAVES * 64;
        for (int it = gt; it < 512 * 1024; it += NGT) { const int cp = it >> 10, n = it & 1023, g = cp >> 7;
            const float* pw = pool_w + (size_t)cp * 128; const float* ps = pool_scale + g * 128; const float* wo = w_out + (size_t)(512 + g * 128) * D + n;
            float a = 0.f;
            for (int d = 0; d < 128; ++d) a += pw[d] * ps[d] * wo[(size_t)d * D];
            WOUT[(size_t)n * D + 512 + cp] = (bf16_t)f2bf(a); }
        for (int it = gt; it < D * NE; it += NGT) WR[it] = norm2_w[it >> 5] * w_router[it];
        for (int it = gt; it < T * 8; it += NGT) { const int t = it >> 3, p = it & 7; const float ang = (float)positions[t] * (*(const float AS4*)(kp + 160 + 4 * p)); float sn, cs; sincosf(ang, &sn, &cs); ROPE[(size_t)t * 16 + p] = cs; ROPE[(size_t)t * 16 + 8 + p] = sn; }
        for (int it = gt; it < 2 * NE * LIST_CAP / 4; it += NGT) ((u32x4*)LIST)[it] = (u32x4){0u, 0u, 0u, 0u};
    }
    SEAM(0);

    if (IN(1)) {
        KP_FRESH(); unsigned char* ws = KWS(); unsigned char* ob = (unsigned char*)KOUT();
        pg8::TabOrder S; S.tab = utab; S.list = nullptr; S.nU = pg8::build_units(utab, T / 256, NIN / 256, F.G, (int)blockIdx.x, nullptr, nullptr);
        pg8::EpiInProj E{(bf16_t*)(ob + DO_QB), (bf16_t*)(ob + DO_KB), (bf16_t*)(ob + DO_VB), (bf16_t*)(ws + WS_UB), (const float*)(ws + WS_RS1), (const float*)(ws + WS_ROPE), KIN(const float*, 4), KIN(const float*, 5)};
        pg8::gemm_phase<pg8::EpiInProj, pg8::TabOrder, 0, false>(F.lds, idxring, (const bf16_t*)(ob + DO_XB), (const bf16_t*)(ws + WS_WIN), S, E);
    }
    SEAM(1);

    if (IN(2)) {
        KP_FRESH(); unsigned char* ws = KWS(); unsigned char* ob = (unsigned char*)KOUT(); const float* sinks = KIN(const float*, 6);
        const bf16_t* QB = (const bf16_t*)(ob + DO_QB); const bf16_t* KB = (const bf16_t*)(ob + DO_KB); const bf16_t* VB = (const bf16_t*)(ob + DO_VB);
        bf16_t* MIXED = (bf16_t*)(ws + WS_MIXED); const bf16_t* UB = (const bf16_t*)(ws + WS_UB);
        for (int uid = blockIdx.x; uid < NB * 2 * 32; uid += F.G) { const int qblk = uid & 31, kvh = (uid >> 5) & 1, b = uid >> 6; attn_unit(F, b, kvh, qblk, QB, KB, VB, MIXED, sinks); }
        const int gt = blockIdx.x * (NWAVES * 64) + F.tid, NGT = F.G * NWAVES * 64;
        for (int it = gt; it < T * 64; it += NGT) { const int t = it >> 6, c8 = (it & 63) * 8, g = c8 >> 7, w = 2 << g, s = t & (SEQ - 1); const int cnt = (s + 1 < w) ? s + 1 : w;
            float acc8[8];
#pragma unroll
            for (int c = 0; c < 8; ++c) acc8[c] = 0.f;
            u32x4 self = *(const u32x4*)(UB + (size_t)t * 512 + c8);
            for (int j = 0; j < cnt; ++j) { const u32x4 v = *(const u32x4*)(UB + (size_t)(t - j) * 512 + c8);
#pragma unroll
                for (int c = 0; c < 4; ++c) { acc8[2 * c] += __builtin_bit_cast(float, v[c] << 16); acc8[2 * c + 1] += __builtin_bit_cast(float, v[c] & 0xffff0000u); } }
            const float ic = 1.0f / (float)cnt; u32x4 o;
#pragma unroll
            for (int c = 0; c < 4; ++c) { const float s0_ = __builtin_bit_cast(float, self[c] << 16), s1_ = __builtin_bit_cast(float, self[c] & 0xffff0000u); o[c] = pk2(acc8[2 * c] * ic - s0_, acc8[2 * c + 1] * ic - s1_); }
            *(u32x4*)(MIXED + (size_t)t * D + 512 + c8) = o; }
    }
    SEAM(2);

    if (IN(3)) {
        KP_FRESH(); unsigned char* ws = KWS();
        pg8::TabOrder S; S.tab = utab; S.list = nullptr; S.nU = pg8::build_units(utab, T / 256, D / 256, F.G, (int)blockIdx.x, nullptr, nullptr);
        pg8::EpiOutProj E{KIN(const float*, 0), KOUT(), (bf16_t*)(ws + WS_HB)};
        pg8::gemm_phase<pg8::EpiOutProj, pg8::TabOrder, 0, false>(F.lds, idxring, (const bf16_t*)(ws + WS_MIXED), (const bf16_t*)(ws + WS_WOUT), S, E);
    }
    SEAM(3);

    if (IN(4)) {
        KP_FRESH(); unsigned char* ws = KWS(); const float* out = KOUT(); const float* b_router = KIN(const float*, 12);
        const float* WR = (const float*)(ws + WS_WR); float* RS2 = (float*)(ws + WS_RS2); float* GATE = (float*)(ws + WS_GATE); int* LIST = (int*)(ws + WS_LIST);
        LAS float* wr = (LAS float*)F.lds;
        for (int i = F.tid; i < D * NE / 4; i += NWAVES * 64) ((LAS f32x4*)wr)[i] = ((const f32x4*)WR)[i];
        LAS int* hist = (LAS int*)(F.lds + L_RH); LAS int* hbase = hist + 32;
        LAS float* lg = (LAS float*)(F.lds + L_RSCR + F.wave * 2112);
        const int r32 = F.lane & 31, hh = F.lane >> 5;
        for (int blk = blockIdx.x; blk < T / 256; blk += F.G) {
            if (F.tid < 32) hist[F.tid] = 0;
            __syncthreads();
            const int tok0 = blk * 256 + F.wave * 32;
            const float* hrow = out + (size_t)(tok0 + r32) * D + 512 * hh;
            f32x16 acc = {}; float ss = 0.f;
#pragma unroll 2
            for (int it = 0; it < 32; ++it) {
                f32x4 a[4];
#pragma unroll
                for (int q = 0; q < 4; ++q) a[q] = *(const f32x4*)(hrow + 16 * it + 4 * q);
#pragma unroll
                for (int q = 0; q < 4; ++q)
#pragma unroll
                    for (int c = 0; c < 4; ++c) { const float av = a[q][c]; ss += av * av; const float bv = wr[(512 * hh + 16 * it + 4 * q + c) * 32 + r32]; acc = __builtin_amdgcn_mfma_f32_32x32x2f32(av, bv, acc, 0, 0, 0); }
            }
            ss += __shfl_xor(ss, 32);
            const float rs = 1.0f / sqrtf(ss * (1.0f / D) + NORM_EPS);
            const int tok = tok0 + r32;
            if (hh == 0) RS2[tok] = rs;
            int sel[4]; float gv[4]; int lpos[4];
#pragma unroll
            for (int pass = 0; pass < 2; ++pass) {
#pragma unroll
                for (int r = 0; r < 8; ++r) { const int rr = 8 * pass + r; const int i = crow(rr, hh) - 16 * pass; lg[i * 33 + r32] = acc[rr]; }
                LDS_WAIT(); asm volatile("" ::: "memory");
                if ((r32 >> 4) == pass && hh == 0) {
                    const int i = r32 & 15; float v[32];
#pragma unroll
                    for (int e = 0; e < 32; ++e) v[e] = lg[i * 33 + e] * rs + b_router[e];
                    unsigned taken = 0u;
#pragma unroll
                    for (int k = 0; k < 4; ++k) { float best = -INFINITY; int bi = 0;
#pragma unroll
                        for (int e = 0; e < 32; ++e) { const bool ok = !((taken >> e) & 1u) && v[e] > best; best = ok ? v[e] : best; bi = ok ? e : bi; }
                        taken |= 1u << bi; sel[k] = bi; gv[k] = best; }
                    const float e1 = __expf(gv[1] - gv[0]), e2 = __expf(gv[2] - gv[0]), e3 = __expf(gv[3] - gv[0]); const float inv = 1.0f / (1.0f + e1 + e2 + e3);
                    gv[0] = inv; gv[1] = e1 * inv; gv[2] = e2 * inv; gv[3] = e3 * inv;
#pragma unroll
                    for (int k = 0; k < 4; ++k) lpos[k] = __hip_atomic_fetch_add(&hist[sel[k]], 1, __ATOMIC_RELAXED, __HIP_MEMORY_SCOPE_WORKGROUP);
                }
                LDS_WAIT(); asm volatile("" ::: "memory");
            }
            __syncthreads();
            const int half = (blk * 256 >= THALF) ? 1 : 0;
            if (F.tid < 32) hbase[F.tid] = (int)__hip_atomic_fetch_add((unsigned*)(ctl + CW_CNT + half * 32 + F.tid), (unsigned)hist[F.tid], RLX_AGENT);
            __syncthreads();
            if (hh == 0) {
#pragma unroll
                for (int k = 0; k < 4; ++k) { const int aid = tok * 4 + k; GATE[aid] = gv[k]; LIST[(size_t)(half * NE + sel[k]) * LIST_CAP + hbase[sel[k]] + lpos[k]] = aid; }
            }
            __syncthreads();
        }
    }
    SEAM(4);

#pragma unroll 1
    for (int half = 0; half < 2; ++half) {
        const int pb = 5 + 3 * half;
        LAS int* cntl = (LAS int*)(F.lds + L_CNT); LAS int* tinfo = (LAS int*)(F.lds + L_TINFO); LAS int* pref = (LAS int*)(F.lds + L_PREF);
        int nMt = 0;
        if (IN(pb) || IN(pb + 1)) {
            __syncthreads();
            if (F.tid < 32) cntl[F.tid] = (int)__hip_atomic_load((unsigned*)(ctl + CW_CNT + half * 32 + F.tid), RLX_AGENT);
            __syncthreads();
            if (F.tid == 0) { int a = 0; for (int e = 0; e < 32; ++e) { pref[e] = a; a += (cntl[e] + 255) >> 8; } pref[32] = a; }
            __syncthreads();
            nMt = pref[32];
            for (int e = 0; e < 32; ++e) { const int p0 = pref[e], n = pref[e + 1] - p0; for (int j = F.tid; j < n; j += NWAVES * 64) tinfo[p0 + j] = e | (j << 8); }
            __syncthreads();
        }
        if (IN(pb)) {
            KP_FRESH(); unsigned char* ws = KWS();
            pg8::TabOrder S; S.tab = utab; S.list = (const int*)(ws + WS_LIST) + (size_t)half * NE * LIST_CAP; S.nU = pg8::build_units(utab, nMt, 8, F.G, (int)blockIdx.x, tinfo, cntl);
            pg8::EpiGU E{(bf16_t*)(ws + WS_ACT), (const float*)(ws + WS_RS2), KIN(const float*, 14)};
            pg8::gemm_phase<pg8::EpiGU, pg8::TabOrder, 1, true>(F.lds, idxring, (const bf16_t*)(ws + WS_HB), (const bf16_t*)(ws + WS_WGU), S, E);
        }
        SEAM(pb);
        if (IN(pb + 1)) {
            KP_FRESH(); unsigned char* ws = KWS();
            pg8::TabOrder S; S.tab = utab; S.list = (const int*)(ws + WS_LIST) + (size_t)half * NE * LIST_CAP; S.nU = pg8::build_units(utab, nMt, 4, F.G, (int)blockIdx.x, tinfo, cntl);
            pg8::EpiDown E{(bf16_t*)(ws + WS_Y), (const float*)(ws + WS_GATE), KIN(const float*, 16), half * THALF * 4};
            pg8::gemm_phase<pg8::EpiDown, pg8::TabOrder, 0, true>(F.lds, idxring, (const bf16_t*)(ws + WS_ACT), (const bf16_t*)(ws + WS_WDN), S, E);
        }
        SEAM(pb + 1);
        if (IN(pb + 2)) {
            KP_FRESH(); float* out = KOUT(); const bf16_t* YB = (const bf16_t*)(KWS() + WS_Y);
            const int gt = blockIdx.x * (NWAVES * 64) + F.tid, NGT = F.G * NWAVES * 64;
            for (int it = gt; it < THALF * 128; it += NGT) { const int tl = it >> 7, c8 = (it & 127) * 8; const size_t o = (size_t)(half * THALF + tl) * D + c8;
                f32x4 h0 = *(const f32x4*)(out + o), h1 = *(const f32x4*)(out + o + 4);
#pragma unroll
                for (int k = 0; k < 4; ++k) { const u32x4 v = *(const u32x4*)(YB + (size_t)(tl * 4 + k) * D + c8);
                    h0[0] += __builtin_bit_cast(float, v[0] << 16); h0[1] += __builtin_bit_cast(float, v[0] & 0xffff0000u); h0[2] += __builtin_bit_cast(float, v[1] << 16); h0[3] += __builtin_bit_cast(float, v[1] & 0xffff0000u);
                    h1[0] += __builtin_bit_cast(float, v[2] << 16); h1[1] += __builtin_bit_cast(float, v[2] & 0xffff0000u); h1[2] += __builtin_bit_cast(float, v[3] << 16); h1[3] += __builtin_bit_cast(float, v[3] & 0xffff0000u); }
                *(f32x4*)(out + o) = h0; *(f32x4*)(out + o + 4) = h1; }
        }
        if (half == 0) SEAM(pb + 2);
    }
#undef IN
#undef SEAM
}

extern "C" void kernel_launch(void* const* d_in, const int* in_sizes, int n_in, void* d_out, int out_size, void* d_ws, size_t ws_size, hipStream_t stream) {
    static int grid = 0;
    if (grid == 0) {
        if (n_in != 17 || out_size != T * D || ws_size < WS_END) { fprintf(stderr, "kernel_launch: unexpected shapes (n_in %d out %d ws %zu)\n", n_in, out_size, ws_size); grid = -1; return; }
        int dev = 0, cus = 0, per_cu = 0;
        if (hipGetDevice(&dev) != hipSuccess || hipDeviceGetAttribute(&cus, hipDeviceAttributeMultiprocessorCount, dev) != hipSuccess) { grid = -1; return; }
        if (hipFuncSetAttribute((const void*)hymba_fwd, hipFuncAttributeMaxDynamicSharedMemorySize, LDS_BYTES) != hipSuccess) { fprintf(stderr, "kernel_launch: hipFuncSetAttribute failed\n"); grid = -1; return; }
        if (hipOccupancyMaxActiveBlocksPerMultiprocessor(&per_cu, (const void*)hymba_fwd, NWAVES * 64, LDS_BYTES) != hipSuccess || per_cu < 1) { fprintf(stderr, "kernel_launch: occupancy query says %d\n", per_cu); }
        (void)hipGetLastError();
        grid = cus;
    }
    if (grid < 0) return;
    (void)hipMemsetAsync((char*)d_ws + WS_CTL, 0, CTL_ZERO_BYTES, stream);
    Args a{};
    for (int i = 0; i < 17; ++i) a.in[i] = d_in[i];
    a.out = (float*)d_out; a.ws = (unsigned char*)d_ws;
    for (int p = 0; p < 8; ++p) a.invf[p] = (float)pow(500000.0, -(double)p / 8.0);
    if (N_LAUNCHES == 1) { a.ph_lo = 0; a.ph_hi = NPH; hipLaunchKernelGGL(hymba_fwd, dim3(grid), dim3(NWAVES * 64), LDS_BYTES, stream, a); }
    else for (int li = 0; li < NPH; ++li) { a.ph_lo = li; a.ph_hi = li + 1; hipLaunchKernelGGL(hymba_fwd, dim3(grid), dim3(NWAVES * 64), LDS_BYTES, stream, a); }
}
```

```cpp
#include <hip/hip_runtime.h>
#include <cstdio>
#include <cstdint>
#include <cmath>

#ifndef MK_N_LAUNCHES
#define MK_N_LAUNCHES 1
#endif

#define LAS __attribute__((address_space(3)))
#define GAS __attribute__((address_space(1)))
typedef unsigned short bf16_t;
typedef short bf16x8 __attribute__((ext_vector_type(8)));
typedef short s16x4 __attribute__((ext_vector_type(4)));
typedef float f32x4 __attribute__((ext_vector_type(4)));
typedef float f32x2 __attribute__((ext_vector_type(2)));
typedef float f32x16 __attribute__((ext_vector_type(16)));
typedef unsigned u32x4 __attribute__((ext_vector_type(4)));
typedef unsigned u32x2 __attribute__((ext_vector_type(2)));
typedef GAS unsigned gu32;

constexpr int NB = 16, SEQ = 4096, T = NB * SEQ, D = 1024, NIN = 1280, NE = 32, FF = 1024;
constexpr int THALF = T / 2;
constexpr int LIST_CAP = THALF;
constexpr float NORM_EPS = 1e-5f, QK_EPS = 1e-6f;
constexpr float LOG2E = 1.4426950408889634f;
constexpr float C2 = 0.125f * LOG2E;
constexpr int NWAVES = 8;
constexpr int NPH = 11;
constexpr int N_LAUNCHES = MK_N_LAUNCHES;

constexpr size_t MiB = 1u << 20;
constexpr size_t WS_CTL = 0, CTL_ZERO_BYTES = 1 * MiB;
constexpr size_t WS_WIN = 1 * MiB;
constexpr size_t WS_WOUT = 4 * MiB;
constexpr size_t WS_WR = 6 * MiB;
constexpr size_t WS_ROPE = 7 * MiB;
constexpr size_t WS_RS1 = 11 * MiB;
constexpr size_t WS_RS2 = 11 * MiB + 512 * 1024;
constexpr size_t WS_GATE = 12 * MiB;
constexpr size_t WS_LIST = 13 * MiB;
constexpr size_t WS_WGU = 22 * MiB;
constexpr size_t WS_WDN = 150 * MiB;
constexpr size_t WS_HB = 214 * MiB;
constexpr size_t WS_UB = 342 * MiB;
constexpr size_t WS_MIXED = 406 * MiB;
constexpr size_t WS_ACT = 342 * MiB;
constexpr size_t WS_Y = 614 * MiB;
constexpr size_t WS_END = 870 * MiB;
constexpr int ACT_SLOTS = THALF * 4 + NE * 256;
static_assert(WS_ACT + (size_t)ACT_SLOTS * 1024 * 2 <= WS_Y, "act");
constexpr size_t DO_XB = 0, DO_QB = 128 * MiB, DO_KB = 192 * MiB, DO_VB = 208 * MiB;
constexpr int CW_CNT = 64;
constexpr int CW_BAR = 4096;

constexpr int RING_BYTES = 131072;
constexpr int L_MISC = RING_BYTES;
constexpr int L_CNT = RING_BYTES + 512;
constexpr int L_PREF = RING_BYTES + 640;
constexpr int L_IDX = RING_BYTES + 1024;
constexpr int L_TINFO = RING_BYTES + 4096;
constexpr int L_RSCR = RING_BYTES + 8704;
constexpr int L_RH = RING_BYTES + 25600;
constexpr int L_UTAB = RING_BYTES + 26624;
constexpr int LDS_BYTES = RING_BYTES + 27648;

#define RLX_AGENT __ATOMIC_RELAXED, __HIP_MEMORY_SCOPE_AGENT
#define LDS_WAIT() asm volatile("s_waitcnt lgkmcnt(0)" ::: "memory")
#define VM_WAIT() asm volatile("s_waitcnt vmcnt(0)" ::: "memory")

__device__ __forceinline__ unsigned f2bf(float f) { unsigned u = __builtin_bit_cast(unsigned, f); return (u + 0x7fffu + ((u >> 16) & 1u)) >> 16; }
__device__ __forceinline__ unsigned pk2(float lo, float hi) { return f2bf(lo) | (f2bf(hi) << 16); }
__device__ __forceinline__ unsigned cvt_pk_bf16(float lo, float hi) { unsigned r; asm volatile("v_cvt_pk_bf16_f32 %0, %1, %2" : "=v"(r) : "v"(lo), "v"(hi)); return r; }
__device__ __forceinline__ float bf2f(unsigned short b) { return __builtin_bit_cast(float, (unsigned)b << 16); }

#define XB_TMO      128
#define XB_XCNT(j)  (256  + 64 * (j))
#define XB_XSUB(j)  (1280 + 64 * (j))
#define XB_XGEN(j)  (2304 + 64 * (j))
#define XB_TOP      3328
#define XB_TOPGEN   3392
#define XCD_BAR_WORDS 3456
#define XB_SPIN_CAP (1u << 23)
__device__ __forceinline__ unsigned xb_ld(unsigned* p)              { return __hip_atomic_load(p, __ATOMIC_RELAXED, __HIP_MEMORY_SCOPE_AGENT); }
__device__ __forceinline__ unsigned xb_add(unsigned* p, unsigned v) { return __hip_atomic_fetch_add(p, v, __ATOMIC_RELAXED, __HIP_MEMORY_SCOPE_AGENT); }
__device__ __forceinline__ unsigned xb_xcc_id() { return (unsigned)__builtin_amdgcn_s_getreg((3 << 11) | 20) & 0xFu; }
#define XB_SPIN(cond, bar) do { unsigned _sp = 0; while (cond) { __builtin_amdgcn_s_sleep(1); \
    if ((++_sp & 255u) == 0u) { if (xb_ld(&(bar)[XB_TMO])) break; if (_sp > XB_SPIN_CAP) { atomicAdd(&(bar)[XB_TMO], 1u); break; } } } } while (0)
struct XcdBarrier { unsigned* bar; unsigned x; volatile LAS unsigned* st; };
__device__ __forceinline__ XcdBarrier xcd_barrier_post(unsigned* bar, volatile LAS unsigned* st) {
    XcdBarrier b; b.bar = bar; b.x = xb_xcc_id(); b.st = st;
    if (threadIdx.x == 0) (void)xb_add(&bar[XB_XCNT(b.x)], 1u);
    return b;
}
__device__ __forceinline__ void xcd_barrier_complete(unsigned* bar, unsigned x, unsigned& nloc, unsigned& nx) {
    const unsigned G = gridDim.x * gridDim.y * gridDim.z;
    unsigned sum, cnt, mine, sp = 0u;
    for (;;) {
        sum = 0u; cnt = 0u; mine = 0u;
#pragma unroll
        for (unsigned j = 0; j < 16; ++j) { const unsigned c = xb_ld(&bar[XB_XCNT(j)]); sum += c; cnt += (c > 0u) ? 1u : 0u; mine = (j == x) ? c : mine; }
        if (sum == G) break;
        __builtin_amdgcn_s_sleep(1);
        if ((++sp & 255u) == 0u) { if (xb_ld(&bar[XB_TMO])) break; if (sp > XB_SPIN_CAP) { atomicAdd(&bar[XB_TMO], 1u); break; } }
    }
    nloc = mine > 0u ? mine : 1u; nx = cnt > 0u ? cnt : 1u;
}
__device__ __forceinline__ void xcd_barrier(const XcdBarrier& b) {
    asm volatile("s_waitcnt vmcnt(0)" ::: "memory");
    __syncthreads();
    if (threadIdx.x == 0) {
        unsigned* bar = b.bar;
        __builtin_amdgcn_s_waitcnt(0);
        unsigned nloc = b.st[0], nx = b.st[1];
        if (nloc == 0u) { xcd_barrier_complete(bar, b.x, nloc, nx); b.st[0] = nloc; b.st[1] = nx; }
        const unsigned old = xb_add(&bar[XB_XSUB(b.x)], 1u);
        const unsigned gen = old / nloc;
        if (old + 1u == (gen + 1u) * nloc) {
            __builtin_amdgcn_fence(__ATOMIC_RELEASE, "agent");
            asm volatile("s_waitcnt vmcnt(0)" ::: "memory");
            const unsigned og = xb_add(&bar[XB_TOP], 1u);
            const unsigned tg = og / nx;
            if (og + 1u == (tg + 1u) * nx) xb_add(&bar[XB_TOPGEN], 1u);
            else XB_SPIN(xb_ld(&bar[XB_TOPGEN]) == tg, bar);
            __builtin_amdgcn_fence(__ATOMIC_ACQUIRE, "agent");
            xb_add(&bar[XB_XGEN(b.x)], 1u);
            asm volatile("s_waitcnt vmcnt(0)" ::: "memory");
        } else {
            XB_SPIN(xb_ld(&bar[XB_XGEN(b.x)]) == gen, bar);
            __builtin_amdgcn_fence(__ATOMIC_ACQUIRE, "agent");
            asm volatile("s_waitcnt vmcnt(0)" ::: "memory");
        }
    }
    __syncthreads();
}

namespace pg8 {
constexpr int BM = 256, BK = 64, HALF = 128, HTB = HALF * BK * 2, NXCD = 8, WGM = 8;
__host__ __device__ __forceinline__ int lds_byte(int r, int c) { const int st = (r >> 4) * 2 + (c >> 5), rr = r & 15, cc = c & 31, ob = rr * 64 + cc * 2; return st * 1024 + (ob ^ (((ob >> 9) & 1) << 5)); }
__host__ __device__ __forceinline__ void stage_rc(int b, int& R, int& C) { const int st = b / 1024, sb = b % 1024, swz = sb ^ (((sb >> 9) & 1) << 5); R = (st >> 1) * 16 + swz / 64; C = (st & 1) * 32 + (swz % 64) / 2; }
__host__ __device__ __forceinline__ int perm32(int rho) { const int n = rho >> 4, i = rho & 15; return 8 * (i >> 2) + 4 * n + (i & 3); }

struct Unit { int pm, pn, bt, e, j, nvalid; };

__device__ __forceinline__ bool order_tile(int i, int nM, int nN, int G, int c, int& pm, int& pn) {
    const int nwg = nM * nN; const long L = (long)i * G + c; if (L >= nwg) return false;
    int wgid = (int)L; { const int q = nwg / NXCD, r = nwg % NXCD, xcd = wgid % NXCD, off = wgid / NXCD; wgid = (xcd < r ? xcd * (q + 1) : r * (q + 1) + (xcd - r) * q) + off; }
    const int nig = WGM * nN, gid = wgid / nig, fm = gid * WGM, gsz = (nM - fm) < WGM ? (nM - fm) : WGM;
    pm = fm + ((wgid % nig) % gsz); pn = (wgid % nig) / gsz; return true;
}
constexpr int MAX_UNITS = 64;
__device__ __forceinline__ int build_units(LAS int* tab, int nM, int nN, int G, int c, const LAS int* tinfo, const LAS int* cnt) {
    const int nwg = nM * nN; const int nU = (nwg > c) ? (nwg - c + G - 1) / G : 0;
    __syncthreads();
    const int i = threadIdx.x;
    if (i < nU && i < MAX_UNITS) { int pm = 0, pn = 0; order_tile(i, nM, nN, G, c, pm, pn);
        int e = 0, j = 0, nv = 256;
        if (tinfo) { const int ti = tinfo[pm]; e = ti & 255; j = ti >> 8; const int c_ = cnt[e] - 256 * j; nv = c_ < 256 ? c_ : 256; }
        tab[4 * i] = pm; tab[4 * i + 1] = pn; tab[4 * i + 2] = e * nN + pn; tab[4 * i + 3] = e | (j << 8) | (nv << 20); }
    __syncthreads();
    return nU < MAX_UNITS ? nU : MAX_UNITS;
}
struct TabOrder {
    const LAS int* tab; int nU; const int* list;
    __device__ __forceinline__ bool next(int i, Unit& u) const {
        if (i >= nU) return false;
        const int w3 = __builtin_amdgcn_readfirstlane(tab[4 * i + 3]);
        u.pm = __builtin_amdgcn_readfirstlane(tab[4 * i]); u.pn = __builtin_amdgcn_readfirstlane(tab[4 * i + 1]); u.bt = __builtin_amdgcn_readfirstlane(tab[4 * i + 2]);
        u.e = w3 & 255; u.j = (w3 >> 8) & 4095; u.nvalid = w3 >> 20; return true;
    }
    __device__ __forceinline__ const int* idx_src(const Unit& u) const { return list + (size_t)u.e * LIST_CAP + 256 * u.j; }
};

template <class Epi, class Sched, int AMODE, bool HAS_IDX, bool ALIGN_EPI = true>
__device__ __forceinline__ void gemm_phase(LAS unsigned char* lds, LAS int* idxring, const bf16_t* Ag, const bf16_t* Btg, const Sched& S, const Epi& E) {
    constexpr int K = 1024;
    const int tid = threadIdx.x, wid = __builtin_amdgcn_readfirstlane(tid >> 6), lane = tid & 63, wr = wid >> 2, wc = wid & 3, fr = lane & 15, fq = lane >> 4;
    const int nt = K / BK;
    unsigned voffB[2];
#pragma unroll
    for (int i = 0; i < 2; ++i) { int R, C; stage_rc(tid * 16 + i * 8192, R, C); const int Rb = Epi::PERM ? ((R & ~31) + perm32(R & 31)) : R; voffB[i] = (unsigned)(Rb * K + C) * 2u; }
    const size_t kstep = (size_t)(BK * 2);
    const size_t hstep = (size_t)HALF * K * 2;
    const size_t tstep = 2 * hstep;
    const unsigned ldsw = (unsigned)wid * 1024u;
    const int aoff = lds_byte(wr * 64 + fr, fq * 8), boff = lds_byte(wc * 32 + fr, fq * 8);
#define PG8_SA(b, h) (((b) * 2 + (h)) * HTB)
#define PG8_SB(b, h) ((4 + (b) * 2 + (h)) * HTB)
#define PG8_STAGE_B(bufoff, gbase) do { _Pragma("unroll") for (int _i = 0; _i < 2; ++_i) \
        __builtin_amdgcn_global_load_lds((const unsigned*)((const char*)(gbase) + voffB[_i]), (LAS unsigned*)(lds + (bufoff) + ldsw + _i * 8192), 16, 0, 0); } while (0)
#define PG8_STAGE_A(bufoff, kb, AO, h) do { _Pragma("unroll") for (int _i = 0; _i < 2; ++_i) \
        __builtin_amdgcn_global_load_lds((const unsigned*)((const char*)Ag + (kb) + (AO)[h][_i]), (LAS unsigned*)(lds + (bufoff) + ldsw + _i * 8192), 16, 0, 0); } while (0)
#define PG8_LDA(dst, b, h) do { _Pragma("unroll") for (int m = 0; m < 4; ++m) _Pragma("unroll") for (int k = 0; k < 2; ++k) dst[m][k] = *(const LAS bf16x8*)(lds + PG8_SA(b, h) + aoff + m * 2048 + k * 1024); } while (0)
#define PG8_LDB(dst, b, h) do { _Pragma("unroll") for (int n = 0; n < 2; ++n) _Pragma("unroll") for (int k = 0; k < 2; ++k) dst[n][k] = *(const LAS bf16x8*)(lds + PG8_SB(b, h) + boff + n * 2048 + k * 1024); } while (0)
#define PG8_MMA(ai, bj, At, Bt) do { __builtin_amdgcn_s_setprio(1); _Pragma("unroll") for (int m = 0; m < 4; ++m) _Pragma("unroll") for (int n = 0; n < 2; ++n) _Pragma("unroll") for (int k = 0; k < 2; ++k) \
        acc[ai][bj][m][n] = __builtin_amdgcn_mfma_f32_16x16x32_bf16(Bt[n][k], At[m][k], acc[ai][bj][m][n], 0, 0, 0); __builtin_amdgcn_s_setprio(0); } while (0)
#define PG8_WAIT_V(n) asm volatile("s_waitcnt vmcnt(" #n ")" ::: "memory")
#define PG8_WAIT_L(n) asm volatile("s_waitcnt lgkmcnt(" #n ")" ::: "memory")
#define PG8_BAR __builtin_amdgcn_s_barrier()
#define PG8_SCHED __builtin_amdgcn_sched_barrier(0)
#define PG8_AOFF(dst, U, islot) do { int _t = tid; asm volatile("" : "+v"(_t)); _Pragma("unroll") for (int _i = 0; _i < 2; ++_i) { int _R, _C; stage_rc(_t * 16 + _i * 8192, _R, _C); \
        _Pragma("unroll") for (int _h = 0; _h < 2; ++_h) { \
        int _row; if (AMODE == 0) _row = (U).pm * BM + _h * HALF + _R; else _row = idxring[(islot) * 256 + _h * HALF + _R] >> 2; \
        dst[_h][_i] = ((unsigned)_row * (unsigned)K + (unsigned)_C) * 2u; } } } while (0)
    Unit cur, nxt; int ui = 0, islot = 0;
    if (!S.next(0, cur)) return;
    if (HAS_IDX) {
        if (wid == 0) { __builtin_amdgcn_global_load_lds((const unsigned*)(S.idx_src(cur) + lane * 4), (LAS unsigned*)(idxring), 16, 0, 0); PG8_WAIT_V(0); }
        __syncthreads();
    }
    f32x4 acc[2][2][4][2];
#pragma unroll
    for (int a = 0; a < 2; ++a)
#pragma unroll
        for (int b = 0; b < 2; ++b)
#pragma unroll
            for (int m = 0; m < 4; ++m)
#pragma unroll
                for (int n = 0; n < 2; ++n) acc[a][b][m][n] = (f32x4){0.f, 0.f, 0.f, 0.f};
    bf16x8 At[4][2], B0[2][2], B1[2][2];
    unsigned ao[2][2];
    PG8_AOFF(ao, cur, 0);
    const char* cB = (const char*)Btg + (size_t)cur.bt * tstep;
    PG8_STAGE_B(PG8_SB(0, 0), cB); PG8_STAGE_B(PG8_SB(0, 1), cB + hstep); PG8_STAGE_A(PG8_SA(0, 0), 0, ao, 0); PG8_STAGE_A(PG8_SA(0, 1), 0, ao, 1);
    if (wr == 1) PG8_BAR;
    PG8_WAIT_V(2); PG8_BAR;
    PG8_STAGE_B(PG8_SB(1, 0), cB + kstep); PG8_STAGE_A(PG8_SA(1, 0), kstep, ao, 0); PG8_STAGE_B(PG8_SB(1, 1), cB + hstep + kstep);
    PG8_WAIT_V(6); PG8_BAR;
    for (;;) {
        const bool has_next = S.next(ui + 1, nxt);
        const int nslot = (islot == 2) ? 0 : islot + 1;
        if (HAS_IDX && has_next && wid == 0)
            __builtin_amdgcn_global_load_lds((const unsigned*)(S.idx_src(nxt) + lane * 4), (LAS unsigned*)(idxring + nslot * 256), 16, 0, 0);
        const char* nB = has_next ? (const char*)Btg + (size_t)nxt.bt * tstep : cB;
        for (int t = 0; t < nt; t += 2) {
            const bool last = (t == nt - 2);
            const size_t k1 = (size_t)(t + 1) * kstep;
            const size_t k2 = last ? 0 : (size_t)(t + 2) * kstep, k3 = k2 + kstep;
            const char* b2 = last ? nB : cB + (size_t)(t + 2) * kstep; const char* b3 = b2 + kstep;
            PG8_LDB(B0, 0, 0); PG8_LDB(B1, 0, 1); PG8_SCHED; PG8_LDA(At, 0, 0); PG8_STAGE_A(PG8_SA(1, 1), k1, ao, 1);
            if (last && has_next) { PG8_AOFF(ao, nxt, nslot); }
            PG8_WAIT_V(8); PG8_WAIT_L(0); PG8_BAR; PG8_MMA(0, 0, At, B0); PG8_MMA(0, 1, At, B1); PG8_BAR; PG8_SCHED;
            PG8_LDA(At, 0, 1); PG8_STAGE_B(PG8_SB(0, 0), b2); PG8_STAGE_B(PG8_SB(0, 1), b2 + hstep); PG8_STAGE_A(PG8_SA(0, 0), k2, ao, 0);
            PG8_WAIT_V(8); PG8_WAIT_L(0); PG8_BAR; PG8_MMA(1, 0, At, B0); PG8_MMA(1, 1, At, B1); PG8_BAR; PG8_SCHED;
            PG8_LDB(B0, 1, 0); PG8_LDB(B1, 1, 1); PG8_SCHED; PG8_LDA(At, 1, 0); PG8_STAGE_A(PG8_SA(0, 1), k2, ao, 1);
            PG8_WAIT_V(8); PG8_WAIT_L(0); PG8_BAR; PG8_MMA(0, 0, At, B0); PG8_MMA(0, 1, At, B1); PG8_BAR; PG8_SCHED;
            PG8_LDA(At, 1, 1); PG8_STAGE_B(PG8_SB(1, 0), b3); PG8_STAGE_B(PG8_SB(1, 1), b3 + hstep); PG8_STAGE_A(PG8_SA(1, 0), k3, ao, 0);
            PG8_WAIT_V(8); PG8_WAIT_L(0); PG8_BAR; PG8_MMA(1, 0, At, B0); PG8_MMA(1, 1, At, B1); PG8_BAR; PG8_SCHED;
        }
        if (ALIGN_EPI) { if (wr == 0) PG8_BAR; }
        E(acc, cur, wr, wc, fr, fq, (const LAS int*)(idxring + islot * 256));
        if (!has_next) break;
#pragma unroll
        for (int a = 0; a < 2; ++a)
#pragma unroll
            for (int b = 0; b < 2; ++b)
#pragma unroll
                for (int m = 0; m < 4; ++m)
#pragma unroll
                    for (int n = 0; n < 2; ++n) acc[a][b][m][n] = (f32x4){0.f, 0.f, 0.f, 0.f};
        cur = nxt; cB = nB; ++ui; islot = nslot;
        if (ALIGN_EPI) { if (wr == 1) PG8_BAR; }
    }
    PG8_WAIT_V(0);
    if (!ALIGN_EPI) { if (wr == 0) PG8_BAR; }
    PG8_BAR;
#undef PG8_SA
#undef PG8_SB
#undef PG8_STAGE_A
#undef PG8_STAGE_B
#undef PG8_LDA
#undef PG8_LDB
#undef PG8_MMA
#undef PG8_WAIT_V
#undef PG8_WAIT_L
#undef PG8_BAR
#undef PG8_SCHED
#undef PG8_AOFF
}

__device__ __forceinline__ u32x4 pack8(const f32x4 a, const f32x4 b) { u32x4 w; w.x = cvt_pk_bf16(a[0], a[1]); w.y = cvt_pk_bf16(a[2], a[3]); w.z = cvt_pk_bf16(b[0], b[1]); w.w = cvt_pk_bf16(b[2], b[3]); return w; }

struct EpiInProj {
    static constexpr bool PERM = true;
    bf16_t *Q, *Kb, *Vb, *U; const float *rs1, *rope, *qw, *kw;
    __device__ __forceinline__ void operator()(const f32x4 (&acc)[2][2][4][2], const Unit& u, int wr, int wc, int fr, int fq, const LAS int*) const {
        const int row0 = u.pm * BM + wr * 64 + fr;
        if (u.pn >= 3) {
#pragma unroll
            for (int ai = 0; ai < 2; ++ai)
#pragma unroll
                for (int m = 0; m < 4; ++m) { const int row = row0 + ai * HALF + m * 16; const float s = rs1[row];
                    bf16_t* rp = U + (size_t)row * 512 + (u.pn - 3) * 256 + wc * 32 + 8 * fq;
#pragma unroll
                    for (int bj = 0; bj < 2; ++bj) *(u32x4*)(rp + bj * HALF) = pack8(acc[ai][bj][m][0] * s, acc[ai][bj][m][1] * s); }
            return;
        }
        const bool isv = (u.pn == 2 && wc >= 2);
        bf16_t* dst; int ld; const float* w; float post;
        if (u.pn < 2) { dst = Q + (4 * u.pn + wc) * 64; ld = 512; w = qw; post = C2; }
        else if (wc < 2) { dst = Kb + wc * 64; ld = 128; w = kw; post = 1.f; }
        else { dst = Vb + (wc - 2) * 64; ld = 128; w = qw; post = 1.f; }
        f32x4 wv[2][2];
#pragma unroll
        for (int bj = 0; bj < 2; ++bj)
#pragma unroll
            for (int n = 0; n < 2; ++n) wv[bj][n] = *(const f32x4*)(w + 32 * bj + 8 * fq + 4 * n);
#pragma unroll
        for (int ai = 0; ai < 2; ++ai)
#pragma unroll
            for (int m = 0; m < 4; ++m) {
                const int row = row0 + ai * HALF + m * 16; const float s = rs1[row];
                f32x4 x[2][2];
#pragma unroll
                for (int bj = 0; bj < 2; ++bj)
#pragma unroll
                    for (int n = 0; n < 2; ++n) x[bj][n] = acc[ai][bj][m][n] * s;
                if (!isv) {
                    float ss = 0.f;
#pragma unroll
                    for (int bj = 0; bj < 2; ++bj)
#pragma unroll
                        for (int n = 0; n < 2; ++n) ss += (x[bj][n][0] * x[bj][n][0] + x[bj][n][1] * x[bj][n][1]) + (x[bj][n][2] * x[bj][n][2] + x[bj][n][3] * x[bj][n][3]);
                    ss += __shfl_xor(ss, 16); ss += __shfl_xor(ss, 32);
                    const float rn = 1.0f / sqrtf(ss * (1.0f / 64.0f) + QK_EPS);
#pragma unroll
                    for (int bj = 0; bj < 2; ++bj)
#pragma unroll
                        for (int n = 0; n < 2; ++n) x[bj][n] = x[bj][n] * rn * wv[bj][n];
                    const float* rp = rope + (size_t)row * 16;
#pragma unroll
                    for (int n = 0; n < 2; ++n) {
                        const f32x4 cs = *(const f32x4*)(rp + 4 * n), sn = *(const f32x4*)(rp + 8 + 4 * n);
                        f32x4 pr;
#pragma unroll
                        for (int c = 0; c < 4; ++c) pr[c] = __shfl_xor(x[0][n][c], 16);
                        const f32x4 r0 = x[0][n] * cs - pr * sn, r1 = x[0][n] * cs + pr * sn;
                        if (fq == 0) x[0][n] = r0; else if (fq == 1) x[0][n] = r1;
                    }
#pragma unroll
                    for (int bj = 0; bj < 2; ++bj)
#pragma unroll
                        for (int n = 0; n < 2; ++n) x[bj][n] = x[bj][n] * post;
                }
                bf16_t* op = dst + (size_t)row * ld + 8 * fq;
#pragma unroll
                for (int bj = 0; bj < 2; ++bj) *(u32x4*)(op + 32 * bj) = pack8(x[bj][0], x[bj][1]);
            }
    }
};
struct EpiOutProj {
    static constexpr bool PERM = true;
    const float* x; float* out; bf16_t* hb;
    __device__ __forceinline__ void operator()(const f32x4 (&acc)[2][2][4][2], const Unit& u, int wr, int wc, int fr, int fq, const LAS int*) const {
        const int row0 = u.pm * BM + wr * 64 + fr, col0 = u.pn * BM + wc * 32 + 8 * fq;
#pragma unroll
        for (int ai = 0; ai < 2; ++ai)
#pragma unroll
            for (int m = 0; m < 4; ++m) { const size_t off = (size_t)(row0 + ai * HALF + m * 16) * D + col0;
#pragma unroll
                for (int bj = 0; bj < 2; ++bj) { const f32x4 h0 = *(const f32x4*)(x + off + bj * HALF) + acc[ai][bj][m][0], h1 = *(const f32x4*)(x + off + bj * HALF + 4) + acc[ai][bj][m][1];
                    *(f32x4*)(out + off + bj * HALF) = h0; *(f32x4*)(out + off + bj * HALF + 4) = h1; *(u32x4*)(hb + off + bj * HALF) = pack8(h0, h1); } }
    }
};
struct EpiGU {
    static constexpr bool PERM = true;
    bf16_t* act; const float* rs2; const float* bgu;
    __device__ __forceinline__ void operator()(const f32x4 (&acc)[2][2][4][2], const Unit& u, int wr, int wc, int fr, int fq, const LAS int* idx) const {
        const int r0 = wr * 64 + fr, c0 = u.pn * 128 + wc * 32 + 8 * fq;
        const float* bp = bgu + (size_t)u.e * 2048 + c0;
        const f32x4 bg0 = *(const f32x4*)(bp), bg1 = *(const f32x4*)(bp + 4), bu0 = *(const f32x4*)(bp + 1024), bu1 = *(const f32x4*)(bp + 1028);
#pragma unroll
        for (int ai = 0; ai < 2; ++ai)
#pragma unroll
            for (int m = 0; m < 4; ++m) { const int r = r0 + ai * HALF + m * 16; const float s = rs2[idx[r] >> 2];
                f32x4 a[2];
#pragma unroll
                for (int n = 0; n < 2; ++n) { const f32x4 g = acc[ai][0][m][n] * s + (n ? bg1 : bg0), uu = acc[ai][1][m][n] * s + (n ? bu1 : bu0);
#pragma unroll
                    for (int c = 0; c < 4; ++c) { const float gc = fminf(g[c], 7.0f), uc = fminf(fmaxf(uu[c], -7.0f), 7.0f);
                        const float sg = __builtin_amdgcn_rcpf(1.0f + __builtin_amdgcn_exp2f(gc * (-1.702f * LOG2E))); a[n][c] = gc * sg * (uc + 1.0f); } }
                *(u32x4*)(act + (size_t)(u.pm * BM + r) * FF + c0) = pack8(a[0], a[1]); }
    }
};
struct EpiDown {
    static constexpr bool PERM = true;
    bf16_t* y; const float* gate; const float* bdn; int aid0;
    __device__ __forceinline__ void operator()(const f32x4 (&acc)[2][2][4][2], const Unit& u, int wr, int wc, int fr, int fq, const LAS int* idx) const {
        const int r0 = wr * 64 + fr, c0 = u.pn * BM + wc * 32 + 8 * fq;
        const float* bp = bdn + (size_t)u.e * D + c0;
        f32x4 bv[2][2];
#pragma unroll
        for (int bj = 0; bj < 2; ++bj)
#pragma unroll
            for (int n = 0; n < 2; ++n) bv[bj][n] = *(const f32x4*)(bp + bj * HALF + 4 * n);
#pragma unroll
        for (int ai = 0; ai < 2; ++ai)
#pragma unroll
            for (int m = 0; m < 4; ++m) { const int r = r0 + ai * HALF + m * 16;
                if (r < u.nvalid) { const int aid = idx[r]; const float g = gate[aid]; bf16_t* yp = y + (size_t)(aid - aid0) * D + c0;
#pragma unroll
                    for (int bj = 0; bj < 2; ++bj) *(u32x4*)(yp + bj * HALF) = pack8((acc[ai][bj][m][0] + bv[bj][0]) * g, (acc[ai][bj][m][1] + bv[bj][1]) * g); } }
    }
};
}

struct Frame {
    LAS unsigned char* lds;
    int tid, lane, wave, G, gw, NGW;
};

__device__ __forceinline__ float wave_sum(float v) {
#pragma unroll
    for (int o = 1; o < 64; o <<= 1) v += __shfl_xor(v, o);
    return v;
}

__device__ __forceinline__ void p0_transpose_item(const float* W, int ldw, int scol0, int k0, const float* ks, bf16_t* WT, int K, int drow0, LAS float* scr, int lane) {
#pragma unroll 8
    for (int i = 0; i < 32; ++i) { const int kk = 2 * i + (lane >> 5); float v = W[(size_t)(k0 + kk) * ldw + scol0 + (lane & 31)]; if (ks) v *= ks[k0 + kk]; scr[kk * 33 + (lane & 31)] = v; }
    LDS_WAIT(); asm volatile("" ::: "memory");
    const int c = lane & 7;
#pragma unroll
    for (int j = 0; j < 4; ++j) { const int n = (lane >> 3) + 8 * j; const LAS float* s = scr + (8 * c) * 33 + n;
        u32x4 o; o.x = pk2(s[0 * 33], s[1 * 33]); o.y = pk2(s[2 * 33], s[3 * 33]); o.z = pk2(s[4 * 33], s[5 * 33]); o.w = pk2(s[6 * 33], s[7 * 33]);
        *(GAS u32x4*)(WT + (size_t)(drow0 + n) * K + k0 + 8 * c) = o; }
    LDS_WAIT(); asm volatile("" ::: "memory");
}
__device__ __forceinline__ int win_src(int rho0) {
    const int pn = rho0 >> 8, within = rho0 & 255, bj = within >> 7, wc = (within & 127) >> 5;
    if (pn < 2) return 64 * (4 * pn + wc) + 32 * bj;
    if (pn == 2) return 512 + 64 * wc + 32 * bj;
    return rho0;
}

struct Args { const void* in[17]; float* out; unsigned char* ws; int ph_lo, ph_hi; float invf[8]; };

__device__ __forceinline__ int crow(int r, int hi) { return (r & 3) + 8 * (r >> 2) + 4 * hi; }
typedef short v4i16_t __attribute__((ext_vector_type(4)));
__device__ __forceinline__ s16x4 vtr(const LAS unsigned char* p) { return __builtin_bit_cast(s16x4, __builtin_amdgcn_ds_read_tr16_b64_v4i16((LAS v4i16_t*)p)); }

__device__ __forceinline__ void attn_unit(const Frame& F, int b, int kvh, int qblk, const bf16_t* Q, const bf16_t* Kb, const bf16_t* Vb, bf16_t* O, const float* sinks) {
    const int lane = F.lane, wid = F.wave, r32 = lane & 31, hi = lane >> 5;
    LAS unsigned char* lds = F.lds;
    const int s0 = qblk * 128; const long rowq0 = (long)b * SEQ + s0;
    {
        u32x4 kv[4], vv[4];
#pragma unroll
        for (int jt = 0; jt < 4; ++jt) {
            long rt = (long)b * SEQ + s0 - 128 + 64 * jt; if (qblk == 0 && jt < 2) rt = (long)b * SEQ;
            kv[jt] = *(const u32x4*)(Kb + (rt + lane) * 128 + kvh * 64 + wid * 8);
            vv[jt] = *(const u32x4*)(Vb + (rt + 16 * (wid & 3) + (lane >> 2)) * 128 + kvh * 64 + (wid >> 2) * 32 + (lane & 3) * 8);
        }
#pragma unroll
        for (int jt = 0; jt < 4; ++jt) { *(LAS u32x4*)(lds + jt * 8192 + wid * 1024 + lane * 16) = kv[jt]; *(LAS u32x4*)(lds + 32768 + jt * 8192 + wid * 1024 + lane * 16) = vv[jt]; }
    }
    __syncthreads();
    const int g = wid >> 1, rh = wid & 1, head = kvh * 4 + g, t0 = rh;
    const float sinkl = sinks[head] * LOG2E;
    LAS bf16_t* stg = (LAS bf16_t*)(lds + 65536) + wid * 2048;
    const int vboff = ((lane >> 4) & 1) * 32 + (lane & 3) * 8 + (4 * hi + ((lane & 15) >> 2)) * 64;
#pragma unroll 1
    for (int s = 0; s < 2; ++s) {
        const int q0 = 64 * rh + 32 * s;
        const bf16_t* Qw = Q + (size_t)(rowq0 + q0 + r32) * 512 + head * 64 + hi * 8;
        bf16x8 qr[4];
#pragma unroll
        for (int d0 = 0; d0 < 4; ++d0) qr[d0] = *(const bf16x8*)(Qw + d0 * 16);
        const int qi = q0 + r32; const int klo = (qblk == 0) ? (qi > 127 ? qi : 127) : qi;
        float mrun = sinkl, l = 1.0f;
        f32x16 o[2]; o[0] = f32x16{}; o[1] = f32x16{};
#pragma unroll 1
        for (int jt = 0; jt < 3; ++jt) {
            const LAS unsigned char* kb = lds + (t0 + jt) * 8192 + hi * 1024 + r32 * 16;
            f32x16 p0 = {}, p1 = {};
#pragma unroll
            for (int d0 = 0; d0 < 4; ++d0) {
                const bf16x8 k0 = *(const LAS bf16x8*)(kb + d0 * 2048), k1 = *(const LAS bf16x8*)(kb + d0 * 2048 + 512);
                p0 = __builtin_amdgcn_mfma_f32_32x32x16_bf16(k0, qr[d0], p0, 0, 0, 0);
                p1 = __builtin_amdgcn_mfma_f32_32x32x16_bf16(k1, qr[d0], p1, 0, 0, 0);
            }
            float mx = mrun; const int kbase = 64 * (t0 + jt);
#pragma unroll
            for (int r = 0; r < 16; ++r) { const int kj = kbase + crow(r, hi);
                const bool ok0 = (kj > klo) && (kj <= qi + 128), ok1 = (kj + 32 > klo) && (kj + 32 <= qi + 128);
                p0[r] = ok0 ? p0[r] : -INFINITY; p1[r] = ok1 ? p1[r] : -INFINITY; mx = fmaxf(mx, fmaxf(p0[r], p1[r])); }
            mx = fmaxf(mx, __shfl_xor(mx, 32));
            const float alpha = __builtin_amdgcn_exp2f(mrun - mx); mrun = mx;
            float ls = 0.f;
#pragma unroll
            for (int r = 0; r < 16; ++r) { p0[r] = __builtin_amdgcn_exp2f(p0[r] - mx); p1[r] = __builtin_amdgcn_exp2f(p1[r] - mx); ls += p0[r] + p1[r]; }
            ls += __shfl_xor(ls, 32);
            l = l * alpha + ls;
#pragma unroll
            for (int d0 = 0; d0 < 2; ++d0)
#pragma unroll
                for (int r = 0; r < 16; ++r) o[d0][r] *= alpha;
            const LAS unsigned char* vp = lds + 32768 + (t0 + jt) * 8192 + vboff;
#pragma unroll
            for (int ks = 0; ks < 4; ++ks) {
                const f32x16& P = (ks < 2) ? p0 : p1; const int rb = (ks & 1) * 8;
                u32x4 pw; pw.x = cvt_pk_bf16(P[rb + 0], P[rb + 1]); pw.y = cvt_pk_bf16(P[rb + 2], P[rb + 3]); pw.z = cvt_pk_bf16(P[rb + 4], P[rb + 5]); pw.w = cvt_pk_bf16(P[rb + 6], P[rb + 7]);
                const bf16x8 pb = __builtin_bit_cast(bf16x8, pw);
#pragma unroll
                for (int d0 = 0; d0 < 2; ++d0) {
                    const s16x4 lo = vtr(vp + d0 * 4096 + ks * 1024), hv = vtr(vp + d0 * 4096 + ks * 1024 + 512);
                    const bf16x8 vf = (bf16x8){lo[0], lo[1], lo[2], lo[3], hv[0], hv[1], hv[2], hv[3]};
                    o[d0] = __builtin_amdgcn_mfma_f32_32x32x16_bf16(vf, pb, o[d0], 0, 0, 0);
                }
            }
        }
        const float rl = 1.0f / l;
#pragma unroll
        for (int d0 = 0; d0 < 2; ++d0)
#pragma unroll
            for (int g4 = 0; g4 < 4; ++g4) { u32x2 w; w.x = cvt_pk_bf16(o[d0][4 * g4] * rl, o[d0][4 * g4 + 1] * rl); w.y = cvt_pk_bf16(o[d0][4 * g4 + 2] * rl, o[d0][4 * g4 + 3] * rl);
                *(LAS u32x2*)(stg + r32 * 64 + 32 * d0 + 8 * g4 + 4 * hi) = w; }
        LDS_WAIT();
        bf16_t* Ow = O + (size_t)(rowq0 + q0) * D + head * 64;
#pragma unroll
        for (int i = 0; i < 4; ++i) { const int row = i * 8 + (lane >> 3), ch = lane & 7; const u32x4 v = *(const LAS u32x4*)(stg + row * 64 + ch * 8); *(u32x4*)(Ow + (size_t)row * D + ch * 8) = v; }
        LDS_WAIT();
    }
    __syncthreads();
}

__global__ void __launch_bounds__(NWAVES * 64, 2) hymba_fwd(Args args) {
    extern __shared__ __attribute__((aligned(16))) unsigned char lds_raw[];
    Frame F;
    F.lds = (LAS unsigned char*)lds_raw;
    F.tid = threadIdx.x; F.lane = F.tid & 63; F.wave = __builtin_amdgcn_readfirstlane(F.tid >> 6);
    F.G = gridDim.x; F.gw = blockIdx.x * NWAVES + F.wave; F.NGW = F.G * NWAVES;
    volatile LAS unsigned* MISC = (volatile LAS unsigned*)(F.lds + L_MISC);
#define AS4 __attribute__((address_space(4)))
    const AS4 char* kbase = (const AS4 char*)__builtin_amdgcn_kernarg_segment_ptr();
#define KP_FRESH() const AS4 char* kp = kbase; asm volatile("" : "+s"(kp))
#define KIN(T, i) ((T)(*(const void* const AS4*)(kp + 8 * (i))))
#define KOUT() (*(float* const AS4*)(kp + 136))
#define KWS() (*(unsigned char* const AS4*)(kp + 144))
    gu32* ctl;
    { KP_FRESH(); ctl = (gu32*)(KWS() + WS_CTL); }
    for (int u = F.tid; u < 512 / 4; u += NWAVES * 64) ((LAS unsigned*)(F.lds + L_MISC))[u] = 0u;
    __syncthreads();
    XcdBarrier bar; bar.bar = (unsigned*)(ctl + CW_BAR); bar.x = 0; bar.st = nullptr;
    if (N_LAUNCHES == 1) bar = xcd_barrier_post((unsigned*)(ctl + CW_BAR), MISC + 8);
    int lo, hi; { KP_FRESH(); lo = *(const int AS4*)(kp + 152); hi = *(const int AS4*)(kp + 156); }
#define IN(k) (lo <= (k) && (k) < hi)
#define SEAM(k) do { if (IN(k) && IN((k) + 1)) xcd_barrier(bar); } while (0)
    LAS int* idxring = (LAS int*)(F.lds + L_IDX);
    LAS int* utab = (LAS int*)(F.lds + L_UTAB);

    if (IN(0)) {
        KP_FRESH(); unsigned char* ws = KWS(); float* out = KOUT();
        const float* x = KIN(const float*, 0); const int* positions = KIN(const int*, 1); const float* norm1_w = KIN(const float*, 2); const float* w_in = KIN(const float*, 3);
        const float* pool_w = KIN(const float*, 7); const float* pool_scale = KIN(const float*, 8); const float* w_out = KIN(const float*, 9); const float* norm2_w = KIN(const float*, 10);
        const float* w_router = KIN(const float*, 11); const float* w_gu = KIN(const float*, 13); const float* w_down = KIN(const float*, 15);
        bf16_t* WIN = (bf16_t*)(ws + WS_WIN); bf16_t* WOUT = (bf16_t*)(ws + WS_WOUT); float* WR = (float*)(ws + WS_WR); float* ROPE = (float*)(ws + WS_ROPE);
        float* RS1 = (float*)(ws + WS_RS1); int* LIST = (int*)(ws + WS_LIST); bf16_t* WGU = (bf16_t*)(ws + WS_WGU); bf16_t* WDN = (bf16_t*)(ws + WS_WDN);
        bf16_t* XB = (bf16_t*)((unsigned char*)out + DO_XB);
        LAS float* scr = (LAS float*)(F.lds + F.wave * 16384);
        constexpr int I_IN = 16 * 40, I_OUT = 8 * 32, I_GU = 32 * 16 * 64, I_DN = 32 * 16 * 32, NITEMS = I_IN + I_OUT + I_GU + I_DN;
        for (int it = F.gw; it < NITEMS; it += F.NGW) {
            int r = it;
            if (r < I_IN) { const int kb = r / 40, nb = r % 40; p0_transpose_item(w_in, NIN, win_src(32 * nb), 64 * kb, norm1_w, WIN, D, 32 * nb, scr, F.lane); continue; } r -= I_IN;
            if (r < I_OUT) { const int kb = r / 32, nb = r % 32; p0_transpose_item(w_out, D, 32 * nb, 64 * kb, nullptr, WOUT, D, 32 * nb, scr, F.lane); continue; } r -= I_OUT;
            if (r < I_GU) { const int e = r / 1024, q = r % 1024, kb = q / 64, nb = q % 64; const int rho0 = 32 * nb, pn = rho0 >> 8, rr = rho0 & 255;
                const int sc = (rr < 128) ? 128 * pn + rr : 1024 + 128 * pn + (rr - 128);
                p0_transpose_item(w_gu + (size_t)e * D * 2048, 2048, sc, 64 * kb, norm2_w, WGU + (size_t)e * 2048 * D, D, rho0, scr, F.lane); continue; } r -= I_GU;
            { const int e = r / 512, q = r % 512, kb = q / 32, nb = q % 32;
                p0_transpose_item(w_down + (size_t)e * FF * D, D, 32 * nb, 64 * kb, nullptr, WDN + (size_t)e * D * FF, FF, 32 * nb, scr, F.lane); }
        }
        for (int m = F.gw; m < T; m += F.NGW) {
            const GAS f32x4* xr = (const GAS f32x4*)(x + (size_t)m * D) + F.lane;
            f32x4 v[4]; float s2 = 0.f;
#pragma unroll
            for (int j = 0; j < 4; ++j) { v[j] = xr[64 * j]; s2 += (v[j].x * v[j].x + v[j].y * v[j].y) + (v[j].z * v[j].z + v[j].w * v[j].w); }
            s2 = wave_sum(s2);
            if (F.lane == 0) RS1[m] = 1.0f / sqrtf(s2 * (1.0f / D) + NORM_EPS);
            GAS unsigned long long* o8 = (GAS unsigned long long*)(XB + (size_t)m * D) + F.lane;
#pragma unroll
            for (int j = 0; j < 4; ++j) o8[64 * j] = (unsigned long long)pk2(v[j].x, v[j].y) | ((unsigned long long)pk2(v[j].z, v[j].w) << 32);
        }
        const int gt = blockIdx.x * (NWAVES * 64) + F.tid, NGT = F.G * NWAVES * 64;
        for (int it = gt; it < 512 * 1024; it += NGT) { const int cp = it >> 10, n = it & 1023, g = cp >> 7;
            const float* pw = pool_w + (size_t)cp * 128; const float* ps = pool_scale + g * 128; const float* wo = w_out + (size_t)(512 + g * 128) * D + n;
            float a = 0.f;
            for (int d = 0; d < 128; ++d) a += pw[d] * ps[d] * wo[(size_t)d * D];
            WOUT[(size_t)n * D + 512 + cp] = (bf16_t)f2bf(a); }
        for (int it = gt; it < D * NE; it += NGT) WR[it] = norm2_w[it >> 5] * w_router[it];
        for (int it = gt; it < T * 8; it += NGT) { const int t = it >> 3, p = it & 7; const float ang = (float)positions[t] * (*(const float AS4*)(kp + 160 + 4 * p)); float sn, cs; sincosf(ang, &sn, &cs); ROPE[(size_t)t * 16 + p] = cs; ROPE[(size_t)t * 16 + 8 + p] = sn; }
        for (int it = gt; it < 2 * NE * LIST_CAP / 4; it += NGT) ((u32x4*)LIST)[it] = (u32x4){0u, 0u, 0u, 0u};
    }
    SEAM(0);

    if (IN(1)) {
        KP_FRESH(); unsigned char* ws = KWS(); unsigned char* ob = (unsigned char*)KOUT();
        pg8::TabOrder S; S.tab = utab; S.list = nullptr; S.nU = pg8::build_units(utab, T / 256, NIN / 256, F.G, (int)blockIdx.x, nullptr, nullptr);
        pg8::EpiInProj E{(bf16_t*)(ob + DO_QB), (bf16_t*)(ob + DO_KB), (bf16_t*)(ob + DO_VB), (bf16_t*)(ws + WS_UB), (const float*)(ws + WS_RS1), (const float*)(ws + WS_ROPE), KIN(const float*, 4), KIN(const float*, 5)};
        pg8::gemm_phase<pg8::EpiInProj, pg8::TabOrder, 0, false>(F.lds, idxring, (const bf16_t*)(ob + DO_XB), (const bf16_t*)(ws + WS_WIN), S, E);
    }
    SEAM(1);

    if (IN(2)) {
        KP_FRESH(); unsigned char* ws = KWS(); unsigned char* ob = (unsigned char*)KOUT(); const float* sinks = KIN(const float*, 6);
        const bf16_t* QB = (const bf16_t*)(ob + DO_QB); const bf16_t* KB = (const bf16_t*)(ob + DO_KB); const bf16_t* VB = (const bf16_t*)(ob + DO_VB);
        bf16_t* MIXED = (bf16_t*)(ws + WS_MIXED); const bf16_t* UB = (const bf16_t*)(ws + WS_UB);
        for (int uid = blockIdx.x; uid < NB * 2 * 32; uid += F.G) { const int qblk = uid & 31, kvh = (uid >> 5) & 1, b = uid >> 6; attn_unit(F, b, kvh, qblk, QB, KB, VB, MIXED, sinks); }
        const int gt = blockIdx.x * (NWAVES * 64) + F.tid, NGT = F.G * NWAVES * 64;
        for (int it = gt; it < T * 64; it += NGT) { const int t = it >> 6, c8 = (it & 63) * 8, g = c8 >> 7, w = 2 << g, s = t & (SEQ - 1); const int cnt = (s + 1 < w) ? s + 1 : w;
            float acc8[8];
#pragma unroll
            for (int c = 0; c < 8; ++c) acc8[c] = 0.f;
            u32x4 self = *(const u32x4*)(UB + (size_t)t * 512 + c8);
            for (int j = 0; j < cnt; ++j) { const u32x4 v = *(const u32x4*)(UB + (size_t)(t - j) * 512 + c8);
#pragma unroll
                for (int c = 0; c < 4; ++c) { acc8[2 * c] += __builtin_bit_cast(float, v[c] << 16); acc8[2 * c + 1] += __builtin_bit_cast(float, v[c] & 0xffff0000u); } }
            const float ic = 1.0f / (float)cnt; u32x4 o;
#pragma unroll
            for (int c = 0; c < 4; ++c) { const float s0_ = __builtin_bit_cast(float, self[c] << 16), s1_ = __builtin_bit_cast(float, self[c] & 0xffff0000u); o[c] = pk2(acc8[2 * c] * ic - s0_, acc8[2 * c + 1] * ic - s1_); }
            *(u32x4*)(MIXED + (size_t)t * D + 512 + c8) = o; }
    }
    SEAM(2);

    if (IN(3)) {
        KP_FRESH(); unsigned char* ws = KWS();
        pg8::TabOrder S; S.tab = utab; S.list = nullptr; S.nU = pg8::build_units(utab, T / 256, D / 256, F.G, (int)blockIdx.x, nullptr, nullptr);
        pg8::EpiOutProj E{KIN(const float*, 0), KOUT(), (bf16_t*)(ws + WS_HB)};
        pg8::gemm_phase<pg8::EpiOutProj, pg8::TabOrder, 0, false>(F.lds, idxring, (const bf16_t*)(ws + WS_MIXED), (const bf16_t*)(ws + WS_WOUT), S, E);
    }
    SEAM(3);

    if (IN(4)) {
        KP_FRESH(); unsigned char* ws = KWS(); const float* out = KOUT(); const float* b_router = KIN(const float*, 12);
        const float* WR = (const float*)(ws + WS_WR); float* RS2 = (float*)(ws + WS_RS2); float* GATE = (float*)(ws + WS_GATE); int* LIST = (int*)(ws + WS_LIST);
        LAS float* wr = (LAS float*)F.lds;
        for (int i = F.tid; i < D * NE / 4; i += NWAVES * 64) ((LAS f32x4*)wr)[i] = ((const f32x4*)WR)[i];
        LAS int* hist = (LAS int*)(F.lds + L_RH); LAS int* hbase = hist + 32;
        LAS float* lg = (LAS float*)(F.lds + L_RSCR + F.wave * 2112);
        const int r32 = F.lane & 31, hh = F.lane >> 5;
        for (int blk = blockIdx.x; blk < T / 256; blk += F.G) {
            if (F.tid < 32) hist[F.tid] = 0;
            __syncthreads();
            const int tok0 = blk * 256 + F.wave * 32;
            const float* hrow = out + (size_t)(tok0 + r32) * D + 512 * hh;
            f32x16 acc = {}; float ss = 0.f;
#pragma unroll 2
            for (int it = 0; it < 32; ++it) {
                f32x4 a[4];
#pragma unroll
                for (int q = 0; q < 4; ++q) a[q] = *(const f32x4*)(hrow + 16 * it + 4 * q);
#pragma unroll
                for (int q = 0; q < 4; ++q)
#pragma unroll
                    for (int c = 0; c < 4; ++c) { const float av = a[q][c]; ss += av * av; const float bv = wr[(512 * hh + 16 * it + 4 * q + c) * 32 + r32]; acc = __builtin_amdgcn_mfma_f32_32x32x2f32(av, bv, acc, 0, 0, 0); }
            }
            ss += __shfl_xor(ss, 32);
            const float rs = 1.0f / sqrtf(ss * (1.0f / D) + NORM_EPS);
            const int tok = tok0 + r32;
            if (hh == 0) RS2[tok] = rs;
            int sel[4]; float gv[4]; int lpos[4];
#pragma unroll
            for (int pass = 0; pass < 2; ++pass) {
#pragma unroll
                for (int r = 0; r < 8; ++r) { const int rr = 8 * pass + r; const int i = crow(rr, hh) - 16 * pass; lg[i * 33 + r32] = acc[rr]; }
                LDS_WAIT(); asm volatile("" ::: "memory");
                if ((r32 >> 4) == pass && hh == 0) {
                    const int i = r32 & 15; float v[32];
#pragma unroll
                    for (int e = 0; e < 32; ++e) v[e] = lg[i * 33 + e] * rs + b_router[e];
                    unsigned taken = 0u;
#pragma unroll
                    for (int k = 0; k < 4; ++k) { float best = -INFINITY; int bi = 0;
#pragma unroll
                        for (int e = 0; e < 32; ++e) { const bool ok = !((taken >> e) & 1u) && v[e] > best; best = ok ? v[e] : best; bi = ok ? e : bi; }
                        taken |= 1u << bi; sel[k] = bi; gv[k] = best; }
                    const float e1 = __expf(gv[1] - gv[0]), e2 = __expf(gv[2] - gv[0]), e3 = __expf(gv[3] - gv[0]); const float inv = 1.0f / (1.0f + e1 + e2 + e3);
                    gv[0] = inv; gv[1] = e1 * inv; gv[2] = e2 * inv; gv[3] = e3 * inv;
#pragma unroll
                    for (int k = 0; k < 4; ++k) lpos[k] = __hip_atomic_fetch_add(&hist[sel[k]], 1, __ATOMIC_RELAXED, __HIP_MEMORY_SCOPE_WORKGROUP);
                }
                LDS_WAIT(); asm volatile("" ::: "memory");
            }
            __syncthreads();
            const int half = (blk * 256 >= THALF) ? 1 : 0;
            if (F.tid < 32) hbase[F.tid] = (int)__hip_atomic_fetch_add((unsigned*)(ctl + CW_CNT + half * 32 + F.tid), (unsigned)hist[F.tid], RLX_AGENT);
            __syncthreads();
            if (hh == 0) {
#pragma unroll
                for (int k = 0; k < 4; ++k) { const int aid = tok * 4 + k; GATE[aid] = gv[k]; LIST[(size_t)(half * NE + sel[k]) * LIST_CAP + hbase[sel[k]] + lpos[k]] = aid; }
            }
            __syncthreads();
        }
    }
    SEAM(4);

#pragma unroll 1
    for (int half = 0; half < 2; ++half) {
        const int pb = 5 + 3 * half;
        LAS int* cntl = (LAS int*)(F.lds + L_CNT); LAS int* tinfo = (LAS int*)(F.lds + L_TINFO); LAS int* pref = (LAS int*)(F.lds + L_PREF);
        int nMt = 0;
        if (IN(pb) || IN(pb + 1)) {
            __syncthreads();
            if (F.tid < 32) cntl[F.tid] = (int)__hip_atomic_load((unsigned*)(ctl + CW_CNT + half * 32 + F.tid), RLX_AGENT);
            __syncthreads();
            if (F.tid == 0) { int a = 0; for (int e = 0; e < 32; ++e) { pref[e] = a; a += (cntl[e] + 255) >> 8; } pref[32] = a; }
            __syncthreads();
            nMt = pref[32];
            for (int e = 0; e < 32; ++e) { const int p0 = pref[e], n = pref[e + 1] - p0; for (int j = F.tid; j < n; j += NWAVES * 64) tinfo[p0 + j] = e | (j << 8); }
            __syncthreads();
        }
        if (IN(pb)) {
            KP_FRESH(); unsigned char* ws = KWS();
            pg8::TabOrder S; S.tab = utab; S.list = (const int*)(ws + WS_LIST) + (size_t)half * NE * LIST_CAP; S.nU = pg8::build_units(utab, nMt, 8, F.G, (int)blockIdx.x, tinfo, cntl);
            pg8::EpiGU E{(bf16_t*)(ws + WS_ACT), (const float*)(ws + WS_RS2), KIN(const float*, 14)};
            pg8::gemm_phase<pg8::EpiGU, pg8::TabOrder, 1, true>(F.lds, idxring, (const bf16_t*)(ws + WS_HB), (const bf16_t*)(ws + WS_WGU), S, E);
        }
        SEAM(pb);
        if (IN(pb + 1)) {
            KP_FRESH(); unsigned char* ws = KWS();
            pg8::TabOrder S; S.tab = utab; S.list = (const int*)(ws + WS_LIST) + (size_t)half * NE * LIST_CAP; S.nU = pg8::build_units(utab, nMt, 4, F.G, (int)blockIdx.x, tinfo, cntl);
            pg8::EpiDown E{(bf16_t*)(ws + WS_Y), (const float*)(ws + WS_GATE), KIN(const float*, 16), half * THALF * 4};
            pg8::gemm_phase<pg8::EpiDown, pg8::TabOrder, 0, true>(F.lds, idxring, (const bf16_t*)(ws + WS_ACT), (const bf16_t*)(ws + WS_WDN), S, E);
        }
        SEAM(pb + 1);
        if (IN(pb + 2)) {
            KP_FRESH(); float* out = KOUT(); const bf16_t* YB = (const bf16_t*)(KWS() + WS_Y);
            const int gt = blockIdx.x * (NWAVES * 64) + F.tid, NGT = F.G * NWAVES * 64;
            for (int it = gt; it < THALF * 128; it += NGT) { const int tl = it >> 7, c8 = (it & 127) * 8; const size_t o = (size_t)(half * THALF + tl) * D + c8;
                f32x4 h0 = *(const f32x4*)(out + o), h1 = *(const f32x4*)(out + o + 4);
#pragma unroll
                for (int k = 0; k < 4; ++k) { const u32x4 v = *(const u32x4*)(YB + (size_t)(tl * 4 + k) * D + c8);
                    h0[0] += __builtin_bit_cast(float, v[0] << 16); h0[1] += __builtin_bit_cast(float, v[0] & 0xffff0000u); h0[2] += __builtin_bit_cast(float, v[1] << 16); h0[3] += __builtin_bit_cast(float, v[1] & 0xffff0000u);
                    h1[0] += __builtin_bit_cast(float, v[2] << 16); h1[1] += __builtin_bit_cast(float, v[2] & 0xffff0000u); h1[2] += __builtin_bit_cast(float, v[3] << 16); h1[3] += __builtin_bit_cast(float, v[3] & 0xffff0000u); }
                *(f32x4*)(out + o) = h0; *(f32x4*)(out + o + 4) = h1; }
        }
        if (half == 0) SEAM(pb + 2);
    }
#undef IN
#undef SEAM
}

extern "C" void kernel_launch(void* const* d_in, const int* in_sizes, int n_in, void* d_out, int out_size, void* d_ws, size_t ws_size, hipStream_t stream) {
    static int grid = 0;
    if (grid == 0) {
        if (n_in != 17 || out_size != T * D || ws_size < WS_END) { fprintf(stderr, "kernel_launch: unexpected shapes (n_in %d out %d ws %zu)\n", n_in, out_size, ws_size); grid = -1; return; }
        int dev = 0, cus = 0, per_cu = 0;
        if (hipGetDevice(&dev) != hipSuccess || hipDeviceGetAttribute(&cus, hipDeviceAttributeMultiprocessorCount, dev) != hipSuccess) { grid = -1; return; }
        if (hipFuncSetAttribute((const void*)hymba_fwd, hipFuncAttributeMaxDynamicSharedMemorySize, LDS_BYTES) != hipSuccess) { fprintf(stderr, "kernel_launch: hipFuncSetAttribute failed\n"); grid = -1; return; }
        if (hipOccupancyMaxActiveBlocksPerMultiprocessor(&per_cu, (const void*)hymba_fwd, NWAVES * 64, LDS_BYTES) != hipSuccess || per_cu < 1) { fprintf(stderr, "kernel_launch: occupancy query says %d\n", per_cu); }
        (void)hipGetLastError();
        grid = cus;
    }
    if (grid < 0) return;
    (void)hipMemsetAsync((char*)d_ws + WS_CTL, 0, CTL_ZERO_BYTES, stream);
    Args a{};
    for (int i = 0; i < 17; ++i) a.in[i] = d_in[i];
    a.out = (float*)d_out; a.ws = (unsigned char*)d_ws;
    for (int p = 0; p < 8; ++p) a.invf[p] = (float)pow(500000.0, -(double)p / 8.0);
    if (N_LAUNCHES == 1) { a.ph_lo = 0; a.ph_hi = NPH; hipLaunchKernelGGL(hymba_fwd, dim3(grid), dim3(NWAVES * 64), LDS_BYTES, stream, a); }
    else for (int li = 0; li < NPH; ++li) { a.ph_lo = li; a.ph_hi = li + 1; hipLaunchKernelGGL(hymba_fwd, dim3(grid), dim3(NWAVES * 64), LDS_BYTES, stream, a); }
}
```

```cpp
#include <hip/hip_runtime.h>
#include <cstdio>
#include <cstdint>
#include <cmath>

#ifndef MK_N_LAUNCHES
#define MK_N_LAUNCHES 1
#endif

#define LAS __attribute__((address_space(3)))
#define GAS __attribute__((address_space(1)))
typedef unsigned short bf16_t;
typedef short bf16x8 __attribute__((ext_vector_type(8)));
typedef short s16x4 __attribute__((ext_vector_type(4)));
typedef float f32x4 __attribute__((ext_vector_type(4)));
typedef float f32x2 __attribute__((ext_vector_type(2)));
typedef float f32x16 __attribute__((ext_vector_type(16)));
typedef unsigned u32x4 __attribute__((ext_vector_type(4)));
typedef unsigned u32x2 __attribute__((ext_vector_type(2)));
typedef GAS unsigned gu32;
typedef int v4i32 __attribute__((ext_vector_type(4)));
typedef int v8i32 __attribute__((ext_vector_type(8)));

constexpr int NB = 16, SEQ = 4096, T = NB * SEQ, D = 1024, NIN = 1280, NE = 32, FF = 1024;
constexpr int LIST_CAP = T;
constexpr float NORM_EPS = 1e-5f, QK_EPS = 1e-6f;
constexpr float LOG2E = 1.4426950408889634f;
constexpr float C2 = 0.125f * LOG2E;
constexpr int NWAVES = 8;
constexpr int NPH = 8;
constexpr int N_LAUNCHES = MK_N_LAUNCHES;
constexpr float W8_SCALE = 64.0f;
constexpr int SCALE_ONE = 0x7F7F7F7F, SCALE_W = 0x79797979;

constexpr size_t MiB = 1u << 20;
constexpr size_t WS_CTL = 0, CTL_ZERO_BYTES = 1 * MiB;
constexpr size_t WS_WIN = 1 * MiB;
constexpr size_t WS_WOUT = 4 * MiB;
constexpr size_t WS_WR = 6 * MiB;
constexpr size_t WS_ROPE = 7 * MiB;
constexpr size_t WS_RS1 = 11 * MiB;
constexpr size_t WS_RS2 = 11 * MiB + 512 * 1024;
constexpr size_t WS_GATE = 12 * MiB;
constexpr size_t WS_LIST = 13 * MiB;
constexpr size_t WS_WGU = 22 * MiB;
constexpr size_t WS_WDN = 86 * MiB;
constexpr size_t WS_H8 = 118 * MiB;
constexpr size_t WS_UB = 182 * MiB;
constexpr size_t WS_MIXED = 246 * MiB;
constexpr size_t WS_ACT = 182 * MiB;
constexpr size_t WS_Y = 446 * MiB;
constexpr size_t WS_END = 958 * MiB;
constexpr int ACT_SLOTS = T * 4 + NE * 256;
static_assert(WS_ACT + (size_t)ACT_SLOTS * 1024 <= WS_Y, "act");
constexpr size_t DO_XB = 0, DO_QB = 128 * MiB, DO_KB = 192 * MiB, DO_VB = 208 * MiB;
constexpr int CW_CNT = 64;
constexpr int CW_BAR = 4096;

constexpr int RING_BYTES = 131072;
constexpr int L_MISC = RING_BYTES;
constexpr int L_CNT = RING_BYTES + 512;
constexpr int L_PREF = RING_BYTES + 640;
constexpr int L_IDX = RING_BYTES + 1024;
constexpr int L_TINFO = RING_BYTES + 4096;
constexpr int L_RSCR = RING_BYTES + 8704;
constexpr int L_RH = RING_BYTES + 25600;
constexpr int L_UTAB = RING_BYTES + 26624;
constexpr int LDS_BYTES = RING_BYTES + 27648;

#define RLX_AGENT __ATOMIC_RELAXED, __HIP_MEMORY_SCOPE_AGENT
#define LDS_WAIT() asm volatile("s_waitcnt lgkmcnt(0)" ::: "memory")
#define VM_WAIT() asm volatile("s_waitcnt vmcnt(0)" ::: "memory")

__device__ __forceinline__ unsigned f2bf(float f) { unsigned u = __builtin_bit_cast(unsigned, f); return (u + 0x7fffu + ((u >> 16) & 1u)) >> 16; }
__device__ __forceinline__ unsigned pk2(float lo, float hi) { return f2bf(lo) | (f2bf(hi) << 16); }
__device__ __forceinline__ unsigned cvt_pk_bf16(float lo, float hi) { unsigned r; asm volatile("v_cvt_pk_bf16_f32 %0, %1, %2" : "=v"(r) : "v"(lo), "v"(hi)); return r; }
__device__ __forceinline__ unsigned pk4_fp8(float a, float b, float c, float d) { unsigned w = 0; w = __builtin_amdgcn_cvt_pk_fp8_f32(a, b, w, false); w = __builtin_amdgcn_cvt_pk_fp8_f32(c, d, w, true); return w; }
__device__ __forceinline__ float bf2f(unsigned short b) { return __builtin_bit_cast(float, (unsigned)b << 16); }

#define XB_TMO      128
#define XB_XCNT(j)  (256  + 64 * (j))
#define XB_XSUB(j)  (1280 + 64 * (j))
#define XB_XGEN(j)  (2304 + 64 * (j))
#define XB_TOP      3328
#define XB_TOPGEN   3392
#define XCD_BAR_WORDS 3456
#define XB_SPIN_CAP (1u << 23)
__device__ __forceinline__ unsigned xb_ld(unsigned* p)              { return __hip_atomic_load(p, __ATOMIC_RELAXED, __HIP_MEMORY_SCOPE_AGENT); }
__device__ __forceinline__ unsigned xb_add(unsigned* p, unsigned v) { return __hip_atomic_fetch_add(p, v, __ATOMIC_RELAXED, __HIP_MEMORY_SCOPE_AGENT); }
__device__ __forceinline__ unsigned xb_xcc_id() { return (unsigned)__builtin_amdgcn_s_getreg((3 << 11) | 20) & 0xFu; }
#define XB_SPIN(cond, bar) do { unsigned _sp = 0; while (cond) { __builtin_amdgcn_s_sleep(1); \
    if ((++_sp & 255u) == 0u) { if (xb_ld(&(bar)[XB_TMO])) break; if (_sp > XB_SPIN_CAP) { atomicAdd(&(bar)[XB_TMO], 1u); break; } } } } while (0)
struct XcdBarrier { unsigned* bar; unsigned x; volatile LAS unsigned* st; };
__device__ __forceinline__ XcdBarrier xcd_barrier_post(unsigned* bar, volatile LAS unsigned* st) {
    XcdBarrier b; b.bar = bar; b.x = xb_xcc_id(); b.st = st;
    if (threadIdx.x == 0) (void)xb_add(&bar[XB_XCNT(b.x)], 1u);
    return b;
}
__device__ __forceinline__ void xcd_barrier_complete(unsigned* bar, unsigned x, unsigned& nloc, unsigned& nx) {
    const unsigned G = gridDim.x * gridDim.y * gridDim.z;
    unsigned sum, cnt, mine, sp = 0u;
    for (;;) {
        sum = 0u; cnt = 0u; mine = 0u;
#pragma unroll
        for (unsigned j = 0; j < 16; ++j) { const unsigned c = xb_ld(&bar[XB_XCNT(j)]); sum += c; cnt += (c > 0u) ? 1u : 0u; mine = (j == x) ? c : mine; }
        if (sum == G) break;
        __builtin_amdgcn_s_sleep(1);
        if ((++sp & 255u) == 0u) { if (xb_ld(&bar[XB_TMO])) break; if (sp > XB_SPIN_CAP) { atomicAdd(&bar[XB_TMO], 1u); break; } }
    }
    nloc = mine > 0u ? mine : 1u; nx = cnt > 0u ? cnt : 1u;
}
__device__ __forceinline__ void xcd_barrier(const XcdBarrier& b) {
    asm volatile("s_waitcnt vmcnt(0)" ::: "memory");
    __syncthreads();
    if (threadIdx.x == 0) {
        unsigned* bar = b.bar;
        __builtin_amdgcn_s_waitcnt(0);
        unsigned nloc = b.st[0], nx = b.st[1];
        if (nloc == 0u) { xcd_barrier_complete(bar, b.x, nloc, nx); b.st[0] = nloc; b.st[1] = nx; }
        const unsigned old = xb_add(&bar[XB_XSUB(b.x)], 1u);
        const unsigned gen = old / nloc;
        if (old + 1u == (gen + 1u) * nloc) {
            __builtin_amdgcn_fence(__ATOMIC_RELEASE, "agent");
            asm volatile("s_waitcnt vmcnt(0)" ::: "memory");
            const unsigned og = xb_add(&bar[XB_TOP], 1u);
            const unsigned tg = og / nx;
            if (og + 1u == (tg + 1u) * nx) xb_add(&bar[XB_TOPGEN], 1u);
            else XB_SPIN(xb_ld(&bar[XB_TOPGEN]) == tg, bar);
            __builtin_amdgcn_fence(__ATOMIC_ACQUIRE, "agent");
            xb_add(&bar[XB_XGEN(b.x)], 1u);
            asm volatile("s_waitcnt vmcnt(0)" ::: "memory");
        } else {
            XB_SPIN(xb_ld(&bar[XB_XGEN(b.x)]) == gen, bar);
            __builtin_amdgcn_fence(__ATOMIC_ACQUIRE, "agent");
            asm volatile("s_waitcnt vmcnt(0)" ::: "memory");
        }
    }
    __syncthreads();
}

namespace pg8 {
constexpr int BM = 256, BK = 64, HALF = 128, HTB = HALF * BK * 2, NXCD = 8, WGM = 8;
__host__ __device__ __forceinline__ int lds_byte(int r, int c) { const int st = (r >> 4) * 2 + (c >> 5), rr = r & 15, cc = c & 31, ob = rr * 64 + cc * 2; return st * 1024 + (ob ^ (((ob >> 9) & 1) << 5)); }
__host__ __device__ __forceinline__ void stage_rc(int b, int& R, int& C) { const int st = b / 1024, sb = b % 1024, swz = sb ^ (((sb >> 9) & 1) << 5); R = (st >> 1) * 16 + swz / 64; C = (st & 1) * 32 + (swz % 64) / 2; }
__host__ __device__ __forceinline__ int perm32(int rho) { const int n = rho >> 4, i = rho & 15; return 8 * (i >> 2) + 4 * n + (i & 3); }

union Frag { v8i32 v; bf16x8 pc[2]; };
struct Unit { int pm, pn, bt, e, j, nvalid; };

__device__ __forceinline__ bool order_tile(int i, int nM, int nN, int G, int c, int& pm, int& pn) {
    const int nwg = nM * nN; const long L = (long)i * G + c; if (L >= nwg) return false;
    int wgid = (int)L; { const int q = nwg / NXCD, r = nwg % NXCD, xcd = wgid % NXCD, off = wgid / NXCD; wgid = (xcd < r ? xcd * (q + 1) : r * (q + 1) + (xcd - r) * q) + off; }
    const int nig = WGM * nN, gid = wgid / nig, fm = gid * WGM, gsz = (nM - fm) < WGM ? (nM - fm) : WGM;
    pm = fm + ((wgid % nig) % gsz); pn = (wgid % nig) / gsz; return true;
}
constexpr int MAX_UNITS = 64;
__device__ __forceinline__ int build_units(LAS int* tab, int nM, int nN, int G, int c, const LAS int* tinfo, const LAS int* cnt) {
    const int nwg = nM * nN; const int nU = (nwg > c) ? (nwg - c + G - 1) / G : 0;
    __syncthreads();
    const int i = threadIdx.x;
    if (i < nU && i < MAX_UNITS) { int pm = 0, pn = 0; order_tile(i, nM, nN, G, c, pm, pn);
        int e = 0, j = 0, nv = 256;
        if (tinfo) { const int ti = tinfo[pm]; e = ti & 255; j = ti >> 8; const int c_ = cnt[e] - 256 * j; nv = c_ < 256 ? c_ : 256; }
        tab[4 * i] = pm; tab[4 * i + 1] = pn; tab[4 * i + 2] = e * nN + pn; tab[4 * i + 3] = e | (j << 8) | (nv << 20); }
    __syncthreads();
    return nU < MAX_UNITS ? nU : MAX_UNITS;
}
struct TabOrder {
    const LAS int* tab; int nU; const int* list;
    __device__ __forceinline__ bool next(int i, Unit& u) const {
        if (i >= nU) return false;
        const int w3 = __builtin_amdgcn_readfirstlane(tab[4 * i + 3]);
        u.pm = __builtin_amdgcn_readfirstlane(tab[4 * i]); u.pn = __builtin_amdgcn_readfirstlane(tab[4 * i + 1]); u.bt = __builtin_amdgcn_readfirstlane(tab[4 * i + 2]);
        u.e = w3 & 255; u.j = (w3 >> 8) & 4095; u.nvalid = w3 >> 20; return true;
    }
    __device__ __forceinline__ const int* idx_src(const Unit& u) const { return list + (size_t)u.e * LIST_CAP + 256 * u.j; }
};

template <class Epi, class Sched, int AMODE, bool HAS_IDX, int K, bool F8, bool ALIGN_EPI = true>
__device__ __forceinline__ void gemm_phase(LAS unsigned char* lds, LAS int* idxring, const void* Ag, const void* Btg, const Sched& S, const Epi& E) {
    const int tid = threadIdx.x, wid = __builtin_amdgcn_readfirstlane(tid >> 6), lane = tid & 63, wr = wid >> 2, wc = wid & 3, fr = lane & 15, fq = lane >> 4;
    const int nt = K / BK;
    unsigned voffB[2];
#pragma unroll
    for (int i = 0; i < 2; ++i) { int R, C; stage_rc(tid * 16 + i * 8192, R, C); const int Rb = Epi::PERM ? ((R & ~31) + perm32(R & 31)) : R; voffB[i] = (unsigned)(Rb * K + C) * 2u; }
    const size_t kstep = (size_t)(BK * 2);
    const size_t hstep = (size_t)HALF * K * 2;
    const size_t tstep = 2 * hstep;
    const unsigned ldsw = (unsigned)wid * 1024u;
    const int aoff = lds_byte(wr * 64 + fr, fq * 8), boff = lds_byte(wc * 32 + fr, fq * 8);
#define PG8_SA(b, h) (((b) * 2 + (h)) * HTB)
#define PG8_SB(b, h) ((4 + (b) * 2 + (h)) * HTB)
#define PG8_STAGE_B(bufoff, gbase) do { _Pragma("unroll") for (int _i = 0; _i < 2; ++_i) \
        __builtin_amdgcn_global_load_lds((const unsigned*)((const char*)(gbase) + voffB[_i]), (LAS unsigned*)(lds + (bufoff) + ldsw + _i * 8192), 16, 0, 0); } while (0)
#define PG8_STAGE_A(bufoff, kb, AO, h) do { _Pragma("unroll") for (int _i = 0; _i < 2; ++_i) \
        __builtin_amdgcn_global_load_lds((const unsigned*)((const char*)Ag + (kb) + (AO)[h][_i]), (LAS unsigned*)(lds + (bufoff) + ldsw + _i * 8192), 16, 0, 0); } while (0)
#define PG8_LDA(dst, b, h) do { _Pragma("unroll") for (int m = 0; m < 4; ++m) _Pragma("unroll") for (int k = 0; k < 2; ++k) dst[m][k] = *(const LAS bf16x8*)(lds + PG8_SA(b, h) + aoff + m * 2048 + k * 1024); } while (0)
#define PG8_LDB(dst, b, h) do { _Pragma("unroll") for (int n = 0; n < 2; ++n) _Pragma("unroll") for (int k = 0; k < 2; ++k) dst[n][k] = *(const LAS bf16x8*)(lds + PG8_SB(b, h) + boff + n * 2048 + k * 1024); } while (0)
#define PG8_MMA(ai, bj, At, Bt) do { __builtin_amdgcn_s_setprio(1); _Pragma("unroll") for (int m = 0; m < 4; ++m) _Pragma("unroll") for (int n = 0; n < 2; ++n) { \
        if constexpr (F8) { \
            const v8i32 bv_ = __builtin_shufflevector(__builtin_bit_cast(v4i32, Bt[n][0]), __builtin_bit_cast(v4i32, Bt[n][1]), 0, 1, 2, 3, 4, 5, 6, 7); \
            const v8i32 av_ = __builtin_shufflevector(__builtin_bit_cast(v4i32, At[m][0]), __builtin_bit_cast(v4i32, At[m][1]), 0, 1, 2, 3, 4, 5, 6, 7); \
            acc[ai][bj][m][n] = __builtin_amdgcn_mfma_scale_f32_16x16x128_f8f6f4(bv_, av_, acc[ai][bj][m][n], 0, 0, 0, SCALE_W, 0, SCALE_ONE); } \
        else { _Pragma("unroll") for (int k = 0; k < 2; ++k) acc[ai][bj][m][n] = __builtin_amdgcn_mfma_f32_16x16x32_bf16(Bt[n][k], At[m][k], acc[ai][bj][m][n], 0, 0, 0); } } \
        __builtin_amdgcn_s_setprio(0); } while (0)
#define PG8_WAIT_V(n) asm volatile("s_waitcnt vmcnt(" #n ")" ::: "memory")
#define PG8_WAIT_L(n) asm volatile("s_waitcnt lgkmcnt(" #n ")" ::: "memory")
#define PG8_BAR __builtin_amdgcn_s_barrier()
#define PG8_SCHED __builtin_amdgcn_sched_barrier(0)
#define PG8_AOFF(dst, U, islot) do { int _t = tid; asm volatile("" : "+v"(_t)); _Pragma("unroll") for (int _i = 0; _i < 2; ++_i) { int _R, _C; stage_rc(_t * 16 + _i * 8192, _R, _C); \
        _Pragma("unroll") for (int _h = 0; _h < 2; ++_h) { \
        int _row; if (AMODE == 0) _row = (U).pm * BM + _h * HALF + _R; else _row = idxring[(islot) * 256 + _h * HALF + _R] >> 2; \
        dst[_h][_i] = ((unsigned)_row * (unsigned)K + (unsigned)_C) * 2u; } } } while (0)
    Unit cur, nxt; int ui = 0, islot = 0;
    if (!S.next(0, cur)) return;
    if (HAS_IDX) {
        if (wid == 0) { __builtin_amdgcn_global_load_lds((const unsigned*)(S.idx_src(cur) + lane * 4), (LAS unsigned*)(idxring), 16, 0, 0); PG8_WAIT_V(0); }
        __syncthreads();
    }
    f32x4 acc[2][2][4][2];
#pragma unroll
    for (int a = 0; a < 2; ++a)
#pragma unroll
        for (int b = 0; b < 2; ++b)
#pragma unroll
            for (int m = 0; m < 4; ++m)
#pragma unroll
                for (int n = 0; n < 2; ++n) acc[a][b][m][n] = (f32x4){0.f, 0.f, 0.f, 0.f};
    bf16x8 At[4][2], B0[2][2], B1[2][2];
    unsigned ao[2][2];
    PG8_AOFF(ao, cur, 0);
    const char* cB = (const char*)Btg + (size_t)cur.bt * tstep;
    PG8_STAGE_B(PG8_SB(0, 0), cB); PG8_STAGE_B(PG8_SB(0, 1), cB + hstep); PG8_STAGE_A(PG8_SA(0, 0), 0, ao, 0); PG8_STAGE_A(PG8_SA(0, 1), 0, ao, 1);
    if (wr == 1) PG8_BAR;
    PG8_WAIT_V(2); PG8_BAR;
    PG8_STAGE_B(PG8_SB(1, 0), cB + kstep); PG8_STAGE_A(PG8_SA(1, 0), kstep, ao, 0); PG8_STAGE_B(PG8_SB(1, 1), cB + hstep + kstep);
    PG8_WAIT_V(6); PG8_BAR;
    for (;;) {
        const bool has_next = S.next(ui + 1, nxt);
        const int nslot = (islot == 2) ? 0 : islot + 1;
        if (HAS_IDX && has_next && wid == 0)
            __builtin_amdgcn_global_load_lds((const unsigned*)(S.idx_src(nxt) + lane * 4), (LAS unsigned*)(idxring + nslot * 256), 16, 0, 0);
        const char* nB = has_next ? (const char*)Btg + (size_t)nxt.bt * tstep : cB;
#pragma unroll 1
        for (int t = 0; t < nt; t += 2) {
            const bool last = (t == nt - 2);
            const size_t k1 = (size_t)(t + 1) * kstep;
            const size_t k2 = last ? 0 : (size_t)(t + 2) * kstep, k3 = k2 + kstep;
            const char* b2 = last ? nB : cB + (size_t)(t + 2) * kstep; const char* b3 = b2 + kstep;
            PG8_LDB(B0, 0, 0); PG8_LDB(B1, 0, 1); PG8_SCHED; PG8_LDA(At, 0, 0); PG8_STAGE_A(PG8_SA(1, 1), k1, ao, 1);
            if (last && has_next) { PG8_AOFF(ao, nxt, nslot); }
            PG8_WAIT_V(8); PG8_WAIT_L(0); PG8_BAR; PG8_MMA(0, 0, At, B0); PG8_MMA(0, 1, At, B1); PG8_BAR; PG8_SCHED;
            PG8_LDA(At, 0, 1); PG8_STAGE_B(PG8_SB(0, 0), b2); PG8_STAGE_B(PG8_SB(0, 1), b2 + hstep); PG8_STAGE_A(PG8_SA(0, 0), k2, ao, 0);
            PG8_WAIT_V(8); PG8_WAIT_L(0); PG8_BAR; PG8_MMA(1, 0, At, B0); PG8_MMA(1, 1, At, B1); PG8_BAR; PG8_SCHED;
            PG8_LDB(B0, 1, 0); PG8_LDB(B1, 1, 1); PG8_SCHED; PG8_LDA(At, 1, 0); PG8_STAGE_A(PG8_SA(0, 1), k2, ao, 1);
            PG8_WAIT_V(8); PG8_WAIT_L(0); PG8_BAR; PG8_MMA(0, 0, At, B0); PG8_MMA(0, 1, At, B1); PG8_BAR; PG8_SCHED;
            PG8_LDA(At, 1, 1); PG8_STAGE_B(PG8_SB(1, 0), b3); PG8_STAGE_B(PG8_SB(1, 1), b3 + hstep); PG8_STAGE_A(PG8_SA(1, 0), k3, ao, 0);
            PG8_WAIT_V(8); PG8_WAIT_L(0); PG8_BAR; PG8_MMA(1, 0, At, B0); PG8_MMA(1, 1, At, B1); PG8_BAR; PG8_SCHED;
        }
        if (ALIGN_EPI) { if (wr == 0) PG8_BAR; }
        E(acc, cur, wr, wc, fr, fq, (const LAS int*)(idxring + islot * 256));
        if (!has_next) break;
#pragma unroll
        for (int a = 0; a < 2; ++a)
#pragma unroll
            for (int b = 0; b < 2; ++b)
#pragma unroll
                for (int m = 0; m < 4; ++m)
#pragma unroll
                    for (int n = 0; n < 2; ++n) acc[a][b][m][n] = (f32x4){0.f, 0.f, 0.f, 0.f};
        cur = nxt; cB = nB; ++ui; islot = nslot;
        if (ALIGN_EPI) { if (wr == 1) PG8_BAR; }
    }
    PG8_WAIT_V(0);
    if (!ALIGN_EPI) { if (wr == 0) PG8_BAR; }
    PG8_BAR;
#undef PG8_SA
#undef PG8_SB
#undef PG8_STAGE_A
#undef PG8_STAGE_B
#undef PG8_LDA
#undef PG8_LDB
#undef PG8_MMA
#undef PG8_WAIT_V
#undef PG8_WAIT_L
#undef PG8_BAR
#undef PG8_SCHED
#undef PG8_AOFF
}

__device__ __forceinline__ u32x4 pack8(const f32x4 a, const f32x4 b) { u32x4 w; w.x = cvt_pk_bf16(a[0], a[1]); w.y = cvt_pk_bf16(a[2], a[3]); w.z = cvt_pk_bf16(b[0], b[1]); w.w = cvt_pk_bf16(b[2], b[3]); return w; }

struct EpiInProj {
    static constexpr bool PERM = true;
    bf16_t *Q, *Kb, *Vb, *U; const float *rs1, *rope, *qw, *kw;
    __device__ __forceinline__ void operator()(const f32x4 (&acc)[2][2][4][2], const Unit& u, int wr, int wc, int fr, int fq, const LAS int*) const {
        const int row0 = u.pm * BM + wr * 64 + fr;
        if (u.pn >= 3) {
#pragma unroll
            for (int ai = 0; ai < 2; ++ai)
#pragma unroll
                for (int m = 0; m < 4; ++m) { const int row = row0 + ai * HALF + m * 16; const float s = rs1[row];
                    bf16_t* rp = U + (size_t)row * 512 + (u.pn - 3) * 256 + wc * 32 + 8 * fq;
#pragma unroll
                    for (int bj = 0; bj < 2; ++bj) *(u32x4*)(rp + bj * HALF) = pack8(acc[ai][bj][m][0] * s, acc[ai][bj][m][1] * s); }
            return;
        }
        const bool isv = (u.pn == 2 && wc >= 2);
        bf16_t* dst; int ld; const float* w; float post;
        if (u.pn < 2) { dst = Q + (4 * u.pn + wc) * 64; ld = 512; w = qw; post = C2; }
        else if (wc < 2) { dst = Kb + wc * 64; ld = 128; w = kw; post = 1.f; }
        else { dst = Vb + (wc - 2) * 64; ld = 128; w = qw; post = 1.f; }
        f32x4 wv[2][2];
#pragma unroll
        for (int bj = 0; bj < 2; ++bj)
#pragma unroll
            for (int n = 0; n < 2; ++n) wv[bj][n] = *(const f32x4*)(w + 32 * bj + 8 * fq + 4 * n);
#pragma unroll
        for (int ai = 0; ai < 2; ++ai)
#pragma unroll
            for (int m = 0; m < 4; ++m) {
                const int row = row0 + ai * HALF + m * 16; const float s = rs1[row];
                f32x4 x[2][2];
#pragma unroll
                for (int bj = 0; bj < 2; ++bj)
#pragma unroll
                    for (int n = 0; n < 2; ++n) x[bj][n] = acc[ai][bj][m][n] * s;
                if (!isv) {
                    float ss = 0.f;
#pragma unroll
                    for (int bj = 0; bj < 2; ++bj)
#pragma unroll
                        for (int n = 0; n < 2; ++n) ss += (x[bj][n][0] * x[bj][n][0] + x[bj][n][1] * x[bj][n][1]) + (x[bj][n][2] * x[bj][n][2] + x[bj][n][3] * x[bj][n][3]);
                    ss += __shfl_xor(ss, 16); ss += __shfl_xor(ss, 32);
                    const float rn = 1.0f / sqrtf(ss * (1.0f / 64.0f) + QK_EPS);
#pragma unroll
                    for (int bj = 0; bj < 2; ++bj)
#pragma unroll
                        for (int n = 0; n < 2; ++n) x[bj][n] = x[bj][n] * rn * wv[bj][n];
                    const float* rp = rope + (size_t)row * 16;
#pragma unroll
                    for (int n = 0; n < 2; ++n) {
                        const f32x4 cs = *(const f32x4*)(rp + 4 * n), sn = *(const f32x4*)(rp + 8 + 4 * n);
                        f32x4 pr;
#pragma unroll
                        for (int c = 0; c < 4; ++c) pr[c] = __shfl_xor(x[0][n][c], 16);
                        const f32x4 r0 = x[0][n] * cs - pr * sn, r1 = x[0][n] * cs + pr * sn;
                        if (fq == 0) x[0][n] = r0; else if (fq == 1) x[0][n] = r1;
                    }
#pragma unroll
                    for (int bj = 0; bj < 2; ++bj)
#pragma unroll
                        for (int n = 0; n < 2; ++n) x[bj][n] = x[bj][n] * post;
                }
                bf16_t* op = dst + (size_t)row * ld + 8 * fq;
#pragma unroll
                for (int bj = 0; bj < 2; ++bj) *(u32x4*)(op + 32 * bj) = pack8(x[bj][0], x[bj][1]);
            }
    }
};
struct EpiOutProj {
    static constexpr bool PERM = true;
    const float* x; float* out; unsigned char* h8;
    __device__ __forceinline__ void operator()(const f32x4 (&acc)[2][2][4][2], const Unit& u, int wr, int wc, int fr, int fq, const LAS int*) const {
        const int row0 = u.pm * BM + wr * 64 + fr, col0 = u.pn * BM + wc * 32 + 8 * fq;
#pragma unroll
        for (int ai = 0; ai < 2; ++ai)
#pragma unroll
            for (int m = 0; m < 4; ++m) { const size_t off = (size_t)(row0 + ai * HALF + m * 16) * D + col0;
#pragma unroll
                for (int bj = 0; bj < 2; ++bj) { const f32x4 h0 = *(const f32x4*)(x + off + bj * HALF) + acc[ai][bj][m][0], h1 = *(const f32x4*)(x + off + bj * HALF + 4) + acc[ai][bj][m][1];
                    *(f32x4*)(out + off + bj * HALF) = h0; *(f32x4*)(out + off + bj * HALF + 4) = h1;
                    u32x2 w; w.x = pk4_fp8(h0[0], h0[1], h0[2], h0[3]); w.y = pk4_fp8(h1[0], h1[1], h1[2], h1[3]); *(u32x2*)(h8 + off + bj * HALF) = w; } }
    }
};
struct EpiGU {
    static constexpr bool PERM = true;
    unsigned char* act; const float* rs2; const float* bgu;
    __device__ __forceinline__ void operator()(const f32x4 (&acc)[2][2][4][2], const Unit& u, int wr, int wc, int fr, int fq, const LAS int* idx) const {
        const int r0 = wr * 64 + fr, c0 = u.pn * 128 + wc * 32 + 8 * fq;
        const float* bp = bgu + (size_t)u.e * 2048 + c0;
        const f32x4 bg0 = *(const f32x4*)(bp), bg1 = *(const f32x4*)(bp + 4), bu0 = *(const f32x4*)(bp + 1024), bu1 = *(const f32x4*)(bp + 1028);
#pragma unroll
        for (int ai = 0; ai < 2; ++ai)
#pragma unroll
            for (int m = 0; m < 4; ++m) { const int r = r0 + ai * HALF + m * 16; const float s = rs2[idx[r] >> 2];
                f32x4 a[2];
#pragma unroll
                for (int n = 0; n < 2; ++n) { const f32x4 g = acc[ai][0][m][n] * s + (n ? bg1 : bg0), uu = acc[ai][1][m][n] * s + (n ? bu1 : bu0);
#pragma unroll
                    for (int c = 0; c < 4; ++c) { const float gc = fminf(g[c], 7.0f), uc = fminf(fmaxf(uu[c], -7.0f), 7.0f);
                        const float sg = __builtin_amdgcn_rcpf(1.0f + __builtin_amdgcn_exp2f(gc * (-1.702f * LOG2E))); a[n][c] = gc * sg * (uc + 1.0f); } }
                u32x2 w; w.x = pk4_fp8(a[0][0], a[0][1], a[0][2], a[0][3]); w.y = pk4_fp8(a[1][0], a[1][1], a[1][2], a[1][3]); *(u32x2*)(act + (size_t)(u.pm * BM + r) * FF + c0) = w; }
    }
};
struct EpiDown {
    static constexpr bool PERM = true;
    bf16_t* y; const float* gate; const float* bdn;
    __device__ __forceinline__ void operator()(const f32x4 (&acc)[2][2][4][2], const Unit& u, int wr, int wc, int fr, int fq, const LAS int* idx) const {
        const int r0 = wr * 64 + fr, c0 = u.pn * BM + wc * 32 + 8 * fq;
        const float* bp = bdn + (size_t)u.e * D + c0;
        f32x4 bv[2][2];
#pragma unroll
        for (int bj = 0; bj < 2; ++bj)
#pragma unroll
            for (int n = 0; n < 2; ++n) bv[bj][n] = *(const f32x4*)(bp + bj * HALF + 4 * n);
#pragma unroll
        for (int ai = 0; ai < 2; ++ai)
#pragma unroll
            for (int m = 0; m < 4; ++m) { const int r = r0 + ai * HALF + m * 16;
                if (r < u.nvalid) { const int aid = idx[r]; const float g = gate[aid]; bf16_t* yp = y + (size_t)aid * D + c0;
#pragma unroll
                    for (int bj = 0; bj < 2; ++bj) *(u32x4*)(yp + bj * HALF) = pack8((acc[ai][bj][m][0] + bv[bj][0]) * g, (acc[ai][bj][m][1] + bv[bj][1]) * g); } }
    }
};
}

struct Frame {
    LAS unsigned char* lds;
    int tid, lane, wave, G, gw, NGW;
};

__device__ __forceinline__ float wave_sum(float v) {
#pragma unroll
    for (int o = 1; o < 64; o <<= 1) v += __shfl_xor(v, o);
    return v;
}

__device__ __forceinline__ void p0_transpose_item(const float* W, int ldw, int scol0, int k0, const float* ks, bf16_t* WT, int K, int drow0, LAS float* scr, int lane) {
#pragma unroll 8
    for (int i = 0; i < 32; ++i) { const int kk = 2 * i + (lane >> 5); float v = W[(size_t)(k0 + kk) * ldw + scol0 + (lane & 31)]; if (ks) v *= ks[k0 + kk]; scr[kk * 33 + (lane & 31)] = v; }
    LDS_WAIT(); asm volatile("" ::: "memory");
    const int c = lane & 7;
#pragma unroll
    for (int j = 0; j < 4; ++j) { const int n = (lane >> 3) + 8 * j; const LAS float* s = scr + (8 * c) * 33 + n;
        u32x4 o; o.x = pk2(s[0 * 33], s[1 * 33]); o.y = pk2(s[2 * 33], s[3 * 33]); o.z = pk2(s[4 * 33], s[5 * 33]); o.w = pk2(s[6 * 33], s[7 * 33]);
        *(GAS u32x4*)(WT + (size_t)(drow0 + n) * K + k0 + 8 * c) = o; }
    LDS_WAIT(); asm volatile("" ::: "memory");
}
__device__ __forceinline__ void p0_transpose_item_f8(const float* W, int ldw, int scol0, int k0, const float* ks, float sc, unsigned char* WT, int K, int drow0, LAS float* scr, int lane) {
#pragma unroll 8
    for (int i = 0; i < 32; ++i) { const int kk = 2 * i + (lane >> 5); float v = W[(size_t)(k0 + kk) * ldw + scol0 + (lane & 31)] * sc; if (ks) v *= ks[k0 + kk]; scr[kk * 33 + (lane & 31)] = v; }
    LDS_WAIT(); asm volatile("" ::: "memory");
    const int c = lane & 3;
#pragma unroll
    for (int j = 0; j < 2; ++j) { const int n = (lane >> 2) + 16 * j; const LAS float* s = scr + (16 * c) * 33 + n;
        u32x4 o; o.x = pk4_fp8(s[0 * 33], s[1 * 33], s[2 * 33], s[3 * 33]); o.y = pk4_fp8(s[4 * 33], s[5 * 33], s[6 * 33], s[7 * 33]);
        o.z = pk4_fp8(s[8 * 33], s[9 * 33], s[10 * 33], s[11 * 33]); o.w = pk4_fp8(s[12 * 33], s[13 * 33], s[14 * 33], s[15 * 33]);
        *(GAS u32x4*)(WT + (size_t)(drow0 + n) * K + k0 + 16 * c) = o; }
    LDS_WAIT(); asm volatile("" ::: "memory");
}
__device__ __forceinline__ int win_src(int rho0) {
    const int pn = rho0 >> 8, within = rho0 & 255, bj = within >> 7, wc = (within & 127) >> 5;
    if (pn < 2) return 64 * (4 * pn + wc) + 32 * bj;
    if (pn == 2) return 512 + 64 * wc + 32 * bj;
    return rho0;
}

struct Args { const void* in[17]; float* out; unsigned char* ws; int ph_lo, ph_hi; float invf[8]; };

__device__ __forceinline__ int crow(int r, int hi) { return (r & 3) + 8 * (r >> 2) + 4 * hi; }
typedef short v4i16_t __attribute__((ext_vector_type(4)));
__device__ __forceinline__ s16x4 vtr(const LAS unsigned char* p) { return __builtin_bit_cast(s16x4, __builtin_amdgcn_ds_read_tr16_b64_v4i16((LAS v4i16_t*)p)); }

__device__ __forceinline__ void attn_unit(const Frame& F, int b, int kvh, int qblk, const bf16_t* Q, const bf16_t* Kb, const bf16_t* Vb, bf16_t* O, const float* sinks) {
    const int lane = F.lane, wid = F.wave, r32 = lane & 31, hi = lane >> 5;
    LAS unsigned char* lds = F.lds;
    const int s0 = qblk * 128; const long rowq0 = (long)b * SEQ + s0;
    {
        u32x4 kv[4], vv[4];
#pragma unroll
        for (int jt = 0; jt < 4; ++jt) {
            long rt = (long)b * SEQ + s0 - 128 + 64 * jt; if (qblk == 0 && jt < 2) rt = (long)b * SEQ;
            kv[jt] = *(const u32x4*)(Kb + (rt + lane) * 128 + kvh * 64 + wid * 8);
            vv[jt] = *(const u32x4*)(Vb + (rt + 16 * (wid & 3) + (lane >> 2)) * 128 + kvh * 64 + (wid >> 2) * 32 + (lane & 3) * 8);
        }
#pragma unroll
        for (int jt = 0; jt < 4; ++jt) { *(LAS u32x4*)(lds + jt * 8192 + wid * 1024 + lane * 16) = kv[jt]; *(LAS u32x4*)(lds + 32768 + jt * 8192 + wid * 1024 + lane * 16) = vv[jt]; }
    }
    __syncthreads();
    const int g = wid >> 1, rh = wid & 1, head = kvh * 4 + g, t0 = rh;
    const float sinkl = sinks[head] * LOG2E;
    LAS bf16_t* stg = (LAS bf16_t*)(lds + 65536) + wid * 2048;
    const int vboff = ((lane >> 4) & 1) * 32 + (lane & 3) * 8 + (4 * hi + ((lane & 15) >> 2)) * 64;
#pragma unroll 1
    for (int s = 0; s < 2; ++s) {
        const int q0 = 64 * rh + 32 * s;
        const bf16_t* Qw = Q + (size_t)(rowq0 + q0 + r32) * 512 + head * 64 + hi * 8;
        bf16x8 qr[4];
#pragma unroll
        for (int d0 = 0; d0 < 4; ++d0) qr[d0] = *(const bf16x8*)(Qw + d0 * 16);
        const int qi = q0 + r32; const int klo = (qblk == 0) ? (qi > 127 ? qi : 127) : qi;
        float mrun = sinkl, l = 1.0f;
        f32x16 o[2]; o[0] = f32x16{}; o[1] = f32x16{};
#pragma unroll 1
        for (int jt = 0; jt < 3; ++jt) {
            const LAS unsigned char* kb = lds + (t0 + jt) * 8192 + hi * 1024 + r32 * 16;
            f32x16 p0 = {}, p1 = {};
#pragma unroll
            for (int d0 = 0; d0 < 4; ++d0) {
                const bf16x8 k0 = *(const LAS bf16x8*)(kb + d0 * 2048), k1 = *(const LAS bf16x8*)(kb + d0 * 2048 + 512);
                p0 = __builtin_amdgcn_mfma_f32_32x32x16_bf16(k0, qr[d0], p0, 0, 0, 0);
                p1 = __builtin_amdgcn_mfma_f32_32x32x16_bf16(k1, qr[d0], p1, 0, 0, 0);
            }
            float mx = mrun; const int kbase = 64 * (t0 + jt);
#pragma unroll
            for (int r = 0; r < 16; ++r) { const int kj = kbase + crow(r, hi);
                const bool ok0 = (kj > klo) && (kj <= qi + 128), ok1 = (kj + 32 > klo) && (kj + 32 <= qi + 128);
                p0[r] = ok0 ? p0[r] : -INFINITY; p1[r] = ok1 ? p1[r] : -INFINITY; mx = fmaxf(mx, fmaxf(p0[r], p1[r])); }
            mx = fmaxf(mx, __shfl_xor(mx, 32));
            const float alpha = __builtin_amdgcn_exp2f(mrun - mx); mrun = mx;
            float ls = 0.f;
#pragma unroll
            for (int r = 0; r < 16; ++r) { p0[r] = __builtin_amdgcn_exp2f(p0[r] - mx); p1[r] = __builtin_amdgcn_exp2f(p1[r] - mx); ls += p0[r] + p1[r]; }
            ls += __shfl_xor(ls, 32);
            l = l * alpha + ls;
#pragma unroll
            for (int d0 = 0; d0 < 2; ++d0)
#pragma unroll
                for (int r = 0; r < 16; ++r) o[d0][r] *= alpha;
            const LAS unsigned char* vp = lds + 32768 + (t0 + jt) * 8192 + vboff;
#pragma unroll
            for (int ks = 0; ks < 4; ++ks) {
                const f32x16& P = (ks < 2) ? p0 : p1; const int rb = (ks & 1) * 8;
                u32x4 pw; pw.x = cvt_pk_bf16(P[rb + 0], P[rb + 1]); pw.y = cvt_pk_bf16(P[rb + 2], P[rb + 3]); pw.z = cvt_pk_bf16(P[rb + 4], P[rb + 5]); pw.w = cvt_pk_bf16(P[rb + 6], P[rb + 7]);
                const bf16x8 pb = __builtin_bit_cast(bf16x8, pw);
#pragma unroll
                for (int d0 = 0; d0 < 2; ++d0) {
                    const s16x4 lo = vtr(vp + d0 * 4096 + ks * 1024), hv = vtr(vp + d0 * 4096 + ks * 1024 + 512);
                    const bf16x8 vf = (bf16x8){lo[0], lo[1], lo[2], lo[3], hv[0], hv[1], hv[2], hv[3]};
                    o[d0] = __builtin_amdgcn_mfma_f32_32x32x16_bf16(vf, pb, o[d0], 0, 0, 0);
                }
            }
        }
        const float rl = 1.0f / l;
#pragma unroll
        for (int d0 = 0; d0 < 2; ++d0)
#pragma unroll
            for (int g4 = 0; g4 < 4; ++g4) { u32x2 w; w.x = cvt_pk_bf16(o[d0][4 * g4] * rl, o[d0][4 * g4 + 1] * rl); w.y = cvt_pk_bf16(o[d0][4 * g4 + 2] * rl, o[d0][4 * g4 + 3] * rl);
                *(LAS u32x2*)(stg + r32 * 64 + 32 * d0 + 8 * g4 + 4 * hi) = w; }
        LDS_WAIT();
        bf16_t* Ow = O + (size_t)(rowq0 + q0) * D + head * 64;
#pragma unroll
        for (int i = 0; i < 4; ++i) { const int row = i * 8 + (lane >> 3), ch = lane & 7; const u32x4 v = *(const LAS u32x4*)(stg + row * 64 + ch * 8); *(u32x4*)(Ow + (size_t)row * D + ch * 8) = v; }
        LDS_WAIT();
    }
    __syncthreads();
}

__global__ void __launch_bounds__(NWAVES * 64, 2) hymba_fwd(Args args) {
    extern __shared__ __attribute__((aligned(16))) unsigned char lds_raw[];
    Frame F;
    F.lds = (LAS unsigned char*)lds_raw;
    F.tid = threadIdx.x; F.lane = F.tid & 63; F.wave = __builtin_amdgcn_readfirstlane(F.tid >> 6);
    F.G = gridDim.x; F.gw = blockIdx.x * NWAVES + F.wave; F.NGW = F.G * NWAVES;
    volatile LAS unsigned* MISC = (volatile LAS unsigned*)(F.lds + L_MISC);
#define AS4 __attribute__((address_space(4)))
    const AS4 char* kbase = (const AS4 char*)__builtin_amdgcn_kernarg_segment_ptr();
#define KP_FRESH() const AS4 char* kp = kbase; asm volatile("" : "+s"(kp))
#define KIN(T, i) ((T)(*(const void* const AS4*)(kp + 8 * (i))))
#define KOUT() (*(float* const AS4*)(kp + 136))
#define KWS() (*(unsigned char* const AS4*)(kp + 144))
    gu32* ctl;
    { KP_FRESH(); ctl = (gu32*)(KWS() + WS_CTL); }
    for (int u = F.tid; u < 512 / 4; u += NWAVES * 64) ((LAS unsigned*)(F.lds + L_MISC))[u] = 0u;
    __syncthreads();
    XcdBarrier bar; bar.bar = (unsigned*)(ctl + CW_BAR); bar.x = 0; bar.st = nullptr;
    if (N_LAUNCHES == 1) bar = xcd_barrier_post((unsigned*)(ctl + CW_BAR), MISC + 8);
    int lo, hi; { KP_FRESH(); lo = *(const int AS4*)(kp + 152); hi = *(const int AS4*)(kp + 156); }
#define IN(k) (lo <= (k) && (k) < hi)
#define SEAM(k) do { if (IN(k) && IN((k) + 1)) xcd_barrier(bar); } while (0)
    LAS int* idxring = (LAS int*)(F.lds + L_IDX);
    LAS int* utab = (LAS int*)(F.lds + L_UTAB);

    if (IN(0)) {
        KP_FRESH(); unsigned char* ws = KWS(); float* out = KOUT();
        const float* x = KIN(const float*, 0); const int* positions = KIN(const int*, 1); const float* norm1_w = KIN(const float*, 2); const float* w_in = KIN(const float*, 3);
        const float* pool_w = KIN(const float*, 7); const float* pool_scale = KIN(const float*, 8); const float* w_out = KIN(const float*, 9); const float* norm2_w = KIN(const float*, 10);
        const float* w_router = KIN(const float*, 11); const float* w_gu = KIN(const float*, 13); const float* w_down = KIN(const float*, 15);
        bf16_t* WIN = (bf16_t*)(ws + WS_WIN); bf16_t* WOUT = (bf16_t*)(ws + WS_WOUT); float* WR = (float*)(ws + WS_WR); float* ROPE = (float*)(ws + WS_ROPE);
        float* RS1 = (float*)(ws + WS_RS1); int* LIST = (int*)(ws + WS_LIST); unsigned char* WGU = ws + WS_WGU; unsigned char* WDN = ws + WS_WDN;
        bf16_t* XB = (bf16_t*)((unsigned char*)out + DO_XB);
        LAS float* scr = (LAS float*)(F.lds + F.wave * 16384);
        constexpr int I_IN = 16 * 40, I_OUT = 8 * 32, I_GU = 32 * 16 * 64, I_DN = 32 * 16 * 32, NITEMS = I_IN + I_OUT + I_GU + I_DN;
        for (int it = F.gw; it < NITEMS; it += F.NGW) {
            int r = it;
            if (r < I_IN) { const int kb = r / 40, nb = r % 40; p0_transpose_item(w_in, NIN, win_src(32 * nb), 64 * kb, norm1_w, WIN, D, 32 * nb, scr, F.lane); continue; } r -= I_IN;
            if (r < I_OUT) { const int kb = r / 32, nb = r % 32; p0_transpose_item(w_out, D, 32 * nb, 64 * kb, nullptr, WOUT, D, 32 * nb, scr, F.lane); continue; } r -= I_OUT;
            if (r < I_GU) { const int e = r / 1024, q = r % 1024, kb = q / 64, nb = q % 64; const int rho0 = 32 * nb, pn = rho0 >> 8, rr = rho0 & 255;
                const int sc = (rr < 128) ? 128 * pn + rr : 1024 + 128 * pn + (rr - 128);
                p0_transpose_item_f8(w_gu + (size_t)e * D * 2048, 2048, sc, 64 * kb, norm2_w, W8_SCALE, WGU + (size_t)e * 2048 * D, D, rho0, scr, F.lane); continue; } r -= I_GU;
            { const int e = r / 512, q = r % 512, kb = q / 32, nb = q % 32;
                p0_transpose_item_f8(w_down + (size_t)e * FF * D, D, 32 * nb, 64 * kb, nullptr, W8_SCALE, WDN + (size_t)e * D * FF, FF, 32 * nb, scr, F.lane); }
        }
        for (int m = F.gw; m < T; m += F.NGW) {
            const GAS f32x4* xr = (const GAS f32x4*)(x + (size_t)m * D) + F.lane;
            f32x4 v[4]; float s2 = 0.f;
#pragma unroll
            for (int j = 0; j < 4; ++j) { v[j] = xr[64 * j]; s2 += (v[j].x * v[j].x + v[j].y * v[j].y) + (v[j].z * v[j].z + v[j].w * v[j].w); }
            s2 = wave_sum(s2);
            if (F.lane == 0) RS1[m] = 1.0f / sqrtf(s2 * (1.0f / D) + NORM_EPS);
            GAS unsigned long long* o8 = (GAS unsigned long long*)(XB + (size_t)m * D) + F.lane;
#pragma unroll
            for (int j = 0; j < 4; ++j) o8[64 * j] = (unsigned long long)pk2(v[j].x, v[j].y) | ((unsigned long long)pk2(v[j].z, v[j].w) << 32);
        }
        const int gt = blockIdx.x * (NWAVES * 64) + F.tid, NGT = F.G * NWAVES * 64;
        for (int it = gt; it < 512 * 1024; it += NGT) { const int cp = it >> 10, n = it & 1023, g = cp >> 7;
            const float* pw = pool_w + (size_t)cp * 128; const float* ps = pool_scale + g * 128; const float* wo = w_out + (size_t)(512 + g * 128) * D + n;
            float a = 0.f;
            for (int d = 0; d < 128; ++d) a += pw[d] * ps[d] * wo[(size_t)d * D];
            WOUT[(size_t)n * D + 512 + cp] = (bf16_t)f2bf(a); }
        for (int it = gt; it < D * NE; it += NGT) WR[it] = norm2_w[it >> 5] * w_router[it];
        for (int it = gt; it < T * 8; it += NGT) { const int t = it >> 3, p = it & 7; const float ang = (float)positions[t] * (*(const float AS4*)(kp + 160 + 4 * p)); float sn, cs; sincosf(ang, &sn, &cs); ROPE[(size_t)t * 16 + p] = cs; ROPE[(size_t)t * 16 + 8 + p] = sn; }
        for (int it = gt; it < NE * LIST_CAP / 4; it += NGT) ((u32x4*)LIST)[it] = (u32x4){0u, 0u, 0u, 0u};
    }
    SEAM(0);

    if (IN(1)) {
        KP_FRESH(); unsigned char* ws = KWS(); unsigned char* ob = (unsigned char*)KOUT();
        pg8::TabOrder S; S.tab = utab; S.list = nullptr; S.nU = pg8::build_units(utab, T / 256, NIN / 256, F.G, (int)blockIdx.x, nullptr, nullptr);
        pg8::EpiInProj E{(bf16_t*)(ob + DO_QB), (bf16_t*)(ob + DO_KB), (bf16_t*)(ob + DO_VB), (bf16_t*)(ws + WS_UB), (const float*)(ws + WS_RS1), (const float*)(ws + WS_ROPE), KIN(const float*, 4), KIN(const float*, 5)};
        pg8::gemm_phase<pg8::EpiInProj, pg8::TabOrder, 0, false, 1024, false>(F.lds, idxring, (const bf16_t*)(ob + DO_XB), (const bf16_t*)(ws + WS_WIN), S, E);
    }
    SEAM(1);

    if (IN(2)) {
        KP_FRESH(); unsigned char* ws = KWS(); unsigned char* ob = (unsigned char*)KOUT(); const float* sinks = KIN(const float*, 6);
        const bf16_t* QB = (const bf16_t*)(ob + DO_QB); const bf16_t* KB = (const bf16_t*)(ob + DO_KB); const bf16_t* VB = (const bf16_t*)(ob + DO_VB);
        bf16_t* MIXED = (bf16_t*)(ws + WS_MIXED); const bf16_t* UB = (const bf16_t*)(ws + WS_UB);
        for (int uid = blockIdx.x; uid < NB * 2 * 32; uid += F.G) { const int qblk = uid & 31, kvh = (uid >> 5) & 1, b = uid >> 6; attn_unit(F, b, kvh, qblk, QB, KB, VB, MIXED, sinks); }
        const int gt = blockIdx.x * (NWAVES * 64) + F.tid, NGT = F.G * NWAVES * 64;
        for (int it = gt; it < T * 64; it += NGT) { const int t = it >> 6, c8 = (it & 63) * 8, g = c8 >> 7, w = 2 << g, s = t & (SEQ - 1); const int cnt = (s + 1 < w) ? s + 1 : w;
            float acc8[8];
#pragma unroll
            for (int c = 0; c < 8; ++c) acc8[c] = 0.f;
            u32x4 self = *(const u32x4*)(UB + (size_t)t * 512 + c8);
            for (int j = 0; j < cnt; ++j) { const u32x4 v = *(const u32x4*)(UB + (size_t)(t - j) * 512 + c8);
#pragma unroll
                for (int c = 0; c < 4; ++c) { acc8[2 * c] += __builtin_bit_cast(float, v[c] << 16); acc8[2 * c + 1] += __builtin_bit_cast(float, v[c] & 0xffff0000u); } }
            const float ic = 1.0f / (float)cnt; u32x4 o;
#pragma unroll
            for (int c = 0; c < 4; ++c) { const float s0_ = __builtin_bit_cast(float, self[c] << 16), s1_ = __builtin_bit_cast(float, self[c] & 0xffff0000u); o[c] = pk2(acc8[2 * c] * ic - s0_, acc8[2 * c + 1] * ic - s1_); }
            *(u32x4*)(MIXED + (size_t)t * D + 512 + c8) = o; }
    }
    SEAM(2);

    if (IN(3)) {
        KP_FRESH(); unsigned char* ws = KWS();
        pg8::TabOrder S; S.tab = utab; S.list = nullptr; S.nU = pg8::build_units(utab, T / 256, D / 256, F.G, (int)blockIdx.x, nullptr, nullptr);
        pg8::EpiOutProj E{KIN(const float*, 0), KOUT(), ws + WS_H8};
        pg8::gemm_phase<pg8::EpiOutProj, pg8::TabOrder, 0, false, 1024, false>(F.lds, idxring, (const bf16_t*)(ws + WS_MIXED), (const bf16_t*)(ws + WS_WOUT), S, E);
    }
    SEAM(3);

    if (IN(4)) {
        KP_FRESH(); unsigned char* ws = KWS(); const float* out = KOUT(); const float* b_router = KIN(const float*, 12);
        const float* WR = (const float*)(ws + WS_WR); float* RS2 = (float*)(ws + WS_RS2); float* GATE = (float*)(ws + WS_GATE); int* LIST = (int*)(ws + WS_LIST);
        LAS float* wr = (LAS float*)F.lds;
        for (int i = F.tid; i < D * NE / 4; i += NWAVES * 64) ((LAS f32x4*)wr)[i] = ((const f32x4*)WR)[i];
        LAS int* hist = (LAS int*)(F.lds + L_RH); LAS int* hbase = hist + 32;
        LAS float* lg = (LAS float*)(F.lds + L_RSCR + F.wave * 2112);
        const int r32 = F.lane & 31, hh = F.lane >> 5;
        for (int blk = blockIdx.x; blk < T / 256; blk += F.G) {
            if (F.tid < 32) hist[F.tid] = 0;
            __syncthreads();
            const int tok0 = blk * 256 + F.wave * 32;
            const float* hrow = out + (size_t)(tok0 + r32) * D + 512 * hh;
            f32x16 acc = {}; float ss = 0.f;
#pragma unroll 2
            for (int it = 0; it < 32; ++it) {
                f32x4 a[4];
#pragma unroll
                for (int q = 0; q < 4; ++q) a[q] = *(const f32x4*)(hrow + 16 * it + 4 * q);
#pragma unroll
                for (int q = 0; q < 4; ++q)
#pragma unroll
                    for (int c = 0; c < 4; ++c) { const float av = a[q][c]; ss += av * av; const float bv = wr[(512 * hh + 16 * it + 4 * q + c) * 32 + r32]; acc = __builtin_amdgcn_mfma_f32_32x32x2f32(av, bv, acc, 0, 0, 0); }
            }
            ss += __shfl_xor(ss, 32);
            const float rs = 1.0f / sqrtf(ss * (1.0f / D) + NORM_EPS);
            const int tok = tok0 + r32;
            if (hh == 0) RS2[tok] = rs;
            int sel[4]; float gv[4]; int lpos[4];
#pragma unroll
            for (int pass = 0; pass < 2; ++pass) {
#pragma unroll
                for (int r = 0; r < 8; ++r) { const int rr = 8 * pass + r; const int i = crow(rr, hh) - 16 * pass; lg[i * 33 + r32] = acc[rr]; }
                LDS_WAIT(); asm volatile("" ::: "memory");
                if ((r32 >> 4) == pass && hh == 0) {
                    const int i = r32 & 15; float v[32];
#pragma unroll
                    for (int e = 0; e < 32; ++e) v[e] = lg[i * 33 + e] * rs + b_router[e];
                    unsigned taken = 0u;
#pragma unroll
                    for (int k = 0; k < 4; ++k) { float best = -INFINITY; int bi = 0;
#pragma unroll
                        for (int e = 0; e < 32; ++e) { const bool ok = !((taken >> e) & 1u) && v[e] > best; best = ok ? v[e] : best; bi = ok ? e : bi; }
                        taken |= 1u << bi; sel[k] = bi; gv[k] = best; }
                    const float e1 = __expf(gv[1] - gv[0]), e2 = __expf(gv[2] - gv[0]), e3 = __expf(gv[3] - gv[0]); const float inv = 1.0f / (1.0f + e1 + e2 + e3);
                    gv[0] = inv; gv[1] = e1 * inv; gv[2] = e2 * inv; gv[3] = e3 * inv;
#pragma unroll
                    for (int k = 0; k < 4; ++k) lpos[k] = __hip_atomic_fetch_add(&hist[sel[k]], 1, __ATOMIC_RELAXED, __HIP_MEMORY_SCOPE_WORKGROUP);
                }
                LDS_WAIT(); asm volatile("" ::: "memory");
            }
            __syncthreads();
            if (F.tid < 32) hbase[F.tid] = (int)__hip_atomic_fetch_add((unsigned*)(ctl + CW_CNT + F.tid), (unsigned)hist[F.tid], RLX_AGENT);
            __syncthreads();
            if (hh == 0) {
#pragma unroll
                for (int k = 0; k < 4; ++k) { const int aid = tok * 4 + k; GATE[aid] = gv[k]; LIST[(size_t)sel[k] * LIST_CAP + hbase[sel[k]] + lpos[k]] = aid; }
            }
            __syncthreads();
        }
    }
    SEAM(4);

    {
        LAS int* cntl = (LAS int*)(F.lds + L_CNT); LAS int* tinfo = (LAS int*)(F.lds + L_TINFO); LAS int* pref = (LAS int*)(F.lds + L_PREF);
        int nMt = 0;
        if (IN(5) || IN(6)) {
            __syncthreads();
            if (F.tid < 32) cntl[F.tid] = (int)__hip_atomic_load((unsigned*)(ctl + CW_CNT + F.tid), RLX_AGENT);
            __syncthreads();
            if (F.tid == 0) { int a = 0; for (int e = 0; e < 32; ++e) { pref[e] = a; a += (cntl[e] + 255) >> 8; } pref[32] = a; }
            __syncthreads();
            nMt = pref[32];
            for (int e = 0; e < 32; ++e) { const int p0 = pref[e], n = pref[e + 1] - p0; for (int j = F.tid; j < n; j += NWAVES * 64) tinfo[p0 + j] = e | (j << 8); }
            __syncthreads();
        }
        if (IN(5)) {
            KP_FRESH(); unsigned char* ws = KWS();
            pg8::TabOrder S; S.tab = utab; S.list = (const int*)(ws + WS_LIST); S.nU = pg8::build_units(utab, nMt, 8, F.G, (int)blockIdx.x, tinfo, cntl);
            pg8::EpiGU E{ws + WS_ACT, (const float*)(ws + WS_RS2), KIN(const float*, 14)};
            pg8::gemm_phase<pg8::EpiGU, pg8::TabOrder, 1, true, 512, true>(F.lds, idxring, ws + WS_H8, ws + WS_WGU, S, E);
        }
        SEAM(5);
        if (IN(6)) {
            KP_FRESH(); unsigned char* ws = KWS();
            pg8::TabOrder S; S.tab = utab; S.list = (const int*)(ws + WS_LIST); S.nU = pg8::build_units(utab, nMt, 4, F.G, (int)blockIdx.x, tinfo, cntl);
            pg8::EpiDown E{(bf16_t*)(ws + WS_Y), (const float*)(ws + WS_GATE), KIN(const float*, 16)};
            pg8::gemm_phase<pg8::EpiDown, pg8::TabOrder, 0, true, 512, true>(F.lds, idxring, ws + WS_ACT, ws + WS_WDN, S, E);
        }
        SEAM(6);
        if (IN(7)) {
            KP_FRESH(); float* out = KOUT(); const bf16_t* YB = (const bf16_t*)(KWS() + WS_Y);
            const int gt = blockIdx.x * (NWAVES * 64) + F.tid, NGT = F.G * NWAVES * 64;
            for (int it = gt; it < T * 128; it += NGT) { const int tl = it >> 7, c8 = (it & 127) * 8; const size_t o = (size_t)tl * D + c8;
                f32x4 h0 = *(const f32x4*)(out + o), h1 = *(const f32x4*)(out + o + 4);
#pragma unroll
                for (int k = 0; k < 4; ++k) { const u32x4 v = *(const u32x4*)(YB + (size_t)(tl * 4 + k) * D + c8);
                    h0[0] += __builtin_bit_cast(float, v[0] << 16); h0[1] += __builtin_bit_cast(float, v[0] & 0xffff0000u); h0[2] += __builtin_bit_cast(float, v[1] << 16); h0[3] += __builtin_bit_cast(float, v[1] & 0xffff0000u);
                    h1[0] += __builtin_bit_cast(float, v[2] << 16); h1[1] += __builtin_bit_cast(float, v[2] & 0xffff0000u); h1[2] += __builtin_bit_cast(float, v[3] << 16); h1[3] += __builtin_bit_cast(float, v[3] & 0xffff0000u); }
                *(f32x4*)(out + o) = h0; *(f32x4*)(out + o + 4) = h1; }
        }
    }
#undef IN
#undef SEAM
}

extern "C" void kernel_launch(void* const* d_in, const int* in_sizes, int n_in, void* d_out, int out_size, void* d_ws, size_t ws_size, hipStream_t stream) {
    static int grid = 0;
    if (grid == 0) {
        if (n_in != 17 || out_size != T * D || ws_size < WS_END) { fprintf(stderr, "kernel_launch: unexpected shapes (n_in %d out %d ws %zu)\n", n_in, out_size, ws_size); grid = -1; return; }
        int dev = 0, cus = 0, per_cu = 0;
        if (hipGetDevice(&dev) != hipSuccess || hipDeviceGetAttribute(&cus, hipDeviceAttributeMultiprocessorCount, dev) != hipSuccess) { grid = -1; return; }
        if (hipFuncSetAttribute((const void*)hymba_fwd, hipFuncAttributeMaxDynamicSharedMemorySize, LDS_BYTES) != hipSuccess) { fprintf(stderr, "kernel_launch: hipFuncSetAttribute failed\n"); grid = -1; return; }
        if (hipOccupancyMaxActiveBlocksPerMultiprocessor(&per_cu, (const void*)hymba_fwd, NWAVES * 64, LDS_BYTES) != hipSuccess || per_cu < 1) { fprintf(stderr, "kernel_launch: occupancy query says %d\n", per_cu); }
        (void)hipGetLastError();
        grid = cus;
    }
    if (grid < 0) return;
    (void)hipMemsetAsync((char*)d_ws + WS_CTL, 0, CTL_ZERO_BYTES, stream);
    Args a{};
    for (int i = 0; i < 17; ++i) a.in[i] = d_in[i];
    a.out = (float*)d_out; a.ws = (unsigned char*)d_ws;
    for (int p = 0; p < 8; ++p) a.invf[p] = (float)pow(500000.0, -(double)p / 8.0);
    if (N_LAUNCHES == 1) { a.ph_lo = 0; a.ph_hi = NPH; hipLaunchKernelGGL(hymba_fwd, dim3(grid), dim3(NWAVES * 64), LDS_BYTES, stream, a); }
    else for (int li = 0; li < NPH; ++li) { a.ph_lo = li; a.ph_hi = li + 1; hipLaunchKernelGGL(hymba_fwd, dim3(grid), dim3(NWAVES * 64), LDS_BYTES, stream, a); }
}
```

```cpp
#include <hip/hip_runtime.h>
#include <cstdio>
#include <cstdint>
#include <cmath>

#ifndef MK_N_LAUNCHES
#define MK_N_LAUNCHES 1
#endif

#define LAS __attribute__((address_space(3)))
#define GAS __attribute__((address_space(1)))
typedef unsigned short bf16_t;
typedef short bf16x8 __attribute__((ext_vector_type(8)));
typedef short s16x4 __attribute__((ext_vector_type(4)));
typedef float f32x4 __attribute__((ext_vector_type(4)));
typedef float f32x2 __attribute__((ext_vector_type(2)));
typedef float f32x16 __attribute__((ext_vector_type(16)));
typedef unsigned u32x4 __attribute__((ext_vector_type(4)));
typedef unsigned u32x2 __attribute__((ext_vector_type(2)));
typedef GAS unsigned gu32;
typedef int v4i32 __attribute__((ext_vector_type(4)));
typedef int v8i32 __attribute__((ext_vector_type(8)));

constexpr int NB = 16, SEQ = 4096, T = NB * SEQ, D = 1024, NIN = 1280, NE = 32, FF = 1024;
constexpr int LIST_CAP = T;
constexpr float NORM_EPS = 1e-5f, QK_EPS = 1e-6f;
constexpr float LOG2E = 1.4426950408889634f;
constexpr float C2 = 0.125f * LOG2E;
constexpr int NWAVES = 8;
constexpr int NPH = 8;
constexpr int N_LAUNCHES = MK_N_LAUNCHES;
constexpr float W8_SCALE = 64.0f;
constexpr int SCALE_ONE = 0x7F7F7F7F, SCALE_W = 0x79797979;

constexpr size_t MiB = 1u << 20;
constexpr size_t WS_CTL = 0, CTL_ZERO_BYTES = 1 * MiB;
constexpr size_t WS_WIN = 1 * MiB;
constexpr size_t WS_WOUT = 4 * MiB;
constexpr size_t WS_WR = 6 * MiB;
constexpr size_t WS_ROPE = 7 * MiB;
constexpr size_t WS_RS1 = 11 * MiB;
constexpr size_t WS_RS2 = 11 * MiB + 512 * 1024;
constexpr size_t WS_GATE = 12 * MiB;
constexpr size_t WS_LIST = 13 * MiB;
constexpr size_t WS_WGU = 22 * MiB;
constexpr size_t WS_WDN = 86 * MiB;
constexpr size_t WS_H8 = 118 * MiB;
constexpr size_t WS_UB = 182 * MiB;
constexpr size_t WS_MIXED = 246 * MiB;
constexpr size_t WS_ACT = 182 * MiB;
constexpr size_t WS_Y = 446 * MiB;
constexpr size_t WS_END = 958 * MiB;
constexpr int ACT_SLOTS = T * 4 + NE * 256;
static_assert(WS_ACT + (size_t)ACT_SLOTS * 1024 <= WS_Y, "act");
constexpr size_t DO_XB = 0, DO_QB = 128 * MiB, DO_KB = 192 * MiB, DO_VB = 208 * MiB;
constexpr int CW_CNT = 64;
constexpr int CW_BAR = 4096;

constexpr int RING_BYTES = 131072;
constexpr int L_MISC = RING_BYTES;
constexpr int L_CNT = RING_BYTES + 512;
constexpr int L_PREF = RING_BYTES + 640;
constexpr int L_IDX = RING_BYTES + 1024;
constexpr int L_TINFO = RING_BYTES + 4096;
constexpr int L_RSCR = RING_BYTES + 8704;
constexpr int L_RH = RING_BYTES + 25600;
constexpr int L_UTAB = RING_BYTES + 26624;
constexpr int LDS_BYTES = RING_BYTES + 27648;

#define RLX_AGENT __ATOMIC_RELAXED, __HIP_MEMORY_SCOPE_AGENT
#define LDS_WAIT() asm volatile("s_waitcnt lgkmcnt(0)" ::: "memory")
#define VM_WAIT() asm volatile("s_waitcnt vmcnt(0)" ::: "memory")

__device__ __forceinline__ unsigned f2bf(float f) { unsigned u = __builtin_bit_cast(unsigned, f); return (u + 0x7fffu + ((u >> 16) & 1u)) >> 16; }
__device__ __forceinline__ unsigned pk2(float lo, float hi) { return f2bf(lo) | (f2bf(hi) << 16); }
__device__ __forceinline__ unsigned cvt_pk_bf16(float lo, float hi) { unsigned r; asm volatile("v_cvt_pk_bf16_f32 %0, %1, %2" : "=v"(r) : "v"(lo), "v"(hi)); return r; }
__device__ __forceinline__ unsigned pk4_fp8(float a, float b, float c, float d) { unsigned w = 0; w = __builtin_amdgcn_cvt_pk_fp8_f32(a, b, w, false); w = __builtin_amdgcn_cvt_pk_fp8_f32(c, d, w, true); return w; }
__device__ __forceinline__ float bf2f(unsigned short b) { return __builtin_bit_cast(float, (unsigned)b << 16); }

#define XB_TMO      128
#define XB_XCNT(j)  (256  + 64 * (j))
#define XB_XSUB(j)  (1280 + 64 * (j))
#define XB_XGEN(j)  (2304 + 64 * (j))
#define XB_TOP      3328
#define XB_TOPGEN   3392
#define XCD_BAR_WORDS 3456
#define XB_SPIN_CAP (1u << 23)
__device__ __forceinline__ unsigned xb_ld(unsigned* p)              { return __hip_atomic_load(p, __ATOMIC_RELAXED, __HIP_MEMORY_SCOPE_AGENT); }
__device__ __forceinline__ unsigned xb_add(unsigned* p, unsigned v) { return __hip_atomic_fetch_add(p, v, __ATOMIC_RELAXED, __HIP_MEMORY_SCOPE_AGENT); }
__device__ __forceinline__ unsigned xb_xcc_id() { return (unsigned)__builtin_amdgcn_s_getreg((3 << 11) | 20) & 0xFu; }
#define XB_SPIN(cond, bar) do { unsigned _sp = 0; while (cond) { __builtin_amdgcn_s_sleep(1); \
    if ((++_sp & 255u) == 0u) { if (xb_ld(&(bar)[XB_TMO])) break; if (_sp > XB_SPIN_CAP) { atomicAdd(&(bar)[XB_TMO], 1u); break; } } } } while (0)
struct XcdBarrier { unsigned* bar; unsigned x; volatile LAS unsigned* st; };
__device__ __forceinline__ XcdBarrier xcd_barrier_post(unsigned* bar, volatile LAS unsigned* st) {
    XcdBarrier b; b.bar = bar; b.x = xb_xcc_id(); b.st = st;
    if (threadIdx.x == 0) (void)xb_add(&bar[XB_XCNT(b.x)], 1u);
    return b;
}
__device__ __forceinline__ void xcd_barrier_complete(unsigned* bar, unsigned x, unsigned& nloc, unsigned& nx) {
    const unsigned G = gridDim.x * gridDim.y * gridDim.z;
    unsigned sum, cnt, mine, sp = 0u;
    for (;;) {
        sum = 0u; cnt = 0u; mine = 0u;
#pragma unroll
        for (unsigned j = 0; j < 16; ++j) { const unsigned c = xb_ld(&bar[XB_XCNT(j)]); sum += c; cnt += (c > 0u) ? 1u : 0u; mine = (j == x) ? c : mine; }
        if (sum == G) break;
        __builtin_amdgcn_s_sleep(1);
        if ((++sp & 255u) == 0u) { if (xb_ld(&bar[XB_TMO])) break; if (sp > XB_SPIN_CAP) { atomicAdd(&bar[XB_TMO], 1u); break; } }
    }
    nloc = mine > 0u ? mine : 1u; nx = cnt > 0u ? cnt : 1u;
}
__device__ __forceinline__ void xcd_barrier(const XcdBarrier& b) {
    asm volatile("s_waitcnt vmcnt(0)" ::: "memory");
    __syncthreads();
    if (threadIdx.x == 0) {
        unsigned* bar = b.bar;
        __builtin_amdgcn_s_waitcnt(0);
        unsigned nloc = b.st[0], nx = b.st[1];
        if (nloc == 0u) { xcd_barrier_complete(bar, b.x, nloc, nx); b.st[0] = nloc; b.st[1] = nx; }
        const unsigned old = xb_add(&bar[XB_XSUB(b.x)], 1u);
        const unsigned gen = old / nloc;
        if (old + 1u == (gen + 1u) * nloc) {
            __builtin_amdgcn_fence(__ATOMIC_RELEASE, "agent");
            asm volatile("s_waitcnt vmcnt(0)" ::: "memory");
            const unsigned og = xb_add(&bar[XB_TOP], 1u);
            const unsigned tg = og / nx;
            if (og + 1u == (tg + 1u) * nx) xb_add(&bar[XB_TOPGEN], 1u);
            else XB_SPIN(xb_ld(&bar[XB_TOPGEN]) == tg, bar);
            __builtin_amdgcn_fence(__ATOMIC_ACQUIRE, "agent");
            xb_add(&bar[XB_XGEN(b.x)], 1u);
            asm volatile("s_waitcnt vmcnt(0)" ::: "memory");
        } else {
            XB_SPIN(xb_ld(&bar[XB_XGEN(b.x)]) == gen, bar);
            __builtin_amdgcn_fence(__ATOMIC_ACQUIRE, "agent");
            asm volatile("s_waitcnt vmcnt(0)" ::: "memory");
        }
    }
    __syncthreads();
}

namespace pg8 {
constexpr int BM = 256, BK = 64, HALF = 128, HTB = HALF * BK * 2, NXCD = 8, WGM = 8;
__host__ __device__ __forceinline__ int lds_byte(int r, int c) { const int st = (r >> 4) * 2 + (c >> 5), rr = r & 15, cc = c & 31, ob = rr * 64 + cc * 2; return st * 1024 + (ob ^ (((ob >> 9) & 1) << 5)); }
__host__ __device__ __forceinline__ void stage_rc(int b, int& R, int& C) { const int st = b / 1024, sb = b % 1024, swz = sb ^ (((sb >> 9) & 1) << 5); R = (st >> 1) * 16 + swz / 64; C = (st & 1) * 32 + (swz % 64) / 2; }
__host__ __device__ __forceinline__ int perm32(int rho) { const int n = rho >> 4, i = rho & 15; return 8 * (i >> 2) + 4 * n + (i & 3); }

union Frag { v8i32 v; bf16x8 pc[2]; };
struct Unit { int pm, pn, bt, e, j, nvalid; };

__device__ __forceinline__ bool order_tile(int i, int nM, int nN, int G, int c, int& pm, int& pn) {
    const int nwg = nM * nN; const long L = (long)i * G + c; if (L >= nwg) return false;
    int wgid = (int)L; { const int q = nwg / NXCD, r = nwg % NXCD, xcd = wgid % NXCD, off = wgid / NXCD; wgid = (xcd < r ? xcd * (q + 1) : r * (q + 1) + (xcd - r) * q) + off; }
    const int nig = WGM * nN, gid = wgid / nig, fm = gid * WGM, gsz = (nM - fm) < WGM ? (nM - fm) : WGM;
    pm = fm + ((wgid % nig) % gsz); pn = (wgid % nig) / gsz; return true;
}
constexpr int MAX_UNITS = 64;
__device__ __forceinline__ int build_units(LAS int* tab, int nM, int nN, int G, int c, const LAS int* tinfo, const LAS int* cnt) {
    const int nwg = nM * nN; const int nU = (nwg > c) ? (nwg - c + G - 1) / G : 0;
    __syncthreads();
    const int i = threadIdx.x;
    if (i < nU && i < MAX_UNITS) { int pm = 0, pn = 0; order_tile(i, nM, nN, G, c, pm, pn);
        int e = 0, j = 0, nv = 256;
        if (tinfo) { const int ti = tinfo[pm]; e = ti & 255; j = ti >> 8; const int c_ = cnt[e] - 256 * j; nv = c_ < 256 ? c_ : 256; }
        tab[4 * i] = pm; tab[4 * i + 1] = pn; tab[4 * i + 2] = e * nN + pn; tab[4 * i + 3] = e | (j << 8) | (nv << 20); }
    __syncthreads();
    return nU < MAX_UNITS ? nU : MAX_UNITS;
}
struct TabOrder {
    const LAS int* tab; int nU; const int* list;
    __device__ __forceinline__ bool next(int i, Unit& u) const {
        if (i >= nU) return false;
        const int w3 = __builtin_amdgcn_readfirstlane(tab[4 * i + 3]);
        u.pm = __builtin_amdgcn_readfirstlane(tab[4 * i]); u.pn = __builtin_amdgcn_readfirstlane(tab[4 * i + 1]); u.bt = __builtin_amdgcn_readfirstlane(tab[4 * i + 2]);
        u.e = w3 & 255; u.j = (w3 >> 8) & 4095; u.nvalid = w3 >> 20; return true;
    }
    __device__ __forceinline__ const int* idx_src(const Unit& u) const { return list + (size_t)u.e * LIST_CAP + 256 * u.j; }
};

template <class Epi, class Sched, int AMODE, bool HAS_IDX, int K, bool F8, bool ALIGN_EPI = true>
__device__ __forceinline__ void gemm_phase(LAS unsigned char* lds, LAS int* idxring, const void* Ag, const void* Btg, const Sched& S, const Epi& E) {
    const int tid = threadIdx.x, wid = __builtin_amdgcn_readfirstlane(tid >> 6), lane = tid & 63, wr = wid >> 2, wc = wid & 3, fr = lane & 15, fq = lane >> 4;
    const int nt = K / BK;
    unsigned voffB[2];
#pragma unroll
    for (int i = 0; i < 2; ++i) { int R, C; stage_rc(tid * 16 + i * 8192, R, C); const int Rb = Epi::PERM ? ((R & ~31) + perm32(R & 31)) : R; voffB[i] = (unsigned)(Rb * K + C) * 2u; }
    const size_t kstep = (size_t)(BK * 2);
    const size_t hstep = (size_t)HALF * K * 2;
    const size_t tstep = 2 * hstep;
    const unsigned ldsw = (unsigned)wid * 1024u;
    const int aoff = lds_byte(wr * 64 + fr, fq * 8), boff = lds_byte(wc * 32 + fr, fq * 8);
#define PG8_SA(b, h) (((b) * 2 + (h)) * HTB)
#define PG8_SB(b, h) ((4 + (b) * 2 + (h)) * HTB)
#define PG8_STAGE_B(bufoff, gbase) do { _Pragma("unroll") for (int _i = 0; _i < 2; ++_i) \
        __builtin_amdgcn_global_load_lds((const unsigned*)((const char*)(gbase) + voffB[_i]), (LAS unsigned*)(lds + (bufoff) + ldsw + _i * 8192), 16, 0, 0); } while (0)
#define PG8_STAGE_A(bufoff, kb, AO, h) do { _Pragma("unroll") for (int _i = 0; _i < 2; ++_i) \
        __builtin_amdgcn_global_load_lds((const unsigned*)((const char*)Ag + (kb) + (AO)[h][_i]), (LAS unsigned*)(lds + (bufoff) + ldsw + _i * 8192), 16, 0, 0); } while (0)
#define PG8_LDA(dst, b, h) do { _Pragma("unroll") for (int m = 0; m < 4; ++m) _Pragma("unroll") for (int k = 0; k < 2; ++k) dst[m][k] = *(const LAS bf16x8*)(lds + PG8_SA(b, h) + aoff + m * 2048 + k * 1024); } while (0)
#define PG8_LDB(dst, b, h) do { _Pragma("unroll") for (int n = 0; n < 2; ++n) _Pragma("unroll") for (int k = 0; k < 2; ++k) dst[n][k] = *(const LAS bf16x8*)(lds + PG8_SB(b, h) + boff + n * 2048 + k * 1024); } while (0)
#define PG8_MMA(ai, bj, At, Bt) do { __builtin_amdgcn_s_setprio(1); _Pragma("unroll") for (int m = 0; m < 4; ++m) _Pragma("unroll") for (int n = 0; n < 2; ++n) { \
        if constexpr (F8) { \
            const v8i32 bv_ = __builtin_shufflevector(__builtin_bit_cast(v4i32, Bt[n][0]), __builtin_bit_cast(v4i32, Bt[n][1]), 0, 1, 2, 3, 4, 5, 6, 7); \
            const v8i32 av_ = __builtin_shufflevector(__builtin_bit_cast(v4i32, At[m][0]), __builtin_bit_cast(v4i32, At[m][1]), 0, 1, 2, 3, 4, 5, 6, 7); \
            acc[ai][bj][m][n] = __builtin_amdgcn_mfma_scale_f32_16x16x128_f8f6f4(bv_, av_, acc[ai][bj][m][n], 0, 0, 0, SCALE_W, 0, SCALE_ONE); } \
        else { _Pragma("unroll") for (int k = 0; k < 2; ++k) acc[ai][bj][m][n] = __builtin_amdgcn_mfma_f32_16x16x32_bf16(Bt[n][k], At[m][k], acc[ai][bj][m][n], 0, 0, 0); } } \
        __builtin_amdgcn_s_setprio(0); } while (0)
#define PG8_WAIT_V(n) asm volatile("s_waitcnt vmcnt(" #n ")" ::: "memory")
#define PG8_WAIT_L(n) asm volatile("s_waitcnt lgkmcnt(" #n ")" ::: "memory")
#define PG8_BAR __builtin_amdgcn_s_barrier()
#define PG8_SCHED __builtin_amdgcn_sched_barrier(0)
#define PG8_AOFF(dst, U, islot) do { int _t = tid; asm volatile("" : "+v"(_t)); _Pragma("unroll") for (int _i = 0; _i < 2; ++_i) { int _R, _C; stage_rc(_t * 16 + _i * 8192, _R, _C); \
        _Pragma("unroll") for (int _h = 0; _h < 2; ++_h) { \
        int _row; if (AMODE == 0) _row = (U).pm * BM + _h * HALF + _R; else _row = idxring[(islot) * 256 + _h * HALF + _R] >> 2; \
        dst[_h][_i] = ((unsigned)_row * (unsigned)K + (unsigned)_C) * 2u; } } } while (0)
    Unit cur, nxt; int ui = 0, islot = 0;
    if (!S.next(0, cur)) return;
    if (HAS_IDX) {
        if (wid == 0) { __builtin_amdgcn_global_load_lds((const unsigned*)(S.idx_src(cur) + lane * 4), (LAS unsigned*)(idxring), 16, 0, 0); PG8_WAIT_V(0); }
        __syncthreads();
    }
    f32x4 acc[2][2][4][2];
#define PG8_ACC_INIT(U) do { if constexpr (Epi::INIT) E.init(acc, U, wr, wc, fr, fq); else { \
        _Pragma("unroll") for (int a = 0; a < 2; ++a) _Pragma("unroll") for (int b = 0; b < 2; ++b) _Pragma("unroll") for (int m = 0; m < 4; ++m) _Pragma("unroll") for (int n = 0; n < 2; ++n) \
            acc[a][b][m][n] = (f32x4){0.f, 0.f, 0.f, 0.f}; } } while (0)
    PG8_ACC_INIT(cur);
    bf16x8 At[4][2], B0[2][2], B1[2][2];
    unsigned ao[2][2];
    PG8_AOFF(ao, cur, 0);
    const char* cB = (const char*)Btg + (size_t)cur.bt * tstep;
    PG8_STAGE_B(PG8_SB(0, 0), cB); PG8_STAGE_B(PG8_SB(0, 1), cB + hstep); PG8_STAGE_A(PG8_SA(0, 0), 0, ao, 0); PG8_STAGE_A(PG8_SA(0, 1), 0, ao, 1);
    if (wr == 1) PG8_BAR;
    PG8_WAIT_V(2); PG8_BAR;
    PG8_STAGE_B(PG8_SB(1, 0), cB + kstep); PG8_STAGE_A(PG8_SA(1, 0), kstep, ao, 0); PG8_STAGE_B(PG8_SB(1, 1), cB + hstep + kstep);
    PG8_WAIT_V(6); PG8_BAR;
    for (;;) {
        const bool has_next = S.next(ui + 1, nxt);
        const int nslot = (islot == 2) ? 0 : islot + 1;
        if (HAS_IDX && has_next && wid == 0)
            __builtin_amdgcn_global_load_lds((const unsigned*)(S.idx_src(nxt) + lane * 4), (LAS unsigned*)(idxring + nslot * 256), 16, 0, 0);
        const char* nB = has_next ? (const char*)Btg + (size_t)nxt.bt * tstep : cB;
#pragma unroll 1
        for (int t = 0; t < nt; t += 2) {
            const bool last = (t == nt - 2);
            const size_t k1 = (size_t)(t + 1) * kstep;
            const size_t k2 = last ? 0 : (size_t)(t + 2) * kstep, k3 = k2 + kstep;
            const char* b2 = last ? nB : cB + (size_t)(t + 2) * kstep; const char* b3 = b2 + kstep;
            PG8_LDB(B0, 0, 0); PG8_LDB(B1, 0, 1); PG8_SCHED; PG8_LDA(At, 0, 0); PG8_STAGE_A(PG8_SA(1, 1), k1, ao, 1);
            if (last && has_next) { PG8_AOFF(ao, nxt, nslot); }
            PG8_WAIT_V(8); PG8_WAIT_L(0); PG8_BAR; PG8_MMA(0, 0, At, B0); PG8_MMA(0, 1, At, B1); PG8_BAR; PG8_SCHED;
            PG8_LDA(At, 0, 1); PG8_STAGE_B(PG8_SB(0, 0), b2); PG8_STAGE_B(PG8_SB(0, 1), b2 + hstep); PG8_STAGE_A(PG8_SA(0, 0), k2, ao, 0);
            PG8_WAIT_V(8); PG8_WAIT_L(0); PG8_BAR; PG8_MMA(1, 0, At, B0); PG8_MMA(1, 1, At, B1); PG8_BAR; PG8_SCHED;
            PG8_LDB(B0, 1, 0); PG8_LDB(B1, 1, 1); PG8_SCHED; PG8_LDA(At, 1, 0); PG8_STAGE_A(PG8_SA(0, 1), k2, ao, 1);
            PG8_WAIT_V(8); PG8_WAIT_L(0); PG8_BAR; PG8_MMA(0, 0, At, B0); PG8_MMA(0, 1, At, B1); PG8_BAR; PG8_SCHED;
            PG8_LDA(At, 1, 1); PG8_STAGE_B(PG8_SB(1, 0), b3); PG8_STAGE_B(PG8_SB(1, 1), b3 + hstep); PG8_STAGE_A(PG8_SA(1, 0), k3, ao, 0);
            PG8_WAIT_V(8); PG8_WAIT_L(0); PG8_BAR; PG8_MMA(1, 0, At, B0); PG8_MMA(1, 1, At, B1); PG8_BAR; PG8_SCHED;
        }
        if (ALIGN_EPI) { if (wr == 0) PG8_BAR; }
        E(acc, cur, wr, wc, fr, fq, (const LAS int*)(idxring + islot * 256));
        if (!has_next) break;
        PG8_ACC_INIT(nxt);
        cur = nxt; cB = nB; ++ui; islot = nslot;
        if (ALIGN_EPI) { if (wr == 1) PG8_BAR; }
    }
    PG8_WAIT_V(0);
    if (!ALIGN_EPI) { if (wr == 0) PG8_BAR; }
    PG8_BAR;
#undef PG8_SA
#undef PG8_SB
#undef PG8_STAGE_A
#undef PG8_STAGE_B
#undef PG8_LDA
#undef PG8_LDB
#undef PG8_MMA
#undef PG8_WAIT_V
#undef PG8_WAIT_L
#undef PG8_BAR
#undef PG8_SCHED
#undef PG8_AOFF
#undef PG8_ACC_INIT
}

__device__ __forceinline__ u32x4 pack8(const f32x4 a, const f32x4 b) { u32x4 w; w.x = cvt_pk_bf16(a[0], a[1]); w.y = cvt_pk_bf16(a[2], a[3]); w.z = cvt_pk_bf16(b[0], b[1]); w.w = cvt_pk_bf16(b[2], b[3]); return w; }

struct EpiInProj {
    static constexpr bool PERM = true, INIT = false;
    bf16_t *Q, *Kb, *Vb, *U; const float *rs1, *rope, *qw, *kw;
    __device__ __forceinline__ void operator()(const f32x4 (&acc)[2][2][4][2], const Unit& u, int wr, int wc, int fr, int fq, const LAS int*) const {
        const int row0 = u.pm * BM + wr * 64 + fr;
        if (u.pn >= 3) {
#pragma unroll
            for (int ai = 0; ai < 2; ++ai)
#pragma unroll
                for (int m = 0; m < 4; ++m) { const int row = row0 + ai * HALF + m * 16; const float s = rs1[row];
                    bf16_t* rp = U + (size_t)row * 512 + (u.pn - 3) * 256 + wc * 32 + 8 * fq;
#pragma unroll
                    for (int bj = 0; bj < 2; ++bj) *(u32x4*)(rp + bj * HALF) = pack8(acc[ai][bj][m][0] * s, acc[ai][bj][m][1] * s); }
            return;
        }
        const bool isv = (u.pn == 2 && wc >= 2);
        bf16_t* dst; int ld; const float* w; float post;
        if (u.pn < 2) { dst = Q + (4 * u.pn + wc) * 64; ld = 512; w = qw; post = C2; }
        else if (wc < 2) { dst = Kb + wc * 64; ld = 128; w = kw; post = 1.f; }
        else { dst = Vb + (wc - 2) * 64; ld = 128; w = qw; post = 1.f; }
        f32x4 wv[2][2];
#pragma unroll
        for (int bj = 0; bj < 2; ++bj)
#pragma unroll
            for (int n = 0; n < 2; ++n) wv[bj][n] = *(const f32x4*)(w + 32 * bj + 8 * fq + 4 * n);
#pragma unroll
        for (int ai = 0; ai < 2; ++ai)
#pragma unroll
            for (int m = 0; m < 4; ++m) {
                const int row = row0 + ai * HALF + m * 16; const float s = rs1[row];
                f32x4 x[2][2];
#pragma unroll
                for (int bj = 0; bj < 2; ++bj)
#pragma unroll
                    for (int n = 0; n < 2; ++n) x[bj][n] = acc[ai][bj][m][n] * s;
                if (!isv) {
                    float ss = 0.f;
#pragma unroll
                    for (int bj = 0; bj < 2; ++bj)
#pragma unroll
                        for (int n = 0; n < 2; ++n) ss += (x[bj][n][0] * x[bj][n][0] + x[bj][n][1] * x[bj][n][1]) + (x[bj][n][2] * x[bj][n][2] + x[bj][n][3] * x[bj][n][3]);
                    ss += __shfl_xor(ss, 16); ss += __shfl_xor(ss, 32);
                    const float rn = 1.0f / sqrtf(ss * (1.0f / 64.0f) + QK_EPS);
#pragma unroll
                    for (int bj = 0; bj < 2; ++bj)
#pragma unroll
                        for (int n = 0; n < 2; ++n) x[bj][n] = x[bj][n] * rn * wv[bj][n];
                    const float* rp = rope + (size_t)row * 16;
#pragma unroll
                    for (int n = 0; n < 2; ++n) {
                        const f32x4 cs = *(const f32x4*)(rp + 4 * n), sn = *(const f32x4*)(rp + 8 + 4 * n);
                        f32x4 pr;
#pragma unroll
                        for (int c = 0; c < 4; ++c) pr[c] = __shfl_xor(x[0][n][c], 16);
                        const f32x4 r0 = x[0][n] * cs - pr * sn, r1 = x[0][n] * cs + pr * sn;
                        if (fq == 0) x[0][n] = r0; else if (fq == 1) x[0][n] = r1;
                    }
#pragma unroll
                    for (int bj = 0; bj < 2; ++bj)
#pragma unroll
                        for (int n = 0; n < 2; ++n) x[bj][n] = x[bj][n] * post;
                }
                bf16_t* op = dst + (size_t)row * ld + 8 * fq;
#pragma unroll
                for (int bj = 0; bj < 2; ++bj) *(u32x4*)(op + 32 * bj) = pack8(x[bj][0], x[bj][1]);
            }
    }
};
struct EpiOutProj {
    static constexpr bool PERM = true, INIT = true;
    const float* x; float* out; unsigned char* h8;
    __device__ __forceinline__ void init(f32x4 (&acc)[2][2][4][2], const Unit& u, int wr, int wc, int fr, int fq) const {
        const int row0 = u.pm * BM + wr * 64 + fr, col0 = u.pn * BM + wc * 32 + 8 * fq;
#pragma unroll
        for (int ai = 0; ai < 2; ++ai)
#pragma unroll
            for (int m = 0; m < 4; ++m) { const size_t off = (size_t)(row0 + ai * HALF + m * 16) * D + col0;
#pragma unroll
                for (int bj = 0; bj < 2; ++bj) { acc[ai][bj][m][0] = *(const f32x4*)(x + off + bj * HALF); acc[ai][bj][m][1] = *(const f32x4*)(x + off + bj * HALF + 4); } }
    }
    __device__ __forceinline__ void operator()(const f32x4 (&acc)[2][2][4][2], const Unit& u, int wr, int wc, int fr, int fq, const LAS int*) const {
        const int row0 = u.pm * BM + wr * 64 + fr, col0 = u.pn * BM + wc * 32 + 8 * fq;
#pragma unroll
        for (int ai = 0; ai < 2; ++ai)
#pragma unroll
            for (int m = 0; m < 4; ++m) { const size_t off = (size_t)(row0 + ai * HALF + m * 16) * D + col0;
#pragma unroll
                for (int bj = 0; bj < 2; ++bj) { const f32x4 h0 = acc[ai][bj][m][0], h1 = acc[ai][bj][m][1];
                    *(f32x4*)(out + off + bj * HALF) = h0; *(f32x4*)(out + off + bj * HALF + 4) = h1;
                    u32x2 w; w.x = pk4_fp8(h0[0], h0[1], h0[2], h0[3]); w.y = pk4_fp8(h1[0], h1[1], h1[2], h1[3]); *(u32x2*)(h8 + off + bj * HALF) = w; } }
    }
};
struct EpiGU {
    static constexpr bool PERM = true, INIT = false;
    unsigned char* act; const float* rs2; const float* bgu;
    __device__ __forceinline__ void operator()(const f32x4 (&acc)[2][2][4][2], const Unit& u, int wr, int wc, int fr, int fq, const LAS int* idx) const {
        const int r0 = wr * 64 + fr, c0 = u.pn * 128 + wc * 32 + 8 * fq;
        const float* bp = bgu + (size_t)u.e * 2048 + c0;
        const f32x4 bg0 = *(const f32x4*)(bp), bg1 = *(const f32x4*)(bp + 4), bu0 = *(const f32x4*)(bp + 1024), bu1 = *(const f32x4*)(bp + 1028);
#pragma unroll
        for (int ai = 0; ai < 2; ++ai)
#pragma unroll
            for (int m = 0; m < 4; ++m) { const int r = r0 + ai * HALF + m * 16; const float s = rs2[idx[r] >> 2];
                f32x4 a[2];
#pragma unroll
                for (int n = 0; n < 2; ++n) { const f32x4 g = acc[ai][0][m][n] * s + (n ? bg1 : bg0), uu = acc[ai][1][m][n] * s + (n ? bu1 : bu0);
#pragma unroll
                    for (int c = 0; c < 4; ++c) { const float gc = fminf(g[c], 7.0f), uc = fminf(fmaxf(uu[c], -7.0f), 7.0f);
                        const float sg = __builtin_amdgcn_rcpf(1.0f + __builtin_amdgcn_exp2f(gc * (-1.702f * LOG2E))); a[n][c] = gc * sg * (uc + 1.0f); } }
                u32x2 w; w.x = pk4_fp8(a[0][0], a[0][1], a[0][2], a[0][3]); w.y = pk4_fp8(a[1][0], a[1][1], a[1][2], a[1][3]); *(u32x2*)(act + (size_t)(u.pm * BM + r) * FF + c0) = w; }
    }
};
struct EpiDown {
    static constexpr bool PERM = true, INIT = false;
    bf16_t* y; const float* gate; const float* bdn;
    __device__ __forceinline__ void operator()(const f32x4 (&acc)[2][2][4][2], const Unit& u, int wr, int wc, int fr, int fq, const LAS int* idx) const {
        const int r0 = wr * 64 + fr, c0 = u.pn * BM + wc * 32 + 8 * fq;
        const float* bp = bdn + (size_t)u.e * D + c0;
        f32x4 bv[2][2];
#pragma unroll
        for (int bj = 0; bj < 2; ++bj)
#pragma unroll
            for (int n = 0; n < 2; ++n) bv[bj][n] = *(const f32x4*)(bp + bj * HALF + 4 * n);
#pragma unroll
        for (int ai = 0; ai < 2; ++ai)
#pragma unroll
            for (int m = 0; m < 4; ++m) { const int r = r0 + ai * HALF + m * 16;
                if (r < u.nvalid) { const int aid = idx[r]; const float g = gate[aid]; bf16_t* yp = y + (size_t)aid * D + c0;
#pragma unroll
                    for (int bj = 0; bj < 2; ++bj) *(u32x4*)(yp + bj * HALF) = pack8((acc[ai][bj][m][0] + bv[bj][0]) * g, (acc[ai][bj][m][1] + bv[bj][1]) * g); } }
    }
};
}

struct Frame {
    LAS unsigned char* lds;
    int tid, lane, wave, G, gw, NGW;
};

__device__ __forceinline__ float wave_sum(float v) {
#pragma unroll
    for (int o = 1; o < 64; o <<= 1) v += __shfl_xor(v, o);
    return v;
}

template <int KQ, bool F8>
__device__ __forceinline__ void p0_tile(const float* W, int ldw, int scolA, int scolB, int k0, const float* ks, float sc, void* WT, int ldk, int drow0, int lane) {
    const int nl = (lane & 15) * 4, kq = lane >> 4, kb = k0 + KQ * kq;
    const char* ub = (const char*)(W + (size_t)k0 * ldw);
    const unsigned voff = (unsigned)(KQ * kq * ldw + ((nl & 32) ? scolB : scolA) + (nl & 31)) * 4u;
    f32x4 v[KQ];
#pragma unroll
    for (int i = 0; i < KQ; ++i) v[i] = *(const f32x4*)(ub + (size_t)i * ldw * 4 + voff);
    if (ks) {
#pragma unroll
        for (int i = 0; i < KQ; i += 4) { const f32x4 kv = *(const f32x4*)(ks + kb + i);
#pragma unroll
            for (int j = 0; j < 4; ++j) v[i + j] = v[i + j] * (kv[j] * sc); }
    } else if (sc != 1.0f) {
#pragma unroll
        for (int i = 0; i < KQ; ++i) v[i] = v[i] * sc;
    }
#pragma unroll
    for (int c = 0; c < 4; ++c) {
        if (F8) { unsigned char* dst = (unsigned char*)WT + (size_t)(drow0 + nl + c) * ldk + kb;
#pragma unroll
            for (int i = 0; i < KQ; i += 16) { u32x4 o; o.x = pk4_fp8(v[i][c], v[i + 1][c], v[i + 2][c], v[i + 3][c]); o.y = pk4_fp8(v[i + 4][c], v[i + 5][c], v[i + 6][c], v[i + 7][c]);
                o.z = pk4_fp8(v[i + 8][c], v[i + 9][c], v[i + 10][c], v[i + 11][c]); o.w = pk4_fp8(v[i + 12][c], v[i + 13][c], v[i + 14][c], v[i + 15][c]); *(GAS u32x4*)(dst + i) = o; } }
        else { bf16_t* dst = (bf16_t*)WT + (size_t)(drow0 + nl + c) * ldk + kb;
#pragma unroll
            for (int i = 0; i < KQ; i += 8) { u32x4 o; o.x = pk2(v[i][c], v[i + 1][c]); o.y = pk2(v[i + 2][c], v[i + 3][c]); o.z = pk2(v[i + 4][c], v[i + 5][c]); o.w = pk2(v[i + 6][c], v[i + 7][c]); *(GAS u32x4*)(dst + i) = o; } }
    }
}
__device__ __forceinline__ int win_src(int rho0) {
    const int pn = rho0 >> 8, within = rho0 & 255, bj = within >> 7, wc = (within & 127) >> 5;
    if (pn < 2) return 64 * (4 * pn + wc) + 32 * bj;
    if (pn == 2) return 512 + 64 * wc + 32 * bj;
    return rho0;
}

struct Args { const void* in[17]; float* out; unsigned char* ws; int ph_lo, ph_hi; float invf[8]; };

__device__ __forceinline__ int crow(int r, int hi) { return (r & 3) + 8 * (r >> 2) + 4 * hi; }
typedef short v4i16_t __attribute__((ext_vector_type(4)));
__device__ __forceinline__ s16x4 vtr(const LAS unsigned char* p) { return __builtin_bit_cast(s16x4, __builtin_amdgcn_ds_read_tr16_b64_v4i16((LAS v4i16_t*)p)); }

__device__ __forceinline__ void attn_unit(const Frame& F, int b, int kvh, int qblk, const bf16_t* Q, const bf16_t* Kb, const bf16_t* Vb, bf16_t* O, const float* sinks) {
    const int lane = F.lane, wid = F.wave, r32 = lane & 31, hi = lane >> 5;
    LAS unsigned char* lds = F.lds;
    const int s0 = qblk * 128; const long rowq0 = (long)b * SEQ + s0;
    {
        u32x4 kv[4], vv[4];
#pragma unroll
        for (int jt = 0; jt < 4; ++jt) {
            long rt = (long)b * SEQ + s0 - 128 + 64 * jt; if (qblk == 0 && jt < 2) rt = (long)b * SEQ;
            kv[jt] = *(const u32x4*)(Kb + (rt + lane) * 128 + kvh * 64 + wid * 8);
            vv[jt] = *(const u32x4*)(Vb + (rt + 16 * (wid & 3) + (lane >> 2)) * 128 + kvh * 64 + (wid >> 2) * 32 + (lane & 3) * 8);
        }
#pragma unroll
        for (int jt = 0; jt < 4; ++jt) { *(LAS u32x4*)(lds + jt * 8192 + wid * 1024 + lane * 16) = kv[jt]; *(LAS u32x4*)(lds + 32768 + jt * 8192 + wid * 1024 + lane * 16) = vv[jt]; }
    }
    __syncthreads();
    const int g = wid >> 1, rh = wid & 1, head = kvh * 4 + g, t0 = rh;
    const float sinkl = sinks[head] * LOG2E;
    LAS bf16_t* stg = (LAS bf16_t*)(lds + 65536) + wid * 2048;
    const int vboff = ((lane >> 4) & 1) * 32 + (lane & 3) * 8 + (4 * hi + ((lane & 15) >> 2)) * 64;
#pragma unroll 1
    for (int s = 0; s < 2; ++s) {
        const int q0 = 64 * rh + 32 * s;
        const bf16_t* Qw = Q + (size_t)(rowq0 + q0 + r32) * 512 + head * 64 + hi * 8;
        bf16x8 qr[4];
#pragma unroll
        for (int d0 = 0; d0 < 4; ++d0) qr[d0] = *(const bf16x8*)(Qw + d0 * 16);
        const int qi = q0 + r32; const int klo = (qblk == 0) ? (qi > 127 ? qi : 127) : qi;
        float mrun = sinkl, l = 1.0f;
        f32x16 o[2]; o[0] = f32x16{}; o[1] = f32x16{};
#pragma unroll 1
        for (int jt = 0; jt < 3; ++jt) {
            const LAS unsigned char* kb = lds + (t0 + jt) * 8192 + hi * 1024 + r32 * 16;
            f32x16 p0 = {}, p1 = {};
#pragma unroll
            for (int d0 = 0; d0 < 4; ++d0) {
                const bf16x8 k0 = *(const LAS bf16x8*)(kb + d0 * 2048), k1 = *(const LAS bf16x8*)(kb + d0 * 2048 + 512);
                p0 = __builtin_amdgcn_mfma_f32_32x32x16_bf16(k0, qr[d0], p0, 0, 0, 0);
                p1 = __builtin_amdgcn_mfma_f32_32x32x16_bf16(k1, qr[d0], p1, 0, 0, 0);
            }
            float mx = mrun; const int kbase = 64 * (t0 + jt);
#pragma unroll
            for (int r = 0; r < 16; ++r) { const int kj = kbase + crow(r, hi);
                const bool ok0 = (kj > klo) && (kj <= qi + 128), ok1 = (kj + 32 > klo) && (kj + 32 <= qi + 128);
                p0[r] = ok0 ? p0[r] : -INFINITY; p1[r] = ok1 ? p1[r] : -INFINITY; mx = fmaxf(mx, fmaxf(p0[r], p1[r])); }
            mx = fmaxf(mx, __shfl_xor(mx, 32));
            const float alpha = __builtin_amdgcn_exp2f(mrun - mx); mrun = mx;
            float ls = 0.f;
#pragma unroll
            for (int r = 0; r < 16; ++r) { p0[r] = __builtin_amdgcn_exp2f(p0[r] - mx); p1[r] = __builtin_amdgcn_exp2f(p1[r] - mx); ls += p0[r] + p1[r]; }
            ls += __shfl_xor(ls, 32);
            l = l * alpha + ls;
#pragma unroll
            for (int d0 = 0; d0 < 2; ++d0)
#pragma unroll
                for (int r = 0; r < 16; ++r) o[d0][r] *= alpha;
            const LAS unsigned char* vp = lds + 32768 + (t0 + jt) * 8192 + vboff;
#pragma unroll
            for (int ks = 0; ks < 4; ++ks) {
                const f32x16& P = (ks < 2) ? p0 : p1; const int rb = (ks & 1) * 8;
                u32x4 pw; pw.x = cvt_pk_bf16(P[rb + 0], P[rb + 1]); pw.y = cvt_pk_bf16(P[rb + 2], P[rb + 3]); pw.z = cvt_pk_bf16(P[rb + 4], P[rb + 5]); pw.w = cvt_pk_bf16(P[rb + 6], P[rb + 7]);
                const bf16x8 pb = __builtin_bit_cast(bf16x8, pw);
#pragma unroll
                for (int d0 = 0; d0 < 2; ++d0) {
                    const s16x4 lo = vtr(vp + d0 * 4096 + ks * 1024), hv = vtr(vp + d0 * 4096 + ks * 1024 + 512);
                    const bf16x8 vf = (bf16x8){lo[0], lo[1], lo[2], lo[3], hv[0], hv[1], hv[2], hv[3]};
                    o[d0] = __builtin_amdgcn_mfma_f32_32x32x16_bf16(vf, pb, o[d0], 0, 0, 0);
                }
            }
        }
        const float rl = 1.0f / l;
#pragma unroll
        for (int d0 = 0; d0 < 2; ++d0)
#pragma unroll
            for (int g4 = 0; g4 < 4; ++g4) { u32x2 w; w.x = cvt_pk_bf16(o[d0][4 * g4] * rl, o[d0][4 * g4 + 1] * rl); w.y = cvt_pk_bf16(o[d0][4 * g4 + 2] * rl, o[d0][4 * g4 + 3] * rl);
                *(LAS u32x2*)(stg + r32 * 64 + 32 * d0 + 8 * g4 + 4 * hi) = w; }
        LDS_WAIT();
        bf16_t* Ow = O + (size_t)(rowq0 + q0) * D + head * 64;
#pragma unroll
        for (int i = 0; i < 4; ++i) { const int row = i * 8 + (lane >> 3), ch = lane & 7; const u32x4 v = *(const LAS u32x4*)(stg + row * 64 + ch * 8); *(u32x4*)(Ow + (size_t)row * D + ch * 8) = v; }
        LDS_WAIT();
    }
    __syncthreads();
}

template <int W>
__device__ __forceinline__ void pool_item(const bf16_t* UB, bf16_t* MIXED, int tb, int g, int lane) {
    const int c8 = g * 128 + (lane & 15) * 8, t0 = tb * 64 + (lane >> 4) * 16, s0 = t0 & (SEQ - 1);
    u32x4 rows[W + 15];
    const bool head = (s0 == 0);
    const unsigned voff = (unsigned)(t0 * 512 + c8) * 2u;
#pragma unroll
    for (int i = 0; i < W + 15; ++i) { const int dt = i - (W - 1);
        if (dt >= 0) rows[i] = *(const u32x4*)((const char*)UB + dt * 1024 + voff);
        else { const u32x4 r = *(const u32x4*)((const char*)UB + (head ? 0 : dt * 1024) + voff); rows[i] = head ? (u32x4){0u, 0u, 0u, 0u} : r; } }
    float S[8];
#pragma unroll
    for (int c = 0; c < 8; ++c) S[c] = 0.f;
#pragma unroll
    for (int i = 0; i < W - 1; ++i)
#pragma unroll
        for (int c = 0; c < 4; ++c) { S[2 * c] += __builtin_bit_cast(float, rows[i][c] << 16); S[2 * c + 1] += __builtin_bit_cast(float, rows[i][c] & 0xffff0000u); }
#pragma unroll
    for (int j = 0; j < 16; ++j) {
        const u32x4 cur = rows[j + W - 1]; float self[8];
#pragma unroll
        for (int c = 0; c < 4; ++c) { self[2 * c] = __builtin_bit_cast(float, cur[c] << 16); self[2 * c + 1] = __builtin_bit_cast(float, cur[c] & 0xffff0000u); S[2 * c] += self[2 * c]; S[2 * c + 1] += self[2 * c + 1]; }
        const int cnt = (s0 + j + 1 < W) ? s0 + j + 1 : W; const float ic = 1.0f / (float)cnt;
        u32x4 o;
#pragma unroll
        for (int c = 0; c < 4; ++c) o[c] = pk2(S[2 * c] * ic - self[2 * c], S[2 * c + 1] * ic - self[2 * c + 1]);
        *(u32x4*)(MIXED + (size_t)(t0 + j) * D + 512 + c8) = o;
        const u32x4 old = rows[j];
#pragma unroll
        for (int c = 0; c < 4; ++c) { S[2 * c] -= __builtin_bit_cast(float, old[c] << 16); S[2 * c + 1] -= __builtin_bit_cast(float, old[c] & 0xffff0000u); }
    }
}

__global__ void __launch_bounds__(NWAVES * 64, 2) hymba_fwd(Args args) {
    extern __shared__ __attribute__((aligned(16))) unsigned char lds_raw[];
    Frame F;
    F.lds = (LAS unsigned char*)lds_raw;
    F.tid = threadIdx.x; F.lane = F.tid & 63; F.wave = __builtin_amdgcn_readfirstlane(F.tid >> 6);
    F.G = gridDim.x; F.gw = blockIdx.x * NWAVES + F.wave; F.NGW = F.G * NWAVES;
    volatile LAS unsigned* MISC = (volatile LAS unsigned*)(F.lds + L_MISC);
#define AS4 __attribute__((address_space(4)))
    const AS4 char* kbase = (const AS4 char*)__builtin_amdgcn_kernarg_segment_ptr();
#define KP_FRESH() const AS4 char* kp = kbase; asm volatile("" : "+s"(kp))
#define KIN(T, i) ((T)(*(const void* const AS4*)(kp + 8 * (i))))
#define KOUT() (*(float* const AS4*)(kp + 136))
#define KWS() (*(unsigned char* const AS4*)(kp + 144))
    gu32* ctl;
    { KP_FRESH(); ctl = (gu32*)(KWS() + WS_CTL); }
    for (int u = F.tid; u < 512 / 4; u += NWAVES * 64) ((LAS unsigned*)(F.lds + L_MISC))[u] = 0u;
    __syncthreads();
    XcdBarrier bar; bar.bar = (unsigned*)(ctl + CW_BAR); bar.x = 0; bar.st = nullptr;
    if (N_LAUNCHES == 1) bar = xcd_barrier_post((unsigned*)(ctl + CW_BAR), MISC + 8);
    int lo, hi; { KP_FRESH(); lo = *(const int AS4*)(kp + 152); hi = *(const int AS4*)(kp + 156); }
#define IN(k) (lo <= (k) && (k) < hi)
#define SEAM(k) do { if (IN(k) && IN((k) + 1)) xcd_barrier(bar); } while (0)
#ifndef DUPMASK
#define DUPMASK 0
#endif
#define REP(k) for (int rep_ = 0; rep_ < (((DUPMASK >> (k)) & 1) ? 2 : 1); ++rep_)
#define REPSEAM(k) do { if (((DUPMASK >> (k)) & 1) && rep_ == 0) xcd_barrier(bar); } while (0)
    LAS int* idxring = (LAS int*)(F.lds + L_IDX);
    LAS int* utab = (LAS int*)(F.lds + L_UTAB);

    if (IN(0)) REP(0) {
        KP_FRESH(); unsigned char* ws = KWS(); float* out = KOUT();
        const float* x = KIN(const float*, 0); const int* positions = KIN(const int*, 1); const float* norm1_w = KIN(const float*, 2); const float* w_in = KIN(const float*, 3);
        const float* pool_w = KIN(const float*, 7); const float* pool_scale = KIN(const float*, 8); const float* w_out = KIN(const float*, 9); const float* norm2_w = KIN(const float*, 10);
        const float* w_router = KIN(const float*, 11); const float* w_gu = KIN(const float*, 13); const float* w_down = KIN(const float*, 15);
        bf16_t* WIN = (bf16_t*)(ws + WS_WIN); bf16_t* WOUT = (bf16_t*)(ws + WS_WOUT); float* WR = (float*)(ws + WS_WR); float* ROPE = (float*)(ws + WS_ROPE);
        float* RS1 = (float*)(ws + WS_RS1); int* LIST = (int*)(ws + WS_LIST); unsigned char* WGU = ws + WS_WGU; unsigned char* WDN = ws + WS_WDN;
        bf16_t* XB = (bf16_t*)((unsigned char*)out + DO_XB);
        constexpr int I_IN = 16 * 20, I_OUT = 8 * 16, I_GU = 32 * 8 * 32, I_DN = 32 * 8 * 16, NITEMS = I_IN + I_OUT + I_GU + I_DN;
#pragma unroll 1
        for (int it = F.gw; it < NITEMS; it += F.NGW) {
            int r = it;
            if (r < I_GU) { const int e = r >> 8, q = r & 255, kb = q >> 5, nb = q & 31; const int rho0 = 64 * nb, pn = rho0 >> 8, rr = rho0 & 255;
                const int sc = (rr < 128) ? 128 * pn + rr : 1024 + 128 * pn + (rr - 128);
                p0_tile<32, true>(w_gu + (size_t)e * D * 2048, 2048, sc, sc + 32, 128 * kb, norm2_w, W8_SCALE, WGU + (size_t)e * 2048 * D, D, rho0, F.lane); continue; } r -= I_GU;
            if (r < I_DN) { const int e = r >> 7, q = r & 127, kb = q >> 4, nb = q & 15;
                p0_tile<32, true>(w_down + (size_t)e * FF * D, D, 64 * nb, 64 * nb + 32, 128 * kb, nullptr, W8_SCALE, WDN + (size_t)e * D * FF, FF, 64 * nb, F.lane); continue; } r -= I_DN;
            if (r < I_IN) { const int kb = r / 20, nb = r % 20; p0_tile<16, false>(w_in, NIN, win_src(64 * nb), win_src(64 * nb + 32), 64 * kb, norm1_w, 1.0f, WIN, D, 64 * nb, F.lane); continue; } r -= I_IN;
            { const int kb = r >> 4, nb = r & 15; p0_tile<16, false>(w_out, D, 64 * nb, 64 * nb + 32, 64 * kb, nullptr, 1.0f, WOUT, D, 64 * nb, F.lane); }
        }
        for (int m = 2 * F.gw; m < T; m += 2 * F.NGW) {
            const GAS f32x4* xr = (const GAS f32x4*)(x + (size_t)m * D) + F.lane;
            f32x4 v[2][4]; float s2[2] = {0.f, 0.f};
#pragma unroll
            for (int q = 0; q < 2; ++q)
#pragma unroll
                for (int j = 0; j < 4; ++j) v[q][j] = xr[q * (D / 4) + 64 * j];
#pragma unroll
            for (int q = 0; q < 2; ++q)
#pragma unroll
                for (int j = 0; j < 4; ++j) s2[q] += (v[q][j].x * v[q][j].x + v[q][j].y * v[q][j].y) + (v[q][j].z * v[q][j].z + v[q][j].w * v[q][j].w);
            s2[0] = wave_sum(s2[0]); s2[1] = wave_sum(s2[1]);
            if (F.lane < 2) RS1[m + F.lane] = 1.0f / sqrtf((F.lane ? s2[1] : s2[0]) * (1.0f / D) + NORM_EPS);
#pragma unroll
            for (int q = 0; q < 2; ++q) { GAS unsigned long long* o8 = (GAS unsigned long long*)(XB + (size_t)(m + q) * D) + F.lane;
#pragma unroll
                for (int j = 0; j < 4; ++j) o8[64 * j] = (unsigned long long)pk2(v[q][j].x, v[q][j].y) | ((unsigned long long)pk2(v[q][j].z, v[q][j].w) << 32); }
        }
        const int gt = blockIdx.x * (NWAVES * 64) + F.tid, NGT = F.G * NWAVES * 64;
        for (int it = gt; it < 512 * 1024; it += NGT) { const int cp = it >> 10, n = it & 1023, g = cp >> 7;
            const float* pw = pool_w + (size_t)cp * 128; const float* ps = pool_scale + g * 128; const float* wo = w_out + (size_t)(512 + g * 128) * D + n;
            float a = 0.f;
            for (int d = 0; d < 128; ++d) a += pw[d] * ps[d] * wo[(size_t)d * D];
            WOUT[(size_t)n * D + 512 + cp] = (bf16_t)f2bf(a); }
        for (int it = gt; it < D * NE; it += NGT) WR[it] = norm2_w[it >> 5] * w_router[it];
        for (int it = gt; it < T * 8; it += NGT) { const int t = it >> 3, p = it & 7; const float ang = (float)positions[t] * (*(const float AS4*)(kp + 160 + 4 * p)); float sn, cs; sincosf(ang, &sn, &cs); ROPE[(size_t)t * 16 + p] = cs; ROPE[(size_t)t * 16 + 8 + p] = sn; }
        for (int it = gt; it < NE * LIST_CAP / 4; it += NGT) ((u32x4*)LIST)[it] = (u32x4){0u, 0u, 0u, 0u};
        REPSEAM(0);
    }
    SEAM(0);

    if (IN(1)) REP(1) {
        KP_FRESH(); unsigned char* ws = KWS(); unsigned char* ob = (unsigned char*)KOUT();
        pg8::TabOrder S; S.tab = utab; S.list = nullptr; S.nU = pg8::build_units(utab, T / 256, NIN / 256, F.G, (int)blockIdx.x, nullptr, nullptr);
        pg8::EpiInProj E{(bf16_t*)(ob + DO_QB), (bf16_t*)(ob + DO_KB), (bf16_t*)(ob + DO_VB), (bf16_t*)(ws + WS_UB), (const float*)(ws + WS_RS1), (const float*)(ws + WS_ROPE), KIN(const float*, 4), KIN(const float*, 5)};
        pg8::gemm_phase<pg8::EpiInProj, pg8::TabOrder, 0, false, 1024, false>(F.lds, idxring, (const bf16_t*)(ob + DO_XB), (const bf16_t*)(ws + WS_WIN), S, E);
        REPSEAM(1);
    }
    SEAM(1);

    if (IN(2)) REP(2) {
        KP_FRESH(); unsigned char* ws = KWS(); unsigned char* ob = (unsigned char*)KOUT(); const float* sinks = KIN(const float*, 6);
        const bf16_t* QB = (const bf16_t*)(ob + DO_QB); const bf16_t* KB = (const bf16_t*)(ob + DO_KB); const bf16_t* VB = (const bf16_t*)(ob + DO_VB);
        bf16_t* MIXED = (bf16_t*)(ws + WS_MIXED); const bf16_t* UB = (const bf16_t*)(ws + WS_UB);
        for (int uid = blockIdx.x; uid < NB * 2 * 32; uid += F.G) { const int qblk = uid & 31, kvh = (uid >> 5) & 1, b = uid >> 6; attn_unit(F, b, kvh, qblk, QB, KB, VB, MIXED, sinks); }
#pragma unroll 1
        for (int it = F.gw; it < (T / 64) * 4; it += F.NGW) { const int g = it & 3, tb = it >> 2;
            if (g == 0) pool_item<2>(UB, MIXED, tb, 0, F.lane); else if (g == 1) pool_item<4>(UB, MIXED, tb, 1, F.lane); else if (g == 2) pool_item<8>(UB, MIXED, tb, 2, F.lane); else pool_item<16>(UB, MIXED, tb, 3, F.lane); }
        REPSEAM(2);
    }
    SEAM(2);

    if (IN(3)) REP(3) {
        KP_FRESH(); unsigned char* ws = KWS();
        pg8::TabOrder S; S.tab = utab; S.list = nullptr; S.nU = pg8::build_units(utab, T / 256, D / 256, F.G, (int)blockIdx.x, nullptr, nullptr);
        pg8::EpiOutProj E{KIN(const float*, 0), KOUT(), ws + WS_H8};
        pg8::gemm_phase<pg8::EpiOutProj, pg8::TabOrder, 0, false, 1024, false>(F.lds, idxring, (const bf16_t*)(ws + WS_MIXED), (const bf16_t*)(ws + WS_WOUT), S, E);
        REPSEAM(3);
    }
    SEAM(3);

    if (IN(4)) {
        KP_FRESH(); unsigned char* ws = KWS(); const float* out = KOUT(); const float* b_router = KIN(const float*, 12);
        const float* WR = (const float*)(ws + WS_WR); float* RS2 = (float*)(ws + WS_RS2); float* GATE = (float*)(ws + WS_GATE); int* LIST = (int*)(ws + WS_LIST);
        LAS float* wr = (LAS float*)F.lds;
        for (int i = F.tid; i < D * NE / 4; i += NWAVES * 64) ((LAS f32x4*)wr)[i] = ((const f32x4*)WR)[i];
        LAS int* hist = (LAS int*)(F.lds + L_RH); LAS int* hbase = hist + 32;
        LAS float* lg = (LAS float*)(F.lds + L_RSCR + F.wave * 2112);
        const int r32 = F.lane & 31, hh = F.lane >> 5;
        for (int blk = blockIdx.x; blk < T / 256; blk += F.G) {
            if (F.tid < 32) hist[F.tid] = 0;
            __syncthreads();
            const int tok0 = blk * 256 + F.wave * 32;
            const float* hrow = out + (size_t)(tok0 + r32) * D + 512 * hh;
            f32x16 acc = {}; float ss = 0.f;
#pragma unroll 2
            for (int it = 0; it < 32; ++it) {
                f32x4 a[4];
#pragma unroll
                for (int q = 0; q < 4; ++q) a[q] = *(const f32x4*)(hrow + 16 * it + 4 * q);
#pragma unroll
                for (int q = 0; q < 4; ++q)
#pragma unroll
                    for (int c = 0; c < 4; ++c) { const float av = a[q][c]; ss += av * av; const float bv = wr[(512 * hh + 16 * it + 4 * q + c) * 32 + r32]; acc = __builtin_amdgcn_mfma_f32_32x32x2f32(av, bv, acc, 0, 0, 0); }
            }
            ss += __shfl_xor(ss, 32);
            const float rs = 1.0f / sqrtf(ss * (1.0f / D) + NORM_EPS);
            const int tok = tok0 + r32;
            if (hh == 0) RS2[tok] = rs;
            int sel[4]; float gv[4]; int lpos[4];
#pragma unroll
            for (int pass = 0; pass < 2; ++pass) {
#pragma unroll
                for (int r = 0; r < 8; ++r) { const int rr = 8 * pass + r; const int i = crow(rr, hh) - 16 * pass; lg[i * 33 + r32] = acc[rr]; }
                LDS_WAIT(); asm volatile("" ::: "memory");
                if ((r32 >> 4) == pass && hh == 0) {
                    const int i = r32 & 15; float v[32];
#pragma unroll
                    for (int e = 0; e < 32; ++e) v[e] = lg[i * 33 + e] * rs + b_router[e];
                    unsigned taken = 0u;
#pragma unroll
                    for (int k = 0; k < 4; ++k) { float best = -INFINITY; int bi = 0;
#pragma unroll
                        for (int e = 0; e < 32; ++e) { const bool ok = !((taken >> e) & 1u) && v[e] > best; best = ok ? v[e] : best; bi = ok ? e : bi; }
                        taken |= 1u << bi; sel[k] = bi; gv[k] = best; }
                    const float e1 = __expf(gv[1] - gv[0]), e2 = __expf(gv[2] - gv[0]), e3 = __expf(gv[3] - gv[0]); const float inv = 1.0f / (1.0f + e1 + e2 + e3);
                    gv[0] = inv; gv[1] = e1 * inv; gv[2] = e2 * inv; gv[3] = e3 * inv;
#pragma unroll
                    for (int k = 0; k < 4; ++k) lpos[k] = __hip_atomic_fetch_add(&hist[sel[k]], 1, __ATOMIC_RELAXED, __HIP_MEMORY_SCOPE_WORKGROUP);
                }
                LDS_WAIT(); asm volatile("" ::: "memory");
            }
            __syncthreads();
            if (F.tid < 32) hbase[F.tid] = (int)__hip_atomic_fetch_add((unsigned*)(ctl + CW_CNT + F.tid), (unsigned)hist[F.tid], RLX_AGENT);
            __syncthreads();
            if (hh == 0) {
#pragma unroll
                for (int k = 0; k < 4; ++k) { const int aid = tok * 4 + k; GATE[aid] = gv[k]; LIST[(size_t)sel[k] * LIST_CAP + hbase[sel[k]] + lpos[k]] = aid; }
            }
            __syncthreads();
        }
    }
    SEAM(4);

    {
        LAS int* cntl = (LAS int*)(F.lds + L_CNT); LAS int* tinfo = (LAS int*)(F.lds + L_TINFO); LAS int* pref = (LAS int*)(F.lds + L_PREF);
        int nMt = 0;
        if (IN(5) || IN(6)) {
            __syncthreads();
            if (F.tid < 32) cntl[F.tid] = (int)__hip_atomic_load((unsigned*)(ctl + CW_CNT + F.tid), RLX_AGENT);
            __syncthreads();
            if (F.tid == 0) { int a = 0; for (int e = 0; e < 32; ++e) { pref[e] = a; a += (cntl[e] + 255) >> 8; } pref[32] = a; }
            __syncthreads();
            nMt = pref[32];
            for (int e = 0; e < 32; ++e) { const int p0 = pref[e], n = pref[e + 1] - p0; for (int j = F.tid; j < n; j += NWAVES * 64) tinfo[p0 + j] = e | (j << 8); }
            __syncthreads();
        }
        if (IN(5)) REP(5) {
            KP_FRESH(); unsigned char* ws = KWS();
            pg8::TabOrder S; S.tab = utab; S.list = (const int*)(ws + WS_LIST); S.nU = pg8::build_units(utab, nMt, 8, F.G, (int)blockIdx.x, tinfo, cntl);
            pg8::EpiGU E{ws + WS_ACT, (const float*)(ws + WS_RS2), KIN(const float*, 14)};
            pg8::gemm_phase<pg8::EpiGU, pg8::TabOrder, 1, true, 512, true>(F.lds, idxring, ws + WS_H8, ws + WS_WGU, S, E);
            REPSEAM(5);
        }
        SEAM(5);
        if (IN(6)) REP(6) {
            KP_FRESH(); unsigned char* ws = KWS();
            pg8::TabOrder S; S.tab = utab; S.list = (const int*)(ws + WS_LIST); S.nU = pg8::build_units(utab, nMt, 4, F.G, (int)blockIdx.x, tinfo, cntl);
            pg8::EpiDown E{(bf16_t*)(ws + WS_Y), (const float*)(ws + WS_GATE), KIN(const float*, 16)};
            pg8::gemm_phase<pg8::EpiDown, pg8::TabOrder, 0, true, 512, true>(F.lds, idxring, ws + WS_ACT, ws + WS_WDN, S, E);
            REPSEAM(6);
        }
        SEAM(6);
        if (IN(7)) {
            KP_FRESH(); float* out = KOUT(); const bf16_t* YB = (const bf16_t*)(KWS() + WS_Y);
            const int gt = blockIdx.x * (NWAVES * 64) + F.tid, NGT = F.G * NWAVES * 64;
            for (int it = gt; it < T * 128; it += NGT) { const int tl = it >> 7, c8 = (it & 127) * 8; const size_t o = (size_t)tl * D + c8;
                f32x4 h0 = *(const f32x4*)(out + o), h1 = *(const f32x4*)(out + o + 4);
#pragma unroll
                for (int k = 0; k < 4; ++k) { const u32x4 v = *(const u32x4*)(YB + (size_t)(tl * 4 + k) * D + c8);
                    h0[0] += __builtin_bit_cast(float, v[0] << 16); h0[1] += __builtin_bit_cast(float, v[0] & 0xffff0000u); h0[2] += __builtin_bit_cast(float, v[1] << 16); h0[3] += __builtin_bit_cast(float, v[1] & 0xffff0000u);
                    h1[0] += __builtin_bit_cast(float, v[2] << 16); h1[1] += __builtin_bit_cast(float, v[2] & 0xffff0000u); h1[2] += __builtin_bit_cast(float, v[3] << 16); h1[3] += __builtin_bit_cast(float, v[3] & 0xffff0000u); }
                *(f32x4*)(out + o) = h0; *(f32x4*)(out + o + 4) = h1; }
        }
    }
#undef IN
#undef SEAM
}

extern "C" void kernel_launch(void* const* d_in, const int* in_sizes, int n_in, void* d_out, int out_size, void* d_ws, size_t ws_size, hipStream_t stream) {
    static int grid = 0;
    if (grid == 0) {
        if (n_in != 17 || out_size != T * D || ws_size < WS_END) { fprintf(stderr, "kernel_launch: unexpected shapes (n_in %d out %d ws %zu)\n", n_in, out_size, ws_size); grid = -1; return; }
        int dev = 0, cus = 0, per_cu = 0;
        if (hipGetDevice(&dev) != hipSuccess || hipDeviceGetAttribute(&cus, hipDeviceAttributeMultiprocessorCount, dev) != hipSuccess) { grid = -1; return; }
        if (hipFuncSetAttribute((const void*)hymba_fwd, hipFuncAttributeMaxDynamicSharedMemorySize, LDS_BYTES) != hipSuccess) { fprintf(stderr, "kernel_launch: hipFuncSetAttribute failed\n"); grid = -1; return; }
        if (hipOccupancyMaxActiveBlocksPerMultiprocessor(&per_cu, (const void*)hymba_fwd, NWAVES * 64, LDS_BYTES) != hipSuccess || per_cu < 1) { fprintf(stderr, "kernel_launch: occupancy query says %d\n", per_cu); }
        (void)hipGetLastError();
        grid = cus;
    }
    if (grid < 0) return;
    (void)hipMemsetAsync((char*)d_ws + WS_CTL, 0, CTL_ZERO_BYTES, stream);
    Args a{};
    for (int i = 0; i < 17; ++i) a.in[i] = d_in[i];
    a.out = (float*)d_out; a.ws = (unsigned char*)d_ws;
    for (int p = 0; p < 8; ++p) a.invf[p] = (float)pow(500000.0, -(double)p / 8.0);
    if (N_LAUNCHES == 1) { a.ph_lo = 0; a.ph_hi = NPH; hipLaunchKernelGGL(hymba_fwd, dim3(grid), dim3(NWAVES * 64), LDS_BYTES, stream, a); }
    else for (int li = 0; li < NPH; ++li) { a.ph_lo = li; a.ph_hi = li + 1; hipLaunchKernelGGL(hymba_fwd, dim3(grid), dim3(NWAVES * 64), LDS_BYTES, stream, a); }
}
```

```cpp
#include <hip/hip_runtime.h>
#include <cstdio>
#include <cstdint>
#include <cmath>

#ifndef MK_N_LAUNCHES
#define MK_N_LAUNCHES 1
#endif

#define LAS __attribute__((address_space(3)))
#define GAS __attribute__((address_space(1)))
typedef unsigned short bf16_t;
typedef short bf16x8 __attribute__((ext_vector_type(8)));
typedef short s16x4 __attribute__((ext_vector_type(4)));
typedef float f32x4 __attribute__((ext_vector_type(4)));
typedef float f32x2 __attribute__((ext_vector_type(2)));
typedef float f32x16 __attribute__((ext_vector_type(16)));
typedef unsigned u32x4 __attribute__((ext_vector_type(4)));
typedef unsigned u32x2 __attribute__((ext_vector_type(2)));
typedef GAS unsigned gu32;
typedef int v4i32 __attribute__((ext_vector_type(4)));
typedef int v8i32 __attribute__((ext_vector_type(8)));

constexpr int NB = 16, SEQ = 4096, T = NB * SEQ, D = 1024, NIN = 1280, NE = 32, FF = 1024;
constexpr int LIST_CAP = T;
constexpr float NORM_EPS = 1e-5f, QK_EPS = 1e-6f;
constexpr float LOG2E = 1.4426950408889634f;
constexpr float C2 = 0.125f * LOG2E;
constexpr int NWAVES = 8;
constexpr int NPH = 8;
constexpr int N_LAUNCHES = MK_N_LAUNCHES;
constexpr float W8_SCALE = 64.0f;
constexpr int SCALE_ONE = 0x7F7F7F7F, SCALE_W = 0x79797979;
constexpr float Y8_SCALE = 16.0f;

constexpr size_t MiB = 1u << 20;
constexpr size_t WS_CTL = 0, CTL_ZERO_BYTES = 1 * MiB;
constexpr size_t WS_WIN = 1 * MiB;
constexpr size_t WS_WOUT = 4 * MiB;
constexpr size_t WS_WR = 6 * MiB;
constexpr size_t WS_ROPE = 7 * MiB;
constexpr size_t WS_RS1 = 11 * MiB;
constexpr size_t WS_RS2 = 11 * MiB + 512 * 1024;
constexpr size_t WS_GATE = 12 * MiB;
constexpr size_t WS_LIST = 13 * MiB;
constexpr size_t WS_WGU = 22 * MiB;
constexpr size_t WS_WDN = 86 * MiB;
constexpr size_t WS_H8 = 118 * MiB;
constexpr size_t WS_UB = 182 * MiB;
constexpr size_t WS_MIXED = 246 * MiB;
constexpr size_t WS_ACT = 182 * MiB;
constexpr size_t WS_Y = 446 * MiB;
constexpr size_t WS_HM = 702 * MiB;
constexpr size_t WS_END = 830 * MiB;
constexpr int ACT_SLOTS = T * 4 + NE * 256;
static_assert(WS_ACT + (size_t)ACT_SLOTS * 1024 <= WS_Y, "act");
constexpr size_t DO_XB = 0, DO_QB = 128 * MiB, DO_KB = 192 * MiB, DO_VB = 208 * MiB;
constexpr int CW_CNT = 64;
constexpr int CW_BAR = 4096;

constexpr int RING_BYTES = 131072;
constexpr int L_MISC = RING_BYTES;
constexpr int L_CNT = RING_BYTES + 512;
constexpr int L_PREF = RING_BYTES + 640;
constexpr int L_IDX = RING_BYTES + 1024;
constexpr int L_TINFO = RING_BYTES + 4096;
constexpr int L_RSCR = RING_BYTES + 8704;
constexpr int L_RH = RING_BYTES + 25600;
constexpr int L_UTAB = RING_BYTES + 26624;
constexpr int LDS_BYTES = RING_BYTES + 27648;

#define RLX_AGENT __ATOMIC_RELAXED, __HIP_MEMORY_SCOPE_AGENT
#define LDS_WAIT() asm volatile("s_waitcnt lgkmcnt(0)" ::: "memory")
#define VM_WAIT() asm volatile("s_waitcnt vmcnt(0)" ::: "memory")

__device__ __forceinline__ unsigned f2bf(float f) { unsigned u = __builtin_bit_cast(unsigned, f); return (u + 0x7fffu + ((u >> 16) & 1u)) >> 16; }
__device__ __forceinline__ unsigned pk2(float lo, float hi) { return f2bf(lo) | (f2bf(hi) << 16); }
__device__ __forceinline__ unsigned cvt_pk_bf16(float lo, float hi) { unsigned r; asm volatile("v_cvt_pk_bf16_f32 %0, %1, %2" : "=v"(r) : "v"(lo), "v"(hi)); return r; }
__device__ __forceinline__ unsigned pk4_fp8(float a, float b, float c, float d) { unsigned w = 0; w = __builtin_amdgcn_cvt_pk_fp8_f32(a, b, w, false); w = __builtin_amdgcn_cvt_pk_fp8_f32(c, d, w, true); return w; }
__device__ __forceinline__ float bf2f(unsigned short b) { return __builtin_bit_cast(float, (unsigned)b << 16); }

#define XB_TMO      128
#define XB_XCNT(j)  (256  + 64 * (j))
#define XB_XSUB(j)  (1280 + 64 * (j))
#define XB_XGEN(j)  (2304 + 64 * (j))
#define XB_TOP      3328
#define XB_TOPGEN   3392
#define XCD_BAR_WORDS 3456
#define XB_SPIN_CAP (1u << 23)
__device__ __forceinline__ unsigned xb_ld(unsigned* p)              { return __hip_atomic_load(p, __ATOMIC_RELAXED, __HIP_MEMORY_SCOPE_AGENT); }
__device__ __forceinline__ unsigned xb_add(unsigned* p, unsigned v) { return __hip_atomic_fetch_add(p, v, __ATOMIC_RELAXED, __HIP_MEMORY_SCOPE_AGENT); }
__device__ __forceinline__ unsigned xb_xcc_id() { return (unsigned)__builtin_amdgcn_s_getreg((3 << 11) | 20) & 0xFu; }
#define XB_SPIN(cond, bar) do { unsigned _sp = 0; while (cond) { __builtin_amdgcn_s_sleep(1); \
    if ((++_sp & 255u) == 0u) { if (xb_ld(&(bar)[XB_TMO])) break; if (_sp > XB_SPIN_CAP) { atomicAdd(&(bar)[XB_TMO], 1u); break; } } } } while (0)
struct XcdBarrier { unsigned* bar; unsigned x; volatile LAS unsigned* st; };
__device__ __forceinline__ XcdBarrier xcd_barrier_post(unsigned* bar, volatile LAS unsigned* st) {
    XcdBarrier b; b.bar = bar; b.x = xb_xcc_id(); b.st = st;
    if (threadIdx.x == 0) (void)xb_add(&bar[XB_XCNT(b.x)], 1u);
    return b;
}
__device__ __forceinline__ void xcd_barrier_complete(unsigned* bar, unsigned x, unsigned& nloc, unsigned& nx) {
    const unsigned G = gridDim.x * gridDim.y * gridDim.z;
    unsigned sum, cnt, mine, sp = 0u;
    for (;;) {
        sum = 0u; cnt = 0u; mine = 0u;
#pragma unroll
        for (unsigned j = 0; j < 16; ++j) { const unsigned c = xb_ld(&bar[XB_XCNT(j)]); sum += c; cnt += (c > 0u) ? 1u : 0u; mine = (j == x) ? c : mine; }
        if (sum == G) break;
        __builtin_amdgcn_s_sleep(1);
        if ((++sp & 255u) == 0u) { if (xb_ld(&bar[XB_TMO])) break; if (sp > XB_SPIN_CAP) { atomicAdd(&bar[XB_TMO], 1u); break; } }
    }
    nloc = mine > 0u ? mine : 1u; nx = cnt > 0u ? cnt : 1u;
}
__device__ __forceinline__ void xcd_barrier(const XcdBarrier& b) {
    asm volatile("s_waitcnt vmcnt(0)" ::: "memory");
    __syncthreads();
    if (threadIdx.x == 0) {
        unsigned* bar = b.bar;
        __builtin_amdgcn_s_waitcnt(0);
        unsigned nloc = b.st[0], nx = b.st[1];
        if (nloc == 0u) { xcd_barrier_complete(bar, b.x, nloc, nx); b.st[0] = nloc; b.st[1] = nx; }
        const unsigned old = xb_add(&bar[XB_XSUB(b.x)], 1u);
        const unsigned gen = old / nloc;
        if (old + 1u == (gen + 1u) * nloc) {
            __builtin_amdgcn_fence(__ATOMIC_RELEASE, "agent");
            asm volatile("s_waitcnt vmcnt(0)" ::: "memory");
            const unsigned og = xb_add(&bar[XB_TOP], 1u);
            const unsigned tg = og / nx;
            if (og + 1u == (tg + 1u) * nx) xb_add(&bar[XB_TOPGEN], 1u);
            else XB_SPIN(xb_ld(&bar[XB_TOPGEN]) == tg, bar);
            __builtin_amdgcn_fence(__ATOMIC_ACQUIRE, "agent");
            xb_add(&bar[XB_XGEN(b.x)], 1u);
            asm volatile("s_waitcnt vmcnt(0)" ::: "memory");
        } else {
            XB_SPIN(xb_ld(&bar[XB_XGEN(b.x)]) == gen, bar);
            __builtin_amdgcn_fence(__ATOMIC_ACQUIRE, "agent");
            asm volatile("s_waitcnt vmcnt(0)" ::: "memory");
        }
    }
    __syncthreads();
}

namespace pg8 {
constexpr int BM = 256, BK = 64, HALF = 128, HTB = HALF * BK * 2, NXCD = 8, WGM = 8;
__host__ __device__ __forceinline__ int lds_byte(int r, int c) { const int st = (r >> 4) * 2 + (c >> 5), rr = r & 15, cc = c & 31, ob = rr * 64 + cc * 2; return st * 1024 + (ob ^ (((ob >> 9) & 1) << 5)); }
__host__ __device__ __forceinline__ void stage_rc(int b, int& R, int& C) { const int st = b / 1024, sb = b % 1024, swz = sb ^ (((sb >> 9) & 1) << 5); R = (st >> 1) * 16 + swz / 64; C = (st & 1) * 32 + (swz % 64) / 2; }
__host__ __device__ __forceinline__ int perm32(int rho) { const int n = rho >> 4, i = rho & 15; return 8 * (i >> 2) + 4 * n + (i & 3); }

union Frag { v8i32 v; bf16x8 pc[2]; };
struct Unit { int pm, pn, bt, e, j, nvalid; };

__device__ __forceinline__ bool order_tile(int i, int nM, int nN, int G, int c, int& pm, int& pn) {
    const int nwg = nM * nN; const long L = (long)i * G + c; if (L >= nwg) return false;
    int wgid = (int)L; { const int q = nwg / NXCD, r = nwg % NXCD, xcd = wgid % NXCD, off = wgid / NXCD; wgid = (xcd < r ? xcd * (q + 1) : r * (q + 1) + (xcd - r) * q) + off; }
    const int nig = WGM * nN, gid = wgid / nig, fm = gid * WGM, gsz = (nM - fm) < WGM ? (nM - fm) : WGM;
    pm = fm + ((wgid % nig) % gsz); pn = (wgid % nig) / gsz; return true;
}
constexpr int MAX_UNITS = 64;
__device__ __forceinline__ int build_units(LAS int* tab, int nM, int nN, int G, int c, const LAS int* tinfo, const LAS int* cnt) {
    const int nwg = nM * nN; const int nU = (nwg > c) ? (nwg - c + G - 1) / G : 0;
    __syncthreads();
    const int i = threadIdx.x;
    if (i < nU && i < MAX_UNITS) { int pm = 0, pn = 0; order_tile(i, nM, nN, G, c, pm, pn);
        int e = 0, j = 0, nv = 256;
        if (tinfo) { const int ti = tinfo[pm]; e = ti & 255; j = ti >> 8; const int c_ = cnt[e] - 256 * j; nv = c_ < 256 ? c_ : 256; }
        tab[4 * i] = pm; tab[4 * i + 1] = pn; tab[4 * i + 2] = e * nN + pn; tab[4 * i + 3] = e | (j << 8) | (nv << 20); }
    __syncthreads();
    return nU < MAX_UNITS ? nU : MAX_UNITS;
}
struct TabOrder {
    const LAS int* tab; int nU; const int* list;
    __device__ __forceinline__ bool next(int i, Unit& u) const {
        if (i >= nU) return false;
        const int w3 = __builtin_amdgcn_readfirstlane(tab[4 * i + 3]);
        u.pm = __builtin_amdgcn_readfirstlane(tab[4 * i]); u.pn = __builtin_amdgcn_readfirstlane(tab[4 * i + 1]); u.bt = __builtin_amdgcn_readfirstlane(tab[4 * i + 2]);
        u.e = w3 & 255; u.j = (w3 >> 8) & 4095; u.nvalid = w3 >> 20; return true;
    }
    __device__ __forceinline__ const int* idx_src(const Unit& u) const { return list + (size_t)u.e * LIST_CAP + 256 * u.j; }
};

template <class Epi, class Sched, int AMODE, bool HAS_IDX, int K, bool F8, bool ALIGN_EPI = true>
__device__ __forceinline__ void gemm_phase(LAS unsigned char* lds, LAS int* idxring, const void* Ag, const void* Btg, const Sched& S, const Epi& E) {
    const int tid = threadIdx.x, wid = __builtin_amdgcn_readfirstlane(tid >> 6), lane = tid & 63, wr = wid >> 2, wc = wid & 3, fr = lane & 15, fq = lane >> 4;
    const int nt = K / BK;
    unsigned voffB[2];
#pragma unroll
    for (int i = 0; i < 2; ++i) { int R, C; stage_rc(tid * 16 + i * 8192, R, C); const int Rb = Epi::PERM ? ((R & ~31) + perm32(R & 31)) : R; voffB[i] = (unsigned)(Rb * K + C) * 2u; }
    const size_t kstep = (size_t)(BK * 2);
    const size_t hstep = (size_t)HALF * K * 2;
    const size_t tstep = 2 * hstep;
    const unsigned ldsw = (unsigned)wid * 1024u;
    const int aoff = lds_byte(wr * 64 + fr, fq * 8), boff = lds_byte(wc * 32 + fr, fq * 8);
#define PG8_SA(b, h) (((b) * 2 + (h)) * HTB)
#define PG8_SB(b, h) ((4 + (b) * 2 + (h)) * HTB)
#define PG8_STAGE_B(bufoff, gbase) do { _Pragma("unroll") for (int _i = 0; _i < 2; ++_i) \
        __builtin_amdgcn_global_load_lds((const unsigned*)((const char*)(gbase) + voffB[_i]), (LAS unsigned*)(lds + (bufoff) + ldsw + _i * 8192), 16, 0, 0); } while (0)
#define PG8_STAGE_A(bufoff, kb, AO, h) do { _Pragma("unroll") for (int _i = 0; _i < 2; ++_i) \
        __builtin_amdgcn_global_load_lds((const unsigned*)((const char*)Ag + (kb) + (AO)[h][_i]), (LAS unsigned*)(lds + (bufoff) + ldsw + _i * 8192), 16, 0, 0); } while (0)
#define PG8_LDA(dst, b, h) do { _Pragma("unroll") for (int m = 0; m < 4; ++m) _Pragma("unroll") for (int k = 0; k < 2; ++k) dst[m][k] = *(const LAS bf16x8*)(lds + PG8_SA(b, h) + aoff + m * 2048 + k * 1024); } while (0)
#define PG8_LDB(dst, b, h) do { _Pragma("unroll") for (int n = 0; n < 2; ++n) _Pragma("unroll") for (int k = 0; k < 2; ++k) dst[n][k] = *(const LAS bf16x8*)(lds + PG8_SB(b, h) + boff + n * 2048 + k * 1024); } while (0)
#define PG8_MMA(ai, bj, At, Bt) do { __builtin_amdgcn_s_setprio(1); _Pragma("unroll") for (int m = 0; m < 4; ++m) _Pragma("unroll") for (int n = 0; n < 2; ++n) { \
        if constexpr (F8) { \
            const v8i32 bv_ = __builtin_shufflevector(__builtin_bit_cast(v4i32, Bt[n][0]), __builtin_bit_cast(v4i32, Bt[n][1]), 0, 1, 2, 3, 4, 5, 6, 7); \
            const v8i32 av_ = __builtin_shufflevector(__builtin_bit_cast(v4i32, At[m][0]), __builtin_bit_cast(v4i32, At[m][1]), 0, 1, 2, 3, 4, 5, 6, 7); \
            acc[ai][bj][m][n] = __builtin_amdgcn_mfma_scale_f32_16x16x128_f8f6f4(bv_, av_, acc[ai][bj][m][n], 0, 0, 0, SCALE_W, 0, SCALE_ONE); } \
        else { _Pragma("unroll") for (int k = 0; k < 2; ++k) acc[ai][bj][m][n] = __builtin_amdgcn_mfma_f32_16x16x32_bf16(Bt[n][k], At[m][k], acc[ai][bj][m][n], 0, 0, 0); } } \
        __builtin_amdgcn_s_setprio(0); } while (0)
#define PG8_WAIT_V(n) asm volatile("s_waitcnt vmcnt(" #n ")" ::: "memory")
#define PG8_WAIT_L(n) asm volatile("s_waitcnt lgkmcnt(" #n ")" ::: "memory")
#define PG8_BAR __builtin_amdgcn_s_barrier()
#define PG8_SCHED __builtin_amdgcn_sched_barrier(0)
#define PG8_AOFF(dst, U, islot) do { int _t = tid; asm volatile("" : "+v"(_t)); _Pragma("unroll") for (int _i = 0; _i < 2; ++_i) { int _R, _C; stage_rc(_t * 16 + _i * 8192, _R, _C); \
        _Pragma("unroll") for (int _h = 0; _h < 2; ++_h) { \
        int _row; if (AMODE == 0) _row = (U).pm * BM + _h * HALF + _R; else _row = idxring[(islot) * 256 + _h * HALF + _R] >> 2; \
        dst[_h][_i] = ((unsigned)_row * (unsigned)K + (unsigned)_C) * 2u; } } } while (0)
    Unit cur, nxt; int ui = 0, islot = 0;
    if (!S.next(0, cur)) return;
    if (HAS_IDX) {
        if (wid == 0) { __builtin_amdgcn_global_load_lds((const unsigned*)(S.idx_src(cur) + lane * 4), (LAS unsigned*)(idxring), 16, 0, 0); PG8_WAIT_V(0); }
        __syncthreads();
    }
    f32x4 acc[2][2][4][2];
#define PG8_ACC_INIT(U) do { if constexpr (Epi::INIT) E.init(acc, U, wr, wc, fr, fq); else { \
        _Pragma("unroll") for (int a = 0; a < 2; ++a) _Pragma("unroll") for (int b = 0; b < 2; ++b) _Pragma("unroll") for (int m = 0; m < 4; ++m) _Pragma("unroll") for (int n = 0; n < 2; ++n) \
            acc[a][b][m][n] = (f32x4){0.f, 0.f, 0.f, 0.f}; } } while (0)
    PG8_ACC_INIT(cur);
    bf16x8 At[4][2], B0[2][2], B1[2][2];
    unsigned ao[2][2];
    PG8_AOFF(ao, cur, 0);
    const char* cB = (const char*)Btg + (size_t)cur.bt * tstep;
    PG8_STAGE_B(PG8_SB(0, 0), cB); PG8_STAGE_B(PG8_SB(0, 1), cB + hstep); PG8_STAGE_A(PG8_SA(0, 0), 0, ao, 0); PG8_STAGE_A(PG8_SA(0, 1), 0, ao, 1);
    if (wr == 1) PG8_BAR;
    PG8_WAIT_V(2); PG8_BAR;
    PG8_STAGE_B(PG8_SB(1, 0), cB + kstep); PG8_STAGE_A(PG8_SA(1, 0), kstep, ao, 0); PG8_STAGE_B(PG8_SB(1, 1), cB + hstep + kstep);
    PG8_WAIT_V(6); PG8_BAR;
    for (;;) {
        const bool has_next = S.next(ui + 1, nxt);
        const int nslot = (islot == 2) ? 0 : islot + 1;
        if (HAS_IDX && has_next && wid == 0)
            __builtin_amdgcn_global_load_lds((const unsigned*)(S.idx_src(nxt) + lane * 4), (LAS unsigned*)(idxring + nslot * 256), 16, 0, 0);
        const char* nB = has_next ? (const char*)Btg + (size_t)nxt.bt * tstep : cB;
#pragma unroll 1
        for (int t = 0; t < nt; t += 2) {
            const bool last = (t == nt - 2);
            const size_t k1 = (size_t)(t + 1) * kstep;
            const size_t k2 = last ? 0 : (size_t)(t + 2) * kstep, k3 = k2 + kstep;
            const char* b2 = last ? nB : cB + (size_t)(t + 2) * kstep; const char* b3 = b2 + kstep;
            PG8_LDB(B0, 0, 0); PG8_LDB(B1, 0, 1); PG8_SCHED; PG8_LDA(At, 0, 0); PG8_STAGE_A(PG8_SA(1, 1), k1, ao, 1);
            if (last && has_next) { PG8_AOFF(ao, nxt, nslot); }
            PG8_WAIT_V(8); PG8_WAIT_L(0); PG8_BAR; PG8_MMA(0, 0, At, B0); PG8_MMA(0, 1, At, B1); PG8_BAR; PG8_SCHED;
            PG8_LDA(At, 0, 1); PG8_STAGE_B(PG8_SB(0, 0), b2); PG8_STAGE_B(PG8_SB(0, 1), b2 + hstep); PG8_STAGE_A(PG8_SA(0, 0), k2, ao, 0);
            PG8_WAIT_V(8); PG8_WAIT_L(0); PG8_BAR; PG8_MMA(1, 0, At, B0); PG8_MMA(1, 1, At, B1); PG8_BAR; PG8_SCHED;
            PG8_LDB(B0, 1, 0); PG8_LDB(B1, 1, 1); PG8_SCHED; PG8_LDA(At, 1, 0); PG8_STAGE_A(PG8_SA(0, 1), k2, ao, 1);
            PG8_WAIT_V(8); PG8_WAIT_L(0); PG8_BAR; PG8_MMA(0, 0, At, B0); PG8_MMA(0, 1, At, B1); PG8_BAR; PG8_SCHED;
            PG8_LDA(At, 1, 1); PG8_STAGE_B(PG8_SB(1, 0), b3); PG8_STAGE_B(PG8_SB(1, 1), b3 + hstep); PG8_STAGE_A(PG8_SA(1, 0), k3, ao, 0);
            PG8_WAIT_V(8); PG8_WAIT_L(0); PG8_BAR; PG8_MMA(1, 0, At, B0); PG8_MMA(1, 1, At, B1); PG8_BAR; PG8_SCHED;
        }
        if (ALIGN_EPI) { if (wr == 0) PG8_BAR; }
        E(acc, cur, wr, wc, fr, fq, (const LAS int*)(idxring + islot * 256));
        if (!has_next) break;
        PG8_ACC_INIT(nxt);
        cur = nxt; cB = nB; ++ui; islot = nslot;
        if (ALIGN_EPI) { if (wr == 1) PG8_BAR; }
    }
    PG8_WAIT_V(0);
    if (!ALIGN_EPI) { if (wr == 0) PG8_BAR; }
    PG8_BAR;
#undef PG8_SA
#undef PG8_SB
#undef PG8_STAGE_A
#undef PG8_STAGE_B
#undef PG8_LDA
#undef PG8_LDB
#undef PG8_MMA
#undef PG8_WAIT_V
#undef PG8_WAIT_L
#undef PG8_BAR
#undef PG8_SCHED
#undef PG8_AOFF
#undef PG8_ACC_INIT
}

__device__ __forceinline__ u32x4 pack8(const f32x4 a, const f32x4 b) { u32x4 w; w.x = cvt_pk_bf16(a[0], a[1]); w.y = cvt_pk_bf16(a[2], a[3]); w.z = cvt_pk_bf16(b[0], b[1]); w.w = cvt_pk_bf16(b[2], b[3]); return w; }

struct EpiInProj {
    static constexpr bool PERM = true, INIT = false;
    bf16_t *Q, *Kb, *Vb, *U; const float *rs1, *rope, *qw, *kw;
    __device__ __forceinline__ void operator()(const f32x4 (&acc)[2][2][4][2], const Unit& u, int wr, int wc, int fr, int fq, const LAS int*) const {
        const int row0 = u.pm * BM + wr * 64 + fr;
        if (u.pn >= 3) {
#pragma unroll
            for (int ai = 0; ai < 2; ++ai)
#pragma unroll
                for (int m = 0; m < 4; ++m) { const int row = row0 + ai * HALF + m * 16; const float s = rs1[row];
                    bf16_t* rp = U + (size_t)row * 512 + (u.pn - 3) * 256 + wc * 32 + 8 * fq;
#pragma unroll
                    for (int bj = 0; bj < 2; ++bj) *(u32x4*)(rp + bj * HALF) = pack8(acc[ai][bj][m][0] * s, acc[ai][bj][m][1] * s); }
            return;
        }
        const bool isv = (u.pn == 2 && wc >= 2);
        bf16_t* dst; int ld; const float* w; float post;
        if (u.pn < 2) { dst = Q + (4 * u.pn + wc) * 64; ld = 512; w = qw; post = C2; }
        else if (wc < 2) { dst = Kb + wc * 64; ld = 128; w = kw; post = 1.f; }
        else { dst = Vb + (wc - 2) * 64; ld = 128; w = qw; post = 1.f; }
        f32x4 wv[2][2];
#pragma unroll
        for (int bj = 0; bj < 2; ++bj)
#pragma unroll
            for (int n = 0; n < 2; ++n) wv[bj][n] = *(const f32x4*)(w + 32 * bj + 8 * fq + 4 * n);
#pragma unroll
        for (int ai = 0; ai < 2; ++ai)
#pragma unroll
            for (int m = 0; m < 4; ++m) {
                const int row = row0 + ai * HALF + m * 16; const float s = rs1[row];
                f32x4 x[2][2];
#pragma unroll
                for (int bj = 0; bj < 2; ++bj)
#pragma unroll
                    for (int n = 0; n < 2; ++n) x[bj][n] = acc[ai][bj][m][n] * s;
                if (!isv) {
                    float ss = 0.f;
#pragma unroll
                    for (int bj = 0; bj < 2; ++bj)
#pragma unroll
                        for (int n = 0; n < 2; ++n) ss += (x[bj][n][0] * x[bj][n][0] + x[bj][n][1] * x[bj][n][1]) + (x[bj][n][2] * x[bj][n][2] + x[bj][n][3] * x[bj][n][3]);
                    ss += __shfl_xor(ss, 16); ss += __shfl_xor(ss, 32);
                    const float rn = 1.0f / sqrtf(ss * (1.0f / 64.0f) + QK_EPS);
#pragma unroll
                    for (int bj = 0; bj < 2; ++bj)
#pragma unroll
                        for (int n = 0; n < 2; ++n) x[bj][n] = x[bj][n] * rn * wv[bj][n];
                    const float* rp = rope + (size_t)row * 16;
#pragma unroll
                    for (int n = 0; n < 2; ++n) {
                        const f32x4 cs = *(const f32x4*)(rp + 4 * n), sn = *(const f32x4*)(rp + 8 + 4 * n);
                        f32x4 pr;
#pragma unroll
                        for (int c = 0; c < 4; ++c) pr[c] = __shfl_xor(x[0][n][c], 16);
                        const f32x4 r0 = x[0][n] * cs - pr * sn, r1 = x[0][n] * cs + pr * sn;
                        if (fq == 0) x[0][n] = r0; else if (fq == 1) x[0][n] = r1;
                    }
#pragma unroll
                    for (int bj = 0; bj < 2; ++bj)
#pragma unroll
                        for (int n = 0; n < 2; ++n) x[bj][n] = x[bj][n] * post;
                }
                bf16_t* op = dst + (size_t)row * ld + 8 * fq;
#pragma unroll
                for (int bj = 0; bj < 2; ++bj) *(u32x4*)(op + 32 * bj) = pack8(x[bj][0], x[bj][1]);
            }
    }
};
struct EpiOutProj {
    static constexpr bool PERM = true, INIT = false;
    bf16_t* hm;
    __device__ __forceinline__ void operator()(const f32x4 (&acc)[2][2][4][2], const Unit& u, int wr, int wc, int fr, int fq, const LAS int*) const {
        const int row0 = u.pm * BM + wr * 64 + fr, col0 = u.pn * BM + wc * 32 + 8 * fq;
#pragma unroll
        for (int ai = 0; ai < 2; ++ai)
#pragma unroll
            for (int m = 0; m < 4; ++m) { bf16_t* rp = hm + (size_t)(row0 + ai * HALF + m * 16) * D + col0;
#pragma unroll
                for (int bj = 0; bj < 2; ++bj) *(u32x4*)(rp + bj * HALF) = pack8(acc[ai][bj][m][0], acc[ai][bj][m][1]); }
    }
};
struct EpiGU {
    static constexpr bool PERM = true, INIT = false;
    unsigned char* act; const float* rs2; const float* bgu;
    __device__ __forceinline__ void operator()(const f32x4 (&acc)[2][2][4][2], const Unit& u, int wr, int wc, int fr, int fq, const LAS int* idx) const {
        const int r0 = wr * 64 + fr, c0 = u.pn * 128 + wc * 32 + 8 * fq;
        const float* bp = bgu + (size_t)u.e * 2048 + c0;
        const f32x4 bg0 = *(const f32x4*)(bp), bg1 = *(const f32x4*)(bp + 4), bu0 = *(const f32x4*)(bp + 1024), bu1 = *(const f32x4*)(bp + 1028);
#pragma unroll
        for (int ai = 0; ai < 2; ++ai)
#pragma unroll
            for (int m = 0; m < 4; ++m) { const int r = r0 + ai * HALF + m * 16; const float s = rs2[idx[r] >> 2];
                f32x4 a[2];
#pragma unroll
                for (int n = 0; n < 2; ++n) { const f32x4 g = acc[ai][0][m][n] * s + (n ? bg1 : bg0), uu = acc[ai][1][m][n] * s + (n ? bu1 : bu0);
#pragma unroll
                    for (int c = 0; c < 4; ++c) { const float gc = fminf(g[c], 7.0f), uc = fminf(fmaxf(uu[c], -7.0f), 7.0f);
                        const float sg = __builtin_amdgcn_rcpf(1.0f + __builtin_amdgcn_exp2f(gc * (-1.702f * LOG2E))); a[n][c] = gc * sg * (uc + 1.0f); } }
                u32x2 w; w.x = pk4_fp8(a[0][0], a[0][1], a[0][2], a[0][3]); w.y = pk4_fp8(a[1][0], a[1][1], a[1][2], a[1][3]); *(u32x2*)(act + (size_t)(u.pm * BM + r) * FF + c0) = w; }
    }
};
struct EpiDown {
    static constexpr bool PERM = true, INIT = false;
    unsigned char* y; const float* gate; const float* bdn;
    __device__ __forceinline__ void operator()(const f32x4 (&acc)[2][2][4][2], const Unit& u, int wr, int wc, int fr, int fq, const LAS int* idx) const {
        const int r0 = wr * 64 + fr, c0 = u.pn * BM + wc * 32 + 8 * fq;
        const float* bp = bdn + (size_t)u.e * D + c0;
        f32x4 bv[2][2];
#pragma unroll
        for (int bj = 0; bj < 2; ++bj)
#pragma unroll
            for (int n = 0; n < 2; ++n) bv[bj][n] = *(const f32x4*)(bp + bj * HALF + 4 * n);
#pragma unroll
        for (int ai = 0; ai < 2; ++ai)
#pragma unroll
            for (int m = 0; m < 4; ++m) { const int r = r0 + ai * HALF + m * 16;
                if (r < u.nvalid) { const int aid = idx[r]; const float g = gate[aid] * Y8_SCALE; unsigned char* yp = y + (size_t)aid * D + c0;
#pragma unroll
                    for (int bj = 0; bj < 2; ++bj) { const f32x4 y0 = (acc[ai][bj][m][0] + bv[bj][0]) * g, y1 = (acc[ai][bj][m][1] + bv[bj][1]) * g;
                        u32x2 w; w.x = pk4_fp8(y0[0], y0[1], y0[2], y0[3]); w.y = pk4_fp8(y1[0], y1[1], y1[2], y1[3]); *(u32x2*)(yp + bj * HALF) = w; } } }
    }
};
}

struct Frame {
    LAS unsigned char* lds;
    int tid, lane, wave, G, gw, NGW;
};

__device__ __forceinline__ float wave_sum(float v) {
#pragma unroll
    for (int o = 1; o < 64; o <<= 1) v += __shfl_xor(v, o);
    return v;
}

template <int KQ, bool F8>
__device__ __forceinline__ void p0_tile(const float* W, int ldw, int scolA, int scolB, int k0, const float* ks, float sc, void* WT, int ldk, int drow0, int lane) {
    const int nl = (lane & 15) * 4, kq = lane >> 4, kb = k0 + KQ * kq;
    const char* ub = (const char*)(W + (size_t)k0 * ldw);
    const unsigned voff = (unsigned)(KQ * kq * ldw + ((nl & 32) ? scolB : scolA) + (nl & 31)) * 4u;
    f32x4 v[KQ];
#pragma unroll
    for (int i = 0; i < KQ; ++i) v[i] = *(const f32x4*)(ub + (size_t)i * ldw * 4 + voff);
    if (ks) {
#pragma unroll
        for (int i = 0; i < KQ; i += 4) { const f32x4 kv = *(const f32x4*)(ks + kb + i);
#pragma unroll
            for (int j = 0; j < 4; ++j) v[i + j] = v[i + j] * (kv[j] * sc); }
    } else if (sc != 1.0f) {
#pragma unroll
        for (int i = 0; i < KQ; ++i) v[i] = v[i] * sc;
    }
#pragma unroll
    for (int c = 0; c < 4; ++c) {
        if (F8) { unsigned char* dst = (unsigned char*)WT + (size_t)(drow0 + nl + c) * ldk + kb;
#pragma unroll
            for (int i = 0; i < KQ; i += 16) { u32x4 o; o.x = pk4_fp8(v[i][c], v[i + 1][c], v[i + 2][c], v[i + 3][c]); o.y = pk4_fp8(v[i + 4][c], v[i + 5][c], v[i + 6][c], v[i + 7][c]);
                o.z = pk4_fp8(v[i + 8][c], v[i + 9][c], v[i + 10][c], v[i + 11][c]); o.w = pk4_fp8(v[i + 12][c], v[i + 13][c], v[i + 14][c], v[i + 15][c]); *(GAS u32x4*)(dst + i) = o; } }
        else { bf16_t* dst = (bf16_t*)WT + (size_t)(drow0 + nl + c) * ldk + kb;
#pragma unroll
            for (int i = 0; i < KQ; i += 8) { u32x4 o; o.x = pk2(v[i][c], v[i + 1][c]); o.y = pk2(v[i + 2][c], v[i + 3][c]); o.z = pk2(v[i + 4][c], v[i + 5][c]); o.w = pk2(v[i + 6][c], v[i + 7][c]); *(GAS u32x4*)(dst + i) = o; } }
    }
}
__device__ __forceinline__ int win_src(int rho0) {
    const int pn = rho0 >> 8, within = rho0 & 255, bj = within >> 7, wc = (within & 127) >> 5;
    if (pn < 2) return 64 * (4 * pn + wc) + 32 * bj;
    if (pn == 2) return 512 + 64 * wc + 32 * bj;
    return rho0;
}

struct Args { const void* in[17]; float* out; unsigned char* ws; int ph_lo, ph_hi; float invf[8]; };

__device__ __forceinline__ int crow(int r, int hi) { return (r & 3) + 8 * (r >> 2) + 4 * hi; }
typedef short v4i16_t __attribute__((ext_vector_type(4)));
__device__ __forceinline__ s16x4 vtr(const LAS unsigned char* p) { return __builtin_bit_cast(s16x4, __builtin_amdgcn_ds_read_tr16_b64_v4i16((LAS v4i16_t*)p)); }

__device__ __forceinline__ void attn_unit(const Frame& F, int b, int kvh, int qblk, const bf16_t* Q, const bf16_t* Kb, const bf16_t* Vb, bf16_t* O, const float* sinks) {
    const int lane = F.lane, wid = F.wave, r32 = lane & 31, hi = lane >> 5;
    LAS unsigned char* lds = F.lds;
    const int s0 = qblk * 128; const long rowq0 = (long)b * SEQ + s0;
    {
        u32x4 kv[4], vv[4];
#pragma unroll
        for (int jt = 0; jt < 4; ++jt) {
            long rt = (long)b * SEQ + s0 - 128 + 64 * jt; if (qblk == 0 && jt < 2) rt = (long)b * SEQ;
            kv[jt] = *(const u32x4*)(Kb + (rt + lane) * 128 + kvh * 64 + wid * 8);
            vv[jt] = *(const u32x4*)(Vb + (rt + 16 * (wid & 3) + (lane >> 2)) * 128 + kvh * 64 + (wid >> 2) * 32 + (lane & 3) * 8);
        }
#pragma unroll
        for (int jt = 0; jt < 4; ++jt) { *(LAS u32x4*)(lds + jt * 8192 + wid * 1024 + lane * 16) = kv[jt]; *(LAS u32x4*)(lds + 32768 + jt * 8192 + wid * 1024 + lane * 16) = vv[jt]; }
    }
    __syncthreads();
    const int g = wid >> 1, rh = wid & 1, head = kvh * 4 + g, t0 = rh;
    const float sinkl = sinks[head] * LOG2E;
    LAS bf16_t* stg = (LAS bf16_t*)(lds + 65536) + wid * 2048;
    const int vboff = ((lane >> 4) & 1) * 32 + (lane & 3) * 8 + (4 * hi + ((lane & 15) >> 2)) * 64;
#pragma unroll 1
    for (int s = 0; s < 2; ++s) {
        const int q0 = 64 * rh + 32 * s;
        const bf16_t* Qw = Q + (size_t)(rowq0 + q0 + r32) * 512 + head * 64 + hi * 8;
        bf16x8 qr[4];
#pragma unroll
        for (int d0 = 0; d0 < 4; ++d0) qr[d0] = *(const bf16x8*)(Qw + d0 * 16);
        const int qi = q0 + r32; const int klo = (qblk == 0) ? (qi > 127 ? qi : 127) : qi;
        float mrun = sinkl, l = 1.0f;
        f32x16 o[2]; o[0] = f32x16{}; o[1] = f32x16{};
#pragma unroll 1
        for (int jt = 0; jt < 3; ++jt) {
            const LAS unsigned char* kb = lds + (t0 + jt) * 8192 + hi * 1024 + r32 * 16;
            f32x16 p0 = {}, p1 = {};
#pragma unroll
            for (int d0 = 0; d0 < 4; ++d0) {
                const bf16x8 k0 = *(const LAS bf16x8*)(kb + d0 * 2048), k1 = *(const LAS bf16x8*)(kb + d0 * 2048 + 512);
                p0 = __builtin_amdgcn_mfma_f32_32x32x16_bf16(k0, qr[d0], p0, 0, 0, 0);
                p1 = __builtin_amdgcn_mfma_f32_32x32x16_bf16(k1, qr[d0], p1, 0, 0, 0);
            }
            float mx = mrun; const int kbase = 64 * (t0 + jt);
#pragma unroll
            for (int r = 0; r < 16; ++r) { const int kj = kbase + crow(r, hi);
                const bool ok0 = (kj > klo) && (kj <= qi + 128), ok1 = (kj + 32 > klo) && (kj + 32 <= qi + 128);
                p0[r] = ok0 ? p0[r] : -INFINITY; p1[r] = ok1 ? p1[r] : -INFINITY; mx = fmaxf(mx, fmaxf(p0[r], p1[r])); }
            mx = fmaxf(mx, __shfl_xor(mx, 32));
            const float alpha = __builtin_amdgcn_exp2f(mrun - mx); mrun = mx;
            float ls = 0.f;
#pragma unroll
            for (int r = 0; r < 16; ++r) { p0[r] = __builtin_amdgcn_exp2f(p0[r] - mx); p1[r] = __builtin_amdgcn_exp2f(p1[r] - mx); ls += p0[r] + p1[r]; }
            ls += __shfl_xor(ls, 32);
            l = l * alpha + ls;
#pragma unroll
            for (int d0 = 0; d0 < 2; ++d0)
#pragma unroll
                for (int r = 0; r < 16; ++r) o[d0][r] *= alpha;
            const LAS unsigned char* vp = lds + 32768 + (t0 + jt) * 8192 + vboff;
#pragma unroll
            for (int ks = 0; ks < 4; ++ks) {
                const f32x16& P = (ks < 2) ? p0 : p1; const int rb = (ks & 1) * 8;
                u32x4 pw; pw.x = cvt_pk_bf16(P[rb + 0], P[rb + 1]); pw.y = cvt_pk_bf16(P[rb + 2], P[rb + 3]); pw.z = cvt_pk_bf16(P[rb + 4], P[rb + 5]); pw.w = cvt_pk_bf16(P[rb + 6], P[rb + 7]);
                const bf16x8 pb = __builtin_bit_cast(bf16x8, pw);
#pragma unroll
                for (int d0 = 0; d0 < 2; ++d0) {
                    const s16x4 lo = vtr(vp + d0 * 4096 + ks * 1024), hv = vtr(vp + d0 * 4096 + ks * 1024 + 512);
                    const bf16x8 vf = (bf16x8){lo[0], lo[1], lo[2], lo[3], hv[0], hv[1], hv[2], hv[3]};
                    o[d0] = __builtin_amdgcn_mfma_f32_32x32x16_bf16(vf, pb, o[d0], 0, 0, 0);
                }
            }
        }
        const float rl = 1.0f / l;
#pragma unroll
        for (int d0 = 0; d0 < 2; ++d0)
#pragma unroll
            for (int g4 = 0; g4 < 4; ++g4) { u32x2 w; w.x = cvt_pk_bf16(o[d0][4 * g4] * rl, o[d0][4 * g4 + 1] * rl); w.y = cvt_pk_bf16(o[d0][4 * g4 + 2] * rl, o[d0][4 * g4 + 3] * rl);
                *(LAS u32x2*)(stg + r32 * 64 + 32 * d0 + 8 * g4 + 4 * hi) = w; }
        LDS_WAIT();
        bf16_t* Ow = O + (size_t)(rowq0 + q0) * D + head * 64;
#pragma unroll
        for (int i = 0; i < 4; ++i) { const int row = i * 8 + (lane >> 3), ch = lane & 7; const u32x4 v = *(const LAS u32x4*)(stg + row * 64 + ch * 8); *(u32x4*)(Ow + (size_t)row * D + ch * 8) = v; }
        LDS_WAIT();
    }
    __syncthreads();
}

template <int W>
__device__ __forceinline__ void pool_item(const bf16_t* UB, bf16_t* MIXED, int tb, int g, int lane) {
    const int c8 = g * 128 + (lane & 15) * 8, t0 = tb * 64 + (lane >> 4) * 16, s0 = t0 & (SEQ - 1);
    u32x4 rows[W + 15];
    const bool head = (s0 == 0);
    const unsigned voff = (unsigned)(t0 * 512 + c8) * 2u;
#pragma unroll
    for (int i = 0; i < W + 15; ++i) { const int dt = i - (W - 1);
        if (dt >= 0) rows[i] = *(const u32x4*)((const char*)UB + dt * 1024 + voff);
        else { const u32x4 r = *(const u32x4*)((const char*)UB + (head ? 0 : dt * 1024) + voff); rows[i] = head ? (u32x4){0u, 0u, 0u, 0u} : r; } }
    float S[8];
#pragma unroll
    for (int c = 0; c < 8; ++c) S[c] = 0.f;
#pragma unroll
    for (int i = 0; i < W - 1; ++i)
#pragma unroll
        for (int c = 0; c < 4; ++c) { S[2 * c] += __builtin_bit_cast(float, rows[i][c] << 16); S[2 * c + 1] += __builtin_bit_cast(float, rows[i][c] & 0xffff0000u); }
#pragma unroll
    for (int j = 0; j < 16; ++j) {
        const u32x4 cur = rows[j + W - 1]; float self[8];
#pragma unroll
        for (int c = 0; c < 4; ++c) { self[2 * c] = __builtin_bit_cast(float, cur[c] << 16); self[2 * c + 1] = __builtin_bit_cast(float, cur[c] & 0xffff0000u); S[2 * c] += self[2 * c]; S[2 * c + 1] += self[2 * c + 1]; }
        const int cnt = (s0 + j + 1 < W) ? s0 + j + 1 : W; const float ic = 1.0f / (float)cnt;
        u32x4 o;
#pragma unroll
        for (int c = 0; c < 4; ++c) o[c] = pk2(S[2 * c] * ic - self[2 * c], S[2 * c + 1] * ic - self[2 * c + 1]);
        *(u32x4*)(MIXED + (size_t)(t0 + j) * D + 512 + c8) = o;
        const u32x4 old = rows[j];
#pragma unroll
        for (int c = 0; c < 4; ++c) { S[2 * c] -= __builtin_bit_cast(float, old[c] << 16); S[2 * c + 1] -= __builtin_bit_cast(float, old[c] & 0xffff0000u); }
    }
}

__global__ void __launch_bounds__(NWAVES * 64, 2) hymba_fwd(Args args) {
    extern __shared__ __attribute__((aligned(16))) unsigned char lds_raw[];
    Frame F;
    F.lds = (LAS unsigned char*)lds_raw;
    F.tid = threadIdx.x; F.lane = F.tid & 63; F.wave = __builtin_amdgcn_readfirstlane(F.tid >> 6);
    F.G = gridDim.x; F.gw = blockIdx.x * NWAVES + F.wave; F.NGW = F.G * NWAVES;
    volatile LAS unsigned* MISC = (volatile LAS unsigned*)(F.lds + L_MISC);
#define AS4 __attribute__((address_space(4)))
    const AS4 char* kbase = (const AS4 char*)__builtin_amdgcn_kernarg_segment_ptr();
#define KP_FRESH() const AS4 char* kp = kbase; asm volatile("" : "+s"(kp))
#define KIN(T, i) ((T)(*(const void* const AS4*)(kp + 8 * (i))))
#define KOUT() (*(float* const AS4*)(kp + 136))
#define KWS() (*(unsigned char* const AS4*)(kp + 144))
    gu32* ctl;
    { KP_FRESH(); ctl = (gu32*)(KWS() + WS_CTL); }
    for (int u = F.tid; u < 512 / 4; u += NWAVES * 64) ((LAS unsigned*)(F.lds + L_MISC))[u] = 0u;
    __syncthreads();
    XcdBarrier bar; bar.bar = (unsigned*)(ctl + CW_BAR); bar.x = 0; bar.st = nullptr;
    if (N_LAUNCHES == 1) bar = xcd_barrier_post((unsigned*)(ctl + CW_BAR), MISC + 8);
    int lo, hi; { KP_FRESH(); lo = *(const int AS4*)(kp + 152); hi = *(const int AS4*)(kp + 156); }
#define IN(k) (lo <= (k) && (k) < hi)
#define SEAM(k) do { if (IN(k) && IN((k) + 1)) xcd_barrier(bar); } while (0)
#ifndef DUPMASK
#define DUPMASK 0
#endif
#define REP(k) for (int rep_ = 0; rep_ < (((DUPMASK >> (k)) & 1) ? 2 : 1); ++rep_)
#define REPSEAM(k) do { if (((DUPMASK >> (k)) & 1) && rep_ == 0) xcd_barrier(bar); } while (0)
    LAS int* idxring = (LAS int*)(F.lds + L_IDX);
    LAS int* utab = (LAS int*)(F.lds + L_UTAB);

    if (IN(0)) REP(0) {
        KP_FRESH(); unsigned char* ws = KWS(); float* out = KOUT();
        const float* x = KIN(const float*, 0); const int* positions = KIN(const int*, 1); const float* norm1_w = KIN(const float*, 2); const float* w_in = KIN(const float*, 3);
        const float* pool_w = KIN(const float*, 7); const float* pool_scale = KIN(const float*, 8); const float* w_out = KIN(const float*, 9); const float* norm2_w = KIN(const float*, 10);
        const float* w_router = KIN(const float*, 11); const float* w_gu = KIN(const float*, 13); const float* w_down = KIN(const float*, 15);
        bf16_t* WIN = (bf16_t*)(ws + WS_WIN); bf16_t* WOUT = (bf16_t*)(ws + WS_WOUT); float* WR = (float*)(ws + WS_WR); float* ROPE = (float*)(ws + WS_ROPE);
        float* RS1 = (float*)(ws + WS_RS1); int* LIST = (int*)(ws + WS_LIST); unsigned char* WGU = ws + WS_WGU; unsigned char* WDN = ws + WS_WDN;
        bf16_t* XB = (bf16_t*)((unsigned char*)out + DO_XB);
        constexpr int I_IN = 16 * 20, I_OUT = 8 * 16, I_GU = 32 * 8 * 32, I_DN = 32 * 8 * 16, NITEMS = I_IN + I_OUT + I_GU + I_DN;
#pragma unroll 1
        for (int it = F.gw; it < NITEMS; it += F.NGW) {
            int r = it;
            if (r < I_GU) { const int e = r >> 8, q = r & 255, kb = q >> 5, nb = q & 31; const int rho0 = 64 * nb, pn = rho0 >> 8, rr = rho0 & 255;
                const int sc = (rr < 128) ? 128 * pn + rr : 1024 + 128 * pn + (rr - 128);
                p0_tile<32, true>(w_gu + (size_t)e * D * 2048, 2048, sc, sc + 32, 128 * kb, norm2_w, W8_SCALE, WGU + (size_t)e * 2048 * D, D, rho0, F.lane); continue; } r -= I_GU;
            if (r < I_DN) { const int e = r >> 7, q = r & 127, kb = q >> 4, nb = q & 15;
                p0_tile<32, true>(w_down + (size_t)e * FF * D, D, 64 * nb, 64 * nb + 32, 128 * kb, nullptr, W8_SCALE, WDN + (size_t)e * D * FF, FF, 64 * nb, F.lane); continue; } r -= I_DN;
            if (r < I_IN) { const int kb = r / 20, nb = r % 20; p0_tile<16, false>(w_in, NIN, win_src(64 * nb), win_src(64 * nb + 32), 64 * kb, norm1_w, 1.0f, WIN, D, 64 * nb, F.lane); continue; } r -= I_IN;
            { const int kb = r >> 4, nb = r & 15; p0_tile<16, false>(w_out, D, 64 * nb, 64 * nb + 32, 64 * kb, nullptr, 1.0f, WOUT, D, 64 * nb, F.lane); }
        }
        for (int m = 2 * F.gw; m < T; m += 2 * F.NGW) {
            const GAS f32x4* xr = (const GAS f32x4*)(x + (size_t)m * D) + F.lane;
            f32x4 v[2][4]; float s2[2] = {0.f, 0.f};
#pragma unroll
            for (int q = 0; q < 2; ++q)
#pragma unroll
                for (int j = 0; j < 4; ++j) v[q][j] = xr[q * (D / 4) + 64 * j];
#pragma unroll
            for (int q = 0; q < 2; ++q)
#pragma unroll
                for (int j = 0; j < 4; ++j) s2[q] += (v[q][j].x * v[q][j].x + v[q][j].y * v[q][j].y) + (v[q][j].z * v[q][j].z + v[q][j].w * v[q][j].w);
            s2[0] = wave_sum(s2[0]); s2[1] = wave_sum(s2[1]);
            if (F.lane < 2) RS1[m + F.lane] = 1.0f / sqrtf((F.lane ? s2[1] : s2[0]) * (1.0f / D) + NORM_EPS);
#pragma unroll
            for (int q = 0; q < 2; ++q) { GAS unsigned long long* o8 = (GAS unsigned long long*)(XB + (size_t)(m + q) * D) + F.lane;
#pragma unroll
                for (int j = 0; j < 4; ++j) o8[64 * j] = (unsigned long long)pk2(v[q][j].x, v[q][j].y) | ((unsigned long long)pk2(v[q][j].z, v[q][j].w) << 32); }
        }
        const int gt = blockIdx.x * (NWAVES * 64) + F.tid, NGT = F.G * NWAVES * 64;
        for (int it = gt; it < 512 * 256; it += NGT) { const int cp = it >> 8, n4 = (it & 255) * 4, g = cp >> 7;
            const float* pw = pool_w + (size_t)cp * 128; const float* ps = pool_scale + g * 128; const float* wo = w_out + (size_t)(512 + g * 128) * D + n4;
            f32x4 a = {0.f, 0.f, 0.f, 0.f};
#pragma unroll 16
            for (int d = 0; d < 128; ++d) a += *(const f32x4*)(wo + (size_t)d * D) * (pw[d] * ps[d]);
#pragma unroll
            for (int c = 0; c < 4; ++c) WOUT[(size_t)(n4 + c) * D + 512 + cp] = (bf16_t)f2bf(a[c]); }
        for (int it = gt; it < D * NE; it += NGT) WR[it] = norm2_w[it >> 5] * w_router[it];
        for (int it = gt; it < T * 8; it += NGT) { const int t = it >> 3, p = it & 7; const float ang = (float)positions[t] * (*(const float AS4*)(kp + 160 + 4 * p)); float sn, cs; sincosf(ang, &sn, &cs); ROPE[(size_t)t * 16 + p] = cs; ROPE[(size_t)t * 16 + 8 + p] = sn; }
        for (int it = gt; it < NE * LIST_CAP / 4; it += NGT) ((u32x4*)LIST)[it] = (u32x4){0u, 0u, 0u, 0u};
        REPSEAM(0);
    }
    SEAM(0);

    if (IN(1)) REP(1) {
        KP_FRESH(); unsigned char* ws = KWS(); unsigned char* ob = (unsigned char*)KOUT();
        pg8::TabOrder S; S.tab = utab; S.list = nullptr; S.nU = pg8::build_units(utab, T / 256, NIN / 256, F.G, (int)blockIdx.x, nullptr, nullptr);
        pg8::EpiInProj E{(bf16_t*)(ob + DO_QB), (bf16_t*)(ob + DO_KB), (bf16_t*)(ob + DO_VB), (bf16_t*)(ws + WS_UB), (const float*)(ws + WS_RS1), (const float*)(ws + WS_ROPE), KIN(const float*, 4), KIN(const float*, 5)};
        pg8::gemm_phase<pg8::EpiInProj, pg8::TabOrder, 0, false, 1024, false>(F.lds, idxring, (const bf16_t*)(ob + DO_XB), (const bf16_t*)(ws + WS_WIN), S, E);
        REPSEAM(1);
    }
    SEAM(1);

    if (IN(2)) REP(2) {
        KP_FRESH(); unsigned char* ws = KWS(); unsigned char* ob = (unsigned char*)KOUT(); const float* sinks = KIN(const float*, 6);
        const bf16_t* QB = (const bf16_t*)(ob + DO_QB); const bf16_t* KB = (const bf16_t*)(ob + DO_KB); const bf16_t* VB = (const bf16_t*)(ob + DO_VB);
        bf16_t* MIXED = (bf16_t*)(ws + WS_MIXED); const bf16_t* UB = (const bf16_t*)(ws + WS_UB);
        for (int uid = blockIdx.x; uid < NB * 2 * 32; uid += F.G) { const int qblk = uid & 31, kvh = (uid >> 5) & 1, b = uid >> 6; attn_unit(F, b, kvh, qblk, QB, KB, VB, MIXED, sinks); }
#pragma unroll 1
        for (int it = F.gw; it < (T / 64) * 4; it += F.NGW) { const int g = it & 3, tb = it >> 2;
            if (g == 0) pool_item<2>(UB, MIXED, tb, 0, F.lane); else if (g == 1) pool_item<4>(UB, MIXED, tb, 1, F.lane); else if (g == 2) pool_item<8>(UB, MIXED, tb, 2, F.lane); else pool_item<16>(UB, MIXED, tb, 3, F.lane); }
        REPSEAM(2);
    }
    SEAM(2);

    if (IN(3)) REP(3) {
        KP_FRESH(); unsigned char* ws = KWS();
        pg8::TabOrder S; S.tab = utab; S.list = nullptr; S.nU = pg8::build_units(utab, T / 256, D / 256, F.G, (int)blockIdx.x, nullptr, nullptr);
        pg8::EpiOutProj E{(bf16_t*)(ws + WS_HM)};
        pg8::gemm_phase<pg8::EpiOutProj, pg8::TabOrder, 0, false, 1024, false>(F.lds, idxring, (const bf16_t*)(ws + WS_MIXED), (const bf16_t*)(ws + WS_WOUT), S, E);
        REPSEAM(3);
    }
    SEAM(3);

    if (IN(4)) {
        KP_FRESH(); unsigned char* ws = KWS(); const float* x = KIN(const float*, 0); const float* b_router = KIN(const float*, 12);
        const bf16_t* HM = (const bf16_t*)(ws + WS_HM); unsigned char* H8 = ws + WS_H8;
        const float* WR = (const float*)(ws + WS_WR); float* RS2 = (float*)(ws + WS_RS2); float* GATE = (float*)(ws + WS_GATE); int* LIST = (int*)(ws + WS_LIST);
        LAS float* wr = (LAS float*)F.lds;
        for (int i = F.tid; i < D * NE / 4; i += NWAVES * 64) ((LAS f32x4*)wr)[i] = ((const f32x4*)WR)[i];
        LAS int* hist = (LAS int*)(F.lds + L_RH); LAS int* hbase = hist + 32;
        LAS float* lg = (LAS float*)(F.lds + L_RSCR + F.wave * 2112);
        const int r32 = F.lane & 31, hh = F.lane >> 5;
        for (int blk = blockIdx.x; blk < T / 256; blk += F.G) {
            if (F.tid < 32) hist[F.tid] = 0;
            __syncthreads();
            const int tok0 = blk * 256 + F.wave * 32;
            const size_t roff = (size_t)(tok0 + r32) * D + 512 * hh;
            const float* xrow = x + roff; const bf16_t* mrow = HM + roff; unsigned char* h8row = H8 + roff;
            f32x16 acc = {}; float ss = 0.f;
#pragma unroll 2
            for (int it = 0; it < 32; ++it) {
                f32x4 a[4];
#pragma unroll
                for (int q = 0; q < 4; ++q) a[q] = *(const f32x4*)(xrow + 16 * it + 4 * q);
                { const u32x4 m0 = *(const u32x4*)(mrow + 16 * it), m1 = *(const u32x4*)(mrow + 16 * it + 8);
#pragma unroll
                  for (int c = 0; c < 2; ++c) { a[c][0] += __builtin_bit_cast(float, m0[2 * c] << 16); a[c][1] += __builtin_bit_cast(float, m0[2 * c] & 0xffff0000u); a[c][2] += __builtin_bit_cast(float, m0[2 * c + 1] << 16); a[c][3] += __builtin_bit_cast(float, m0[2 * c + 1] & 0xffff0000u);
                      a[2 + c][0] += __builtin_bit_cast(float, m1[2 * c] << 16); a[2 + c][1] += __builtin_bit_cast(float, m1[2 * c] & 0xffff0000u); a[2 + c][2] += __builtin_bit_cast(float, m1[2 * c + 1] << 16); a[2 + c][3] += __builtin_bit_cast(float, m1[2 * c + 1] & 0xffff0000u); } }
                { u32x4 w; w.x = pk4_fp8(a[0][0], a[0][1], a[0][2], a[0][3]); w.y = pk4_fp8(a[1][0], a[1][1], a[1][2], a[1][3]); w.z = pk4_fp8(a[2][0], a[2][1], a[2][2], a[2][3]); w.w = pk4_fp8(a[3][0], a[3][1], a[3][2], a[3][3]);
                  *(u32x4*)(h8row + 16 * it) = w; }
#pragma unroll
                for (int q = 0; q < 4; ++q)
#pragma unroll
                    for (int c = 0; c < 4; ++c) { const float av = a[q][c]; ss += av * av; const float bv = wr[(512 * hh + 16 * it + 4 * q + c) * 32 + r32]; acc = __builtin_amdgcn_mfma_f32_32x32x2f32(av, bv, acc, 0, 0, 0); }
            }
            ss += __shfl_xor(ss, 32);
            const float rs = 1.0f / sqrtf(ss * (1.0f / D) + NORM_EPS);
            const int tok = tok0 + r32;
            if (hh == 0) RS2[tok] = rs;
            int sel[4]; float gv[4]; int lpos[4];
#pragma unroll
            for (int pass = 0; pass < 2; ++pass) {
#pragma unroll
                for (int r = 0; r < 8; ++r) { const int rr = 8 * pass + r; const int i = crow(rr, hh) - 16 * pass; lg[i * 33 + r32] = acc[rr]; }
                LDS_WAIT(); asm volatile("" ::: "memory");
                if ((r32 >> 4) == pass && hh == 0) {
                    const int i = r32 & 15; float v[32];
#pragma unroll
                    for (int e = 0; e < 32; ++e) v[e] = lg[i * 33 + e] * rs + b_router[e];
                    unsigned taken = 0u;
#pragma unroll
                    for (int k = 0; k < 4; ++k) { float best = -INFINITY; int bi = 0;
#pragma unroll
                        for (int e = 0; e < 32; ++e) { const bool ok = !((taken >> e) & 1u) && v[e] > best; best = ok ? v[e] : best; bi = ok ? e : bi; }
                        taken |= 1u << bi; sel[k] = bi; gv[k] = best; }
                    const float e1 = __expf(gv[1] - gv[0]), e2 = __expf(gv[2] - gv[0]), e3 = __expf(gv[3] - gv[0]); const float inv = 1.0f / (1.0f + e1 + e2 + e3);
                    gv[0] = inv; gv[1] = e1 * inv; gv[2] = e2 * inv; gv[3] = e3 * inv;
#pragma unroll
                    for (int k = 0; k < 4; ++k) lpos[k] = __hip_atomic_fetch_add(&hist[sel[k]], 1, __ATOMIC_RELAXED, __HIP_MEMORY_SCOPE_WORKGROUP);
                }
                LDS_WAIT(); asm volatile("" ::: "memory");
            }
            __syncthreads();
            if (F.tid < 32) hbase[F.tid] = (int)__hip_atomic_fetch_add((unsigned*)(ctl + CW_CNT + F.tid), (unsigned)hist[F.tid], RLX_AGENT);
            __syncthreads();
            if (hh == 0) {
#pragma unroll
                for (int k = 0; k < 4; ++k) { const int aid = tok * 4 + k; GATE[aid] = gv[k]; LIST[(size_t)sel[k] * LIST_CAP + hbase[sel[k]] + lpos[k]] = aid; }
            }
            __syncthreads();
        }
    }
    SEAM(4);

    {
        LAS int* cntl = (LAS int*)(F.lds + L_CNT); LAS int* tinfo = (LAS int*)(F.lds + L_TINFO); LAS int* pref = (LAS int*)(F.lds + L_PREF);
        int nMt = 0;
        if (IN(5) || IN(6)) {
            __syncthreads();
            if (F.tid < 32) cntl[F.tid] = (int)__hip_atomic_load((unsigned*)(ctl + CW_CNT + F.tid), RLX_AGENT);
            __syncthreads();
            if (F.tid == 0) { int a = 0; for (int e = 0; e < 32; ++e) { pref[e] = a; a += (cntl[e] + 255) >> 8; } pref[32] = a; }
            __syncthreads();
            nMt = pref[32];
            for (int e = 0; e < 32; ++e) { const int p0 = pref[e], n = pref[e + 1] - p0; for (int j = F.tid; j < n; j += NWAVES * 64) tinfo[p0 + j] = e | (j << 8); }
            __syncthreads();
        }
        if (IN(5)) REP(5) {
            KP_FRESH(); unsigned char* ws = KWS();
            pg8::TabOrder S; S.tab = utab; S.list = (const int*)(ws + WS_LIST); S.nU = pg8::build_units(utab, nMt, 8, F.G, (int)blockIdx.x, tinfo, cntl);
            pg8::EpiGU E{ws + WS_ACT, (const float*)(ws + WS_RS2), KIN(const float*, 14)};
            pg8::gemm_phase<pg8::EpiGU, pg8::TabOrder, 1, true, 512, true>(F.lds, idxring, ws + WS_H8, ws + WS_WGU, S, E);
            REPSEAM(5);
        }
        SEAM(5);
        if (IN(6)) REP(6) {
            KP_FRESH(); unsigned char* ws = KWS();
            pg8::TabOrder S; S.tab = utab; S.list = (const int*)(ws + WS_LIST); S.nU = pg8::build_units(utab, nMt, 4, F.G, (int)blockIdx.x, tinfo, cntl);
            pg8::EpiDown E{ws + WS_Y, (const float*)(ws + WS_GATE), KIN(const float*, 16)};
            pg8::gemm_phase<pg8::EpiDown, pg8::TabOrder, 0, true, 512, true>(F.lds, idxring, ws + WS_ACT, ws + WS_WDN, S, E);
            REPSEAM(6);
        }
        SEAM(6);
        if (IN(7)) {
            KP_FRESH(); float* out = KOUT(); const float* x = KIN(const float*, 0); unsigned char* ws = KWS(); const unsigned char* Y8 = ws + WS_Y; const bf16_t* HM = (const bf16_t*)(ws + WS_HM);
            const int gt = blockIdx.x * (NWAVES * 64) + F.tid, NGT = F.G * NWAVES * 64;
            for (int it = gt; it < T * 128; it += NGT) { const int tl = it >> 7, c8 = (it & 127) * 8; const size_t o = (size_t)tl * D + c8;
                f32x4 h0 = *(const f32x4*)(x + o), h1 = *(const f32x4*)(x + o + 4); const u32x4 hm = *(const u32x4*)(HM + o);
                u32x2 yv[4];
#pragma unroll
                for (int k = 0; k < 4; ++k) yv[k] = *(const u32x2*)(Y8 + (size_t)(tl * 4 + k) * D + c8);
                h0[0] += __builtin_bit_cast(float, hm[0] << 16); h0[1] += __builtin_bit_cast(float, hm[0] & 0xffff0000u); h0[2] += __builtin_bit_cast(float, hm[1] << 16); h0[3] += __builtin_bit_cast(float, hm[1] & 0xffff0000u);
                h1[0] += __builtin_bit_cast(float, hm[2] << 16); h1[1] += __builtin_bit_cast(float, hm[2] & 0xffff0000u); h1[2] += __builtin_bit_cast(float, hm[3] << 16); h1[3] += __builtin_bit_cast(float, hm[3] & 0xffff0000u);
                f32x4 s0 = {0.f, 0.f, 0.f, 0.f}, s1 = {0.f, 0.f, 0.f, 0.f};
#pragma unroll
                for (int k = 0; k < 4; ++k) { const f32x2 a = __builtin_amdgcn_cvt_pk_f32_fp8((int)yv[k].x, false), b = __builtin_amdgcn_cvt_pk_f32_fp8((int)yv[k].x, true),
                                                          c = __builtin_amdgcn_cvt_pk_f32_fp8((int)yv[k].y, false), d = __builtin_amdgcn_cvt_pk_f32_fp8((int)yv[k].y, true);
                    s0[0] += a[0]; s0[1] += a[1]; s0[2] += b[0]; s0[3] += b[1]; s1[0] += c[0]; s1[1] += c[1]; s1[2] += d[0]; s1[3] += d[1]; }
                *(f32x4*)(out + o) = h0 + s0 * (1.0f / Y8_SCALE); *(f32x4*)(out + o + 4) = h1 + s1 * (1.0f / Y8_SCALE); }
        }
    }
#undef IN
#undef SEAM
}

extern "C" void kernel_launch(void* const* d_in, const int* in_sizes, int n_in, void* d_out, int out_size, void* d_ws, size_t ws_size, hipStream_t stream) {
    static int grid = 0;
    if (grid == 0) {
        if (n_in != 17 || out_size != T * D || ws_size < WS_END) { fprintf(stderr, "kernel_launch: unexpected shapes (n_in %d out %d ws %zu)\n", n_in, out_size, ws_size); grid = -1; return; }
        int dev = 0, cus = 0, per_cu = 0;
        if (hipGetDevice(&dev) != hipSuccess || hipDeviceGetAttribute(&cus, hipDeviceAttributeMultiprocessorCount, dev) != hipSuccess) { grid = -1; return; }
        if (hipFuncSetAttribute((const void*)hymba_fwd, hipFuncAttributeMaxDynamicSharedMemorySize, LDS_BYTES) != hipSuccess) { fprintf(stderr, "kernel_launch: hipFuncSetAttribute failed\n"); grid = -1; return; }
        if (hipOccupancyMaxActiveBlocksPerMultiprocessor(&per_cu, (const void*)hymba_fwd, NWAVES * 64, LDS_BYTES) != hipSuccess || per_cu < 1) { fprintf(stderr, "kernel_launch: occupancy query says %d\n", per_cu); }
        (void)hipGetLastError();
        grid = cus;
    }
    if (grid < 0) return;
    (void)hipMemsetAsync((char*)d_ws + WS_CTL, 0, CTL_ZERO_BYTES, stream);
    Args a{};
    for (int i = 0; i < 17; ++i) a.in[i] = d_in[i];
    a.out = (float*)d_out; a.ws = (unsigned char*)d_ws;
    for (int p = 0; p < 8; ++p) a.invf[p] = (float)pow(500000.0, -(double)p / 8.0);
    if (N_LAUNCHES == 1) { a.ph_lo = 0; a.ph_hi = NPH; hipLaunchKernelGGL(hymba_fwd, dim3(grid), dim3(NWAVES * 64), LDS_BYTES, stream, a); }
    else for (int li = 0; li < NPH; ++li) { a.ph_lo = li; a.ph_hi = li + 1; hipLaunchKernelGGL(hymba_fwd, dim3(grid), dim3(NWAVES * 64), LDS_BYTES, stream, a); }
}
```

```cpp
#include <hip/hip_runtime.h>
#include <cstdio>
#include <cstdint>
#include <cmath>

#ifndef MK_XLOCAL
#define MK_XLOCAL 1
#endif
#ifndef MK_N_LAUNCHES
#define MK_N_LAUNCHES 1
#endif

#define LAS __attribute__((address_space(3)))
#define GAS __attribute__((address_space(1)))
typedef unsigned short bf16_t;
typedef short bf16x8 __attribute__((ext_vector_type(8)));
typedef __bf16 bf16x2_t __attribute__((ext_vector_type(2)));
typedef short s16x4 __attribute__((ext_vector_type(4)));
typedef float f32x4 __attribute__((ext_vector_type(4)));
typedef float f32x2 __attribute__((ext_vector_type(2)));
typedef float f32x16 __attribute__((ext_vector_type(16)));
typedef unsigned u32x4 __attribute__((ext_vector_type(4)));
typedef unsigned u32x2 __attribute__((ext_vector_type(2)));
typedef GAS unsigned gu32;
typedef int v4i32 __attribute__((ext_vector_type(4)));
typedef int v8i32 __attribute__((ext_vector_type(8)));

constexpr int NB = 16, SEQ = 4096, T = NB * SEQ, D = 1024, NIN = 1280, NE = 32, FF = 1024;
constexpr float NORM_EPS = 1e-5f, QK_EPS = 1e-6f;
constexpr float LOG2E = 1.4426950408889634f;
constexpr float C2 = 0.125f * LOG2E;
constexpr int NWAVES = 8;
constexpr int NPH = 8;
constexpr int N_LAUNCHES = MK_N_LAUNCHES;
constexpr float W8_SCALE = 64.0f;
constexpr int SCALE_ONE = 0x7F7F7F7F, SCALE_W = 0x79797979;
constexpr float Y8_SCALE = 16.0f;

constexpr size_t MiB = 1u << 20;
constexpr size_t WS_CTL = 0, CTL_ZERO_BYTES = 32 * 1024;
constexpr size_t WS_WIN = 1 * MiB, WIN_GS = 0;
constexpr size_t WS_WOUT = 25 * MiB, WOUT_GS = 0;
constexpr size_t WS_WR = 41 * MiB, WR_GS = 0;
constexpr size_t WS_ROPE = 45 * MiB;
constexpr size_t WS_RS1 = 49 * MiB;
constexpr size_t WS_RS2 = 49 * MiB + 512 * 1024;
constexpr size_t WS_GATE = 50 * MiB;
constexpr size_t WS_LIST = 51 * MiB;
constexpr size_t WS_WGU = 59 * MiB;
constexpr size_t WS_WDN = 123 * MiB;
constexpr size_t WS_H8 = 155 * MiB;
constexpr size_t WS_GRP = 219 * MiB;
constexpr size_t WS_Y = 483 * MiB;
constexpr size_t WS_HM = 747 * MiB;
constexpr size_t WS_EP = 875 * MiB;
constexpr size_t WS_XB = 876 * MiB;
constexpr size_t WS_END = 1004 * MiB;
constexpr size_t GRP_GS = 0;
static_assert((size_t)(T * 4 + NE * 256) * 1024 <= 264 * MiB, "act / y regions");
constexpr int CW_CNT = 64;
constexpr int CW_LBAR = 2048;
constexpr int CW_CEN = 1024;
constexpr int CW_CHK = 200;
constexpr int CW_BAR = 4096;

constexpr int RING_BYTES = 131072;
constexpr int L_MISC = RING_BYTES;
constexpr int L_CNT = RING_BYTES + 512;
constexpr int L_PREF = RING_BYTES + 640;
constexpr int L_IDX = RING_BYTES + 1024;
constexpr int L_TINFO = RING_BYTES + 4096;
constexpr int L_RSCR = RING_BYTES + 8704;
constexpr int L_RH = RING_BYTES + 25600;
constexpr int L_UTAB = RING_BYTES + 26624;
constexpr int LDS_BYTES = RING_BYTES + 27648;

#define RLX_AGENT __ATOMIC_RELAXED, __HIP_MEMORY_SCOPE_AGENT
#define LDS_WAIT() asm volatile("s_waitcnt lgkmcnt(0)" ::: "memory")
#define VM_WAIT() asm volatile("s_waitcnt vmcnt(0)" ::: "memory")

__device__ __forceinline__ unsigned f2bf(float f) { unsigned u = __builtin_bit_cast(unsigned, f); return (u + 0x7fffu + ((u >> 16) & 1u)) >> 16; }
__device__ __forceinline__ unsigned pk2(float lo, float hi) { return f2bf(lo) | (f2bf(hi) << 16); }
__device__ __forceinline__ unsigned cvt_pk_bf16(float lo, float hi) { unsigned r; asm volatile("v_cvt_pk_bf16_f32 %0, %1, %2" : "=v"(r) : "v"(lo), "v"(hi)); return r; }
__device__ __forceinline__ unsigned pk4_fp8(float a, float b, float c, float d) { unsigned w = 0; w = __builtin_amdgcn_cvt_pk_fp8_f32(a, b, w, false); w = __builtin_amdgcn_cvt_pk_fp8_f32(c, d, w, true); return w; }
__device__ __forceinline__ float bf2f(unsigned short b) { return __builtin_bit_cast(float, (unsigned)b << 16); }

#define XB_TMO      128
#define XB_XCNT(j)  (256  + 64 * (j))
#define XB_XSUB(j)  (1280 + 64 * (j))
#define XB_XGEN(j)  (2304 + 64 * (j))
#define XB_TOP      3328
#define XB_TOPGEN   3392
#define XCD_BAR_WORDS 3456
#define XB_SPIN_CAP (1u << 23)
__device__ __forceinline__ unsigned xb_ld(unsigned* p)              { return __hip_atomic_load(p, __ATOMIC_RELAXED, __HIP_MEMORY_SCOPE_AGENT); }
__device__ __forceinline__ unsigned xb_add(unsigned* p, unsigned v) { return __hip_atomic_fetch_add(p, v, __ATOMIC_RELAXED, __HIP_MEMORY_SCOPE_AGENT); }
__device__ __forceinline__ unsigned xb_xcc_id() { return (unsigned)__builtin_amdgcn_s_getreg((3 << 11) | 20) & 0xFu; }
#define XB_SPIN(cond, bar) do { unsigned _sp = 0; while (cond) { __builtin_amdgcn_s_sleep(1); \
    if ((++_sp & 255u) == 0u) { if (xb_ld(&(bar)[XB_TMO])) break; if (_sp > XB_SPIN_CAP) { atomicAdd(&(bar)[XB_TMO], 1u); break; } } } } while (0)
struct XcdBarrier { unsigned* bar; unsigned x; volatile LAS unsigned* st; };
__device__ __forceinline__ XcdBarrier xcd_barrier_post(unsigned* bar, volatile LAS unsigned* st) {
    XcdBarrier b; b.bar = bar; b.x = xb_xcc_id(); b.st = st;
    if (threadIdx.x == 0) (void)xb_add(&bar[XB_XCNT(b.x)], 1u);
    return b;
}
__device__ __forceinline__ void xcd_barrier_complete(unsigned* bar, unsigned x, unsigned& nloc, unsigned& nx) {
    const unsigned G = gridDim.x * gridDim.y * gridDim.z;
    unsigned sum, cnt, mine, sp = 0u;
    for (;;) {
        sum = 0u; cnt = 0u; mine = 0u;
#pragma unroll
        for (unsigned j = 0; j < 16; ++j) { const unsigned c = xb_ld(&bar[XB_XCNT(j)]); sum += c; cnt += (c > 0u) ? 1u : 0u; mine = (j == x) ? c : mine; }
        if (sum == G) break;
        __builtin_amdgcn_s_sleep(1);
        if ((++sp & 255u) == 0u) { if (xb_ld(&bar[XB_TMO])) break; if (sp > XB_SPIN_CAP) { atomicAdd(&bar[XB_TMO], 1u); break; } }
    }
    nloc = mine > 0u ? mine : 1u; nx = cnt > 0u ? cnt : 1u;
}
__device__ __forceinline__ void xcd_barrier(const XcdBarrier& b) {
    asm volatile("s_waitcnt vmcnt(0)" ::: "memory");
    __syncthreads();
    if (threadIdx.x == 0) {
        unsigned* bar = b.bar;
        __builtin_amdgcn_s_waitcnt(0);
        unsigned nloc = b.st[0], nx = b.st[1];
        if (nloc == 0u) { xcd_barrier_complete(bar, b.x, nloc, nx); b.st[0] = nloc; b.st[1] = nx; }
        const unsigned old = xb_add(&bar[XB_XSUB(b.x)], 1u);
        const unsigned gen = old / nloc;
        if (old + 1u == (gen + 1u) * nloc) {
            __builtin_amdgcn_fence(__ATOMIC_RELEASE, "agent");
            asm volatile("s_waitcnt vmcnt(0)" ::: "memory");
            const unsigned og = xb_add(&bar[XB_TOP], 1u);
            const unsigned tg = og / nx;
            if (og + 1u == (tg + 1u) * nx) xb_add(&bar[XB_TOPGEN], 1u);
            else XB_SPIN(xb_ld(&bar[XB_TOPGEN]) == tg, bar);
            __builtin_amdgcn_fence(__ATOMIC_ACQUIRE, "agent");
            xb_add(&bar[XB_XGEN(b.x)], 1u);
            asm volatile("s_waitcnt vmcnt(0)" ::: "memory");
        } else {
            XB_SPIN(xb_ld(&bar[XB_XGEN(b.x)]) == gen, bar);
            __builtin_amdgcn_fence(__ATOMIC_ACQUIRE, "agent");
            asm volatile("s_waitcnt vmcnt(0)" ::: "memory");
        }
    }
    __syncthreads();
}

__device__ __forceinline__ void xcc_barrier(unsigned* cnt, unsigned nloc, unsigned& gen) {
    asm volatile("s_waitcnt vmcnt(0)" ::: "memory");
    __syncthreads();
    ++gen;
    if (threadIdx.x == 0) {
        __builtin_amdgcn_s_waitcnt(0);
        (void)xb_add(cnt, 1u);
        unsigned sp = 0u; while (xb_ld(cnt) < gen * nloc) { __builtin_amdgcn_s_sleep(1); if (++sp > XB_SPIN_CAP) break; }
        __builtin_amdgcn_fence(__ATOMIC_ACQUIRE, "agent");
        asm volatile("s_waitcnt vmcnt(0)" ::: "memory");
    }
    __syncthreads();
}

namespace pg8 {
constexpr int BM = 256, BK = 64, HALF = 128, HTB = HALF * BK * 2;
__host__ __device__ __forceinline__ int lds_byte(int r, int c) { const int st = (r >> 4) * 2 + (c >> 5), rr = r & 15, cc = c & 31, ob = rr * 64 + cc * 2; return st * 1024 + (ob ^ (((ob >> 9) & 1) << 5)); }
__host__ __device__ __forceinline__ void stage_rc(int b, int& R, int& C) { const int st = b / 1024, sb = b % 1024, swz = sb ^ (((sb >> 9) & 1) << 5); R = (st >> 1) * 16 + swz / 64; C = (st & 1) * 32 + (swz % 64) / 2; }
__host__ __device__ __forceinline__ int perm32(int rho) { const int n = rho >> 4, i = rho & 15; return 8 * (i >> 2) + 4 * n + (i & 3); }

union Frag { v8i32 v; bf16x8 pc[2]; };
struct Unit { int pm, pn, bt, e, j, nvalid; };

__device__ __forceinline__ bool order_tile(int i, int nM, int nN, int G, int c, int& pm, int& pn, const int WGM, const int NXCD) {
    const int nwg = nM * nN; const long L = (long)i * G + c; if (L >= nwg) return false;
    int wgid = (int)L; { const int q = nwg / NXCD, r = nwg % NXCD, xcd = wgid % NXCD, off = wgid / NXCD; wgid = (xcd < r ? xcd * (q + 1) : r * (q + 1) + (xcd - r) * q) + off; }
    const int nig = WGM * nN, gid = wgid / nig, fm = gid * WGM, gsz = (nM - fm) < WGM ? (nM - fm) : WGM;
    pm = fm + ((wgid % nig) % gsz); pn = (wgid % nig) / gsz; return true;
}
constexpr int MAX_UNITS = 64;
template <bool OWNROWS = false>
__device__ __forceinline__ int build_units(LAS int* tab, int nM, int nN, int G, int c, int nxcd, const LAS int* tinfo, const LAS int* cnt, const int wgm = 8) {
    const int nwg = nM * nN; int nU = (nwg > c) ? (nwg - c + G - 1) / G : 0;
    if (OWNROWS) nU = (nM > c) ? ((nM - c + G - 1) / G) * nN : 0;
    __syncthreads();
    const int i = threadIdx.x;
    if (i < nU && i < MAX_UNITS) { int pm = 0, pn = 0; if (OWNROWS) { pm = c + G * (i / nN); pn = i % nN; } else order_tile(i, nM, nN, G, c, pm, pn, wgm, nxcd);
        int e = 0, j = 0, nv = 256;
        if (tinfo) { const int ti = tinfo[pm]; e = ti & 255; j = ti >> 8; const int c_ = cnt[e] - 256 * j; nv = c_ < 256 ? c_ : 256; }
        tab[4 * i] = pm; tab[4 * i + 1] = pn; tab[4 * i + 2] = e * nN + pn; tab[4 * i + 3] = e | (j << 8) | (nv << 20); }
    __syncthreads();
    return nU < MAX_UNITS ? nU : MAX_UNITS;
}
struct TabOrder {
    const LAS int* tab; int nU; const int* list; int lcap;
    __device__ __forceinline__ bool next(int i, Unit& u) const {
        if (i >= nU) return false;
        const int w3 = __builtin_amdgcn_readfirstlane(tab[4 * i + 3]);
        u.pm = __builtin_amdgcn_readfirstlane(tab[4 * i]); u.pn = __builtin_amdgcn_readfirstlane(tab[4 * i + 1]); u.bt = __builtin_amdgcn_readfirstlane(tab[4 * i + 2]);
        u.e = w3 & 255; u.j = (w3 >> 8) & 4095; u.nvalid = w3 >> 20; return true;
    }
    __device__ __forceinline__ const int* idx_src(const Unit& u) const { return list + (size_t)u.e * lcap + 256 * u.j; }
};

template <class Epi, class Sched, int AMODE, bool HAS_IDX, int K, bool F8, bool ALIGN_EPI = true>
__device__ __forceinline__ void gemm_phase(LAS unsigned char* lds, LAS int* idxring, LAS float* rmeta, const void* Ag, const void* Btg, const Sched& S, const Epi& E) {
    const int tid = threadIdx.x, wid = __builtin_amdgcn_readfirstlane(tid >> 6), lane = tid & 63, wr = wid >> 2, wc = wid & 3, fr = lane & 15, fq = lane >> 4;
    const int nt = K / BK;
    unsigned voffB[2];
#pragma unroll
    for (int i = 0; i < 2; ++i) { int R, C; stage_rc(tid * 16 + i * 8192, R, C); const int Rb = Epi::PERM ? ((R & ~31) + perm32(R & 31)) : R; voffB[i] = (unsigned)(Rb * K + C) * 2u; }
    const size_t kstep = (size_t)(BK * 2);
    const size_t hstep = (size_t)HALF * K * 2;
    const size_t tstep = 2 * hstep;
    const unsigned ldsw = (unsigned)wid * 1024u;
    const int aoff = lds_byte(wr * 64 + fr, fq * 8), boff = lds_byte(wc * 32 + fr, fq * 8);
#define PG8_SA(b, h) (((b) * 2 + (h)) * HTB)
#define PG8_SB(b, h) ((4 + (b) * 2 + (h)) * HTB)
#define PG8_STAGE_B(bufoff, gbase) do { _Pragma("unroll") for (int _i = 0; _i < 2; ++_i) \
        __builtin_amdgcn_global_load_lds((const unsigned*)((const char*)(gbase) + voffB[_i]), (LAS unsigned*)(lds + (bufoff) + ldsw + _i * 8192), 16, 0, 0); } while (0)
#define PG8_STAGE_A(bufoff, kb, AO, h) do { _Pragma("unroll") for (int _i = 0; _i < 2; ++_i) \
        __builtin_amdgcn_global_load_lds((const unsigned*)((const char*)Ag + (kb) + (AO)[h][_i]), (LAS unsigned*)(lds + (bufoff) + ldsw + _i * 8192), 16, 0, 0); } while (0)
#define PG8_LDA(dst, b, h) do { _Pragma("unroll") for (int m = 0; m < 4; ++m) _Pragma("unroll") for (int k = 0; k < 2; ++k) dst[m][k] = *(const LAS bf16x8*)(lds + PG8_SA(b, h) + aoff + m * 2048 + k * 1024); } while (0)
#define PG8_LDB(dst, b, h) do { _Pragma("unroll") for (int n = 0; n < 2; ++n) _Pragma("unroll") for (int k = 0; k < 2; ++k) dst[n][k] = *(const LAS bf16x8*)(lds + PG8_SB(b, h) + boff + n * 2048 + k * 1024); } while (0)
#define PG8_MMA_G(ai, bj, At, Bt, ZERO) do { __builtin_amdgcn_s_setprio(1); _Pragma("unroll") for (int m = 0; m < 4; ++m) _Pragma("unroll") for (int n = 0; n < 2; ++n) { \
        if constexpr (F8) { \
            const v8i32 bv_ = __builtin_shufflevector(__builtin_bit_cast(v4i32, Bt[n][0]), __builtin_bit_cast(v4i32, Bt[n][1]), 0, 1, 2, 3, 4, 5, 6, 7); \
            const v8i32 av_ = __builtin_shufflevector(__builtin_bit_cast(v4i32, At[m][0]), __builtin_bit_cast(v4i32, At[m][1]), 0, 1, 2, 3, 4, 5, 6, 7); \
            acc[ai][bj][m][n] = __builtin_amdgcn_mfma_scale_f32_16x16x128_f8f6f4(bv_, av_, (ZERO) ? (f32x4){0.f, 0.f, 0.f, 0.f} : acc[ai][bj][m][n], 0, 0, 0, 0, 0, 0);   } \
        else { acc[ai][bj][m][n] = __builtin_amdgcn_mfma_f32_16x16x32_bf16(Bt[n][0], At[m][0], (ZERO) ? (f32x4){0.f, 0.f, 0.f, 0.f} : acc[ai][bj][m][n], 0, 0, 0); \
               acc[ai][bj][m][n] = __builtin_amdgcn_mfma_f32_16x16x32_bf16(Bt[n][1], At[m][1], acc[ai][bj][m][n], 0, 0, 0); } } \
        __builtin_amdgcn_s_setprio(0); } while (0)
#define PG8_MMA(ai, bj, At, Bt) PG8_MMA_G(ai, bj, At, Bt, 0)
#define PG8_MMA2(ai, At) do { if (!Epi::INIT && t == 0) { PG8_MMA_G(ai, 0, At, B0, 1); PG8_MMA_G(ai, 1, At, B1, 1); } else { PG8_MMA_G(ai, 0, At, B0, 0); PG8_MMA_G(ai, 1, At, B1, 0); } } while (0)
#define PG8_WAIT_V(n) asm volatile("s_waitcnt vmcnt(" #n ")" ::: "memory")
#define PG8_WAIT_L(n) asm volatile("s_waitcnt lgkmcnt(" #n ")" ::: "memory")
#define PG8_BAR __builtin_amdgcn_s_barrier()
#define PG8_SCHED __builtin_amdgcn_sched_barrier(0)
#define PG8_AOFF(dst, U, islot) do { int _t = tid; asm volatile("" : "+v"(_t)); _Pragma("unroll") for (int _i = 0; _i < 2; ++_i) { int _R, _C; stage_rc(_t * 16 + _i * 8192, _R, _C); \
        _Pragma("unroll") for (int _h = 0; _h < 2; ++_h) { \
        int _row; if (AMODE == 0) _row = (U).pm * BM + _h * HALF + _R; else _row = (idxring[(islot) * 256 + _h * HALF + _R] >> 2) & (T - 1);   \
        dst[_h][_i] = ((unsigned)_row * (unsigned)K + (unsigned)_C) * 2u; } } } while (0)
    Unit cur, nxt; int ui = 0, islot = 0;
    if (!S.next(0, cur)) return;
    if (HAS_IDX) {
        if (wid == 0) { __builtin_amdgcn_global_load_lds((const unsigned*)(S.idx_src(cur) + lane * 4), (LAS unsigned*)(idxring), 16, 0, 0); PG8_WAIT_V(0); }
        __syncthreads();
    }
    f32x4 acc[2][2][4][2];
#define PG8_ACC_INIT(U) do { if constexpr (Epi::INIT) E.init(acc, U, wr, wc, fr, fq); } while (0)
    PG8_ACC_INIT(cur);
    bf16x8 At[4][2], B0[2][2], B1[2][2];
    unsigned ao[2][2];
    PG8_AOFF(ao, cur, 0);
    const char* cB = (const char*)Btg + (size_t)cur.bt * tstep;
    PG8_STAGE_B(PG8_SB(0, 0), cB); PG8_STAGE_B(PG8_SB(0, 1), cB + hstep); PG8_STAGE_A(PG8_SA(0, 0), 0, ao, 0); PG8_STAGE_A(PG8_SA(0, 1), 0, ao, 1);
    if (wr == 1) PG8_BAR;
    PG8_WAIT_V(2); PG8_BAR;
    PG8_STAGE_B(PG8_SB(1, 0), cB + kstep); PG8_STAGE_A(PG8_SA(1, 0), kstep, ao, 0); PG8_STAGE_B(PG8_SB(1, 1), cB + hstep + kstep);
    PG8_WAIT_V(6); PG8_BAR;
    for (;;) {
        const bool has_next = S.next(ui + 1, nxt);
        const int nslot = (islot == 2) ? 0 : islot + 1;
        if (HAS_IDX && has_next && wid == 0)
            __builtin_amdgcn_global_load_lds((const unsigned*)(S.idx_src(nxt) + lane * 4), (LAS unsigned*)(idxring + nslot * 256), 16, 0, 0);
        const char* nB = has_next ? (const char*)Btg + (size_t)nxt.bt * tstep : cB;
#pragma unroll 1
        for (int t = 0; t < nt; t += 2) {
            const bool last = (t == nt - 2);
            if (last) {
                if constexpr (Epi::RM == 1) { if (wid == 0) __builtin_amdgcn_global_load_lds((const unsigned*)(E.rm_base + (size_t)cur.pm * BM + lane * 4), (LAS unsigned*)rmeta, 16, 0, 0);
                }
                if constexpr (Epi::PRE) E.pre(cur, wid, lane, rmeta);
                if constexpr (Epi::RM == 2) { if (wid < 4) { const int id_ = idxring[islot * 256 + 64 * wid + lane];
                    __builtin_amdgcn_global_load_lds((const unsigned*)(E.rm_base + ((id_ & (4 * T - 1)) >> Epi::RM_SHIFT)), (LAS unsigned*)(rmeta + 64 * wid), 4, 0, 0); } }
            }
            const size_t k1 = (size_t)(t + 1) * kstep;
            const size_t k2 = last ? 0 : (size_t)(t + 2) * kstep, k3 = k2 + kstep;
            const char* b2 = last ? nB : cB + (size_t)(t + 2) * kstep; const char* b3 = b2 + kstep;
            PG8_LDB(B0, 0, 0); PG8_LDB(B1, 0, 1); PG8_SCHED; PG8_LDA(At, 0, 0); PG8_STAGE_A(PG8_SA(1, 1), k1, ao, 1);
            if (last && has_next) { PG8_AOFF(ao, nxt, nslot); }
            PG8_WAIT_V(8); PG8_WAIT_L(0); PG8_BAR; PG8_MMA2(0, At); PG8_BAR; PG8_SCHED;
            PG8_LDA(At, 0, 1); PG8_STAGE_B(PG8_SB(0, 0), b2); PG8_STAGE_B(PG8_SB(0, 1), b2 + hstep); PG8_STAGE_A(PG8_SA(0, 0), k2, ao, 0);
            PG8_WAIT_V(8); PG8_WAIT_L(0); PG8_BAR; PG8_MMA2(1, At); PG8_BAR; PG8_SCHED;
            PG8_LDB(B0, 1, 0); PG8_LDB(B1, 1, 1); PG8_SCHED; PG8_LDA(At, 1, 0); PG8_STAGE_A(PG8_SA(0, 1), k2, ao, 1);
            PG8_WAIT_V(8); PG8_WAIT_L(0); PG8_BAR; PG8_MMA(0, 0, At, B0); PG8_MMA(0, 1, At, B1); PG8_BAR; PG8_SCHED;
            PG8_LDA(At, 1, 1); PG8_STAGE_B(PG8_SB(1, 0), b3); PG8_STAGE_B(PG8_SB(1, 1), b3 + hstep); PG8_STAGE_A(PG8_SA(1, 0), k3, ao, 0);
            PG8_WAIT_V(8); PG8_WAIT_L(0); PG8_BAR; PG8_MMA(1, 0, At, B0); PG8_MMA(1, 1, At, B1); PG8_BAR; PG8_SCHED;
        }
        if (ALIGN_EPI) { if (wr == 0) PG8_BAR; }
        E(acc, cur, wr, wc, fr, fq, (const LAS int*)(idxring + islot * 256), (const LAS float*)rmeta);
        if (!has_next) break;
        PG8_ACC_INIT(nxt);
        cur = nxt; cB = nB; ++ui; islot = nslot;
        if (ALIGN_EPI) { if (wr == 1) PG8_BAR; }
    }
    PG8_WAIT_V(0);
    if (!ALIGN_EPI) { if (wr == 0) PG8_BAR; }
    PG8_BAR;
#undef PG8_SA
#undef PG8_SB
#undef PG8_STAGE_A
#undef PG8_STAGE_B
#undef PG8_LDA
#undef PG8_LDB
#undef PG8_MMA
#undef PG8_MMA2
#undef PG8_MMA_G
#undef PG8_WAIT_V
#undef PG8_WAIT_L
#undef PG8_BAR
#undef PG8_SCHED
#undef PG8_AOFF
#undef PG8_ACC_INIT
}

__device__ __forceinline__ u32x4 pair16(const u32x2 a, const u32x2 b) {
    const auto r0 = __builtin_amdgcn_permlane16_swap(a.x, b.x, false, false), r1 = __builtin_amdgcn_permlane16_swap(a.y, b.y, false, false);
    return (u32x4){r0[0], r1[0], r0[1], r1[1]};
}
__device__ __forceinline__ u32x4 pack8(const f32x4 a, const f32x4 b) { u32x4 w; w.x = cvt_pk_bf16(a[0], a[1]); w.y = cvt_pk_bf16(a[2], a[3]); w.z = cvt_pk_bf16(b[0], b[1]); w.w = cvt_pk_bf16(b[2], b[3]); return w; }

struct EpiInProj {
    static constexpr bool PERM = true, INIT = false, PRE = true; static constexpr int RM = 1, RM_SHIFT = 0;
    bf16_t *Q, *Kb, *Vb, *U; const float *rm_base  , *rope, *qw, *kw; LAS float* ropel;
    __device__ __forceinline__ void pre(const Unit& u, int wid, int lane, LAS float* rm) const {
        if (u.pn < 3) {
            if (wid == 1 && lane < 32) __builtin_amdgcn_global_load_lds((const unsigned*)((lane < 16 ? qw : kw - 64) + lane * 4), (LAS unsigned*)(rm + 256), 16, 0, 0);
#pragma unroll
            for (int i = 0; i < 2; ++i)
                __builtin_amdgcn_global_load_lds((const unsigned*)(rope + (size_t)u.pm * BM * 16 + i * 2048 + wid * 256 + lane * 4), (LAS unsigned*)(ropel + i * 2048 + wid * 256), 16, 0, 0); }
    }
    __device__ __forceinline__ void operator()(const f32x4 (&acc)[2][2][4][2], const Unit& u, int wr, int wc, int fr, int fq, const LAS int*, const LAS float* rm) const {
        const int row0 = u.pm * BM + wr * 64 + fr;
        float sv[2][4];
#pragma unroll
        for (int ai = 0; ai < 2; ++ai)
#pragma unroll
            for (int m = 0; m < 4; ++m) sv[ai][m] = rm[wr * 64 + fr + ai * HALF + m * 16];
        if (u.pn >= 3) {
#pragma unroll
            for (int ai = 0; ai < 2; ++ai)
#pragma unroll
                for (int m = 0; m < 4; ++m) { const int row = row0 + ai * HALF + m * 16; const float s = sv[ai][m];
                    bf16_t* rp = U + (size_t)row * 512 + (u.pn - 3) * 256 + wc * 32 + 8 * fq;
#pragma unroll
                    for (int bj = 0; bj < 2; ++bj) *(u32x4*)(rp + bj * HALF) = pack8(acc[ai][bj][m][0] * s, acc[ai][bj][m][1] * s); }
            return;
        }
        const bool isv = (u.pn == 2 && wc >= 2);
        bf16_t* dst; int ld; const LAS float* w; float post;
        if (u.pn < 2) { dst = Q + (4 * u.pn + wc) * 64; ld = 512; w = rm + 256; post = C2; }
        else if (wc < 2) { dst = Kb + wc * 64; ld = 128; w = rm + 320; post = 1.f; }
        else { dst = Vb + (wc - 2) * 64; ld = 128; w = rm + 256; post = 1.f; }
        f32x4 wv[2][2];
#pragma unroll
        for (int bj = 0; bj < 2; ++bj)
#pragma unroll
            for (int n = 0; n < 2; ++n) wv[bj][n] = *(const LAS f32x4*)(w + 32 * bj + 8 * fq + 4 * n);
#pragma unroll
        for (int ai = 0; ai < 2; ++ai) {
#pragma unroll
            for (int m = 0; m < 4; ++m) {
                const int row = row0 + ai * HALF + m * 16; const float s = sv[ai][m];
                f32x4 x[2][2];
#pragma unroll
                for (int bj = 0; bj < 2; ++bj)
#pragma unroll
                    for (int n = 0; n < 2; ++n) x[bj][n] = acc[ai][bj][m][n] * s;
                if (!isv) {
                    float ss = 0.f;
#pragma unroll
                    for (int bj = 0; bj < 2; ++bj)
#pragma unroll
                        for (int n = 0; n < 2; ++n) ss += (x[bj][n][0] * x[bj][n][0] + x[bj][n][1] * x[bj][n][1]) + (x[bj][n][2] * x[bj][n][2] + x[bj][n][3] * x[bj][n][3]);
                    ss += __shfl_xor(ss, 16); ss += __shfl_xor(ss, 32);
                    const float rn = 1.0f / sqrtf(ss * (1.0f / 64.0f) + QK_EPS);
#pragma unroll
                    for (int bj = 0; bj < 2; ++bj)
#pragma unroll
                        for (int n = 0; n < 2; ++n) x[bj][n] = x[bj][n] * rn * wv[bj][n];
                    const LAS float* rp = ropel + (wr * 64 + fr + ai * HALF + m * 16) * 16;
#pragma unroll
                    for (int n = 0; n < 2; ++n) {
                        const f32x4 cs = *(const LAS f32x4*)(rp + 4 * n), sn = *(const LAS f32x4*)(rp + 8 + 4 * n);
                        f32x4 pr;
#pragma unroll
                        for (int c = 0; c < 4; ++c) pr[c] = __shfl_xor(x[0][n][c], 16);
                        const f32x4 r0 = x[0][n] * cs - pr * sn, r1 = x[0][n] * cs + pr * sn;
                        if (fq == 0) x[0][n] = r0; else if (fq == 1) x[0][n] = r1;
                    }
#pragma unroll
                    for (int bj = 0; bj < 2; ++bj)
#pragma unroll
                        for (int n = 0; n < 2; ++n) x[bj][n] = x[bj][n] * post;
                }
                bf16_t* op = dst + (size_t)row * ld + 8 * fq;
#pragma unroll
                for (int bj = 0; bj < 2; ++bj) *(u32x4*)(op + 32 * bj) = pack8(x[bj][0], x[bj][1]);
            }
        }
    }
};
struct EpiOutProj {
    static constexpr bool PERM = true, INIT = false, PRE = false; static constexpr int RM = 0, RM_SHIFT = 0;
    bf16_t* h; unsigned char* h8; const bf16_t* xb;
    __device__ __forceinline__ void operator()(const f32x4 (&acc)[2][2][4][2], const Unit& u, int wr, int wc, int fr, int fq, const LAS int*, const LAS float*) const {
        const int row0 = u.pm * BM + wr * 64 + fr, col0 = u.pn * BM + wc * 32 + 8 * fq;
        u32x4 xv[2][4][2];
#pragma unroll
        for (int ai = 0; ai < 2; ++ai)
#pragma unroll
            for (int m = 0; m < 4; ++m)
#pragma unroll
                for (int bj = 0; bj < 2; ++bj) xv[ai][m][bj] = *(const u32x4*)(xb + (size_t)(row0 + ai * HALF + m * 16) * D + col0 + bj * HALF);
#pragma unroll
        for (int ai = 0; ai < 2; ++ai)
#pragma unroll
            for (int mp = 0; mp < 2; ++mp) { const int r8 = row0 + ai * HALF + (2 * mp + (fq & 1)) * 16;
#pragma unroll
                for (int bj = 0; bj < 2; ++bj) { u32x2 wv[2];
#pragma unroll
                    for (int q = 0; q < 2; ++q) { const int m = 2 * mp + q; const u32x4 xw = xv[ai][m][bj];
                        f32x4 h0 = acc[ai][bj][m][0], h1 = acc[ai][bj][m][1];
                        h0[0] += __builtin_bit_cast(float, xw[0] << 16); h0[1] += __builtin_bit_cast(float, xw[0] & 0xffff0000u); h0[2] += __builtin_bit_cast(float, xw[1] << 16); h0[3] += __builtin_bit_cast(float, xw[1] & 0xffff0000u);
                        h1[0] += __builtin_bit_cast(float, xw[2] << 16); h1[1] += __builtin_bit_cast(float, xw[2] & 0xffff0000u); h1[2] += __builtin_bit_cast(float, xw[3] << 16); h1[3] += __builtin_bit_cast(float, xw[3] & 0xffff0000u);
                        *(u32x4*)(h + (size_t)(row0 + ai * HALF + m * 16) * D + col0 + bj * HALF) = pack8(h0, h1);
                        wv[q].x = pk4_fp8(h0[0], h0[1], h0[2], h0[3]); wv[q].y = pk4_fp8(h1[0], h1[1], h1[2], h1[3]); }
                    *(u32x4*)(h8 + (size_t)r8 * D + col0 + bj * HALF - 8 * (fq & 1)) = pair16(wv[0], wv[1]); } }
    }
};
struct EpiGU {
    static constexpr bool PERM = true, INIT = false, PRE = true; static constexpr int RM = 2, RM_SHIFT = 2;
    unsigned char* act; const float* rm_base  ; const float* bgu;
    __device__ __forceinline__ void pre(const Unit& u, int wid, int lane, LAS float* rm) const {
        if (wid == 0) __builtin_amdgcn_global_load_lds((const unsigned*)(bgu + (size_t)u.e * 2048 + (lane < 32 ? 0 : 1024 - 128) + u.pn * 128 + lane * 4), (LAS unsigned*)(rm + 256), 16, 0, 0);
    }
    __device__ __forceinline__ void operator()(const f32x4 (&acc)[2][2][4][2], const Unit& u, int wr, int wc, int fr, int fq, const LAS int* idx, const LAS float* rm) const {
        const int r0 = wr * 64 + fr, c0 = u.pn * 128 + wc * 32 + 8 * fq;
        const LAS float* bp = rm + 256 + wc * 32 + 8 * fq;
        constexpr float CZ = -1.702f * LOG2E, ICZ = 1.0f / CZ;
        const f32x4 bg0 = *(const LAS f32x4*)(bp) * CZ, bg1 = *(const LAS f32x4*)(bp + 4) * CZ, bu0p = (*(const LAS f32x4*)(bp + 128) + 1.0f) * ICZ, bu1p = (*(const LAS f32x4*)(bp + 132) + 1.0f) * ICZ;
        float sv[2][4];
#pragma unroll
        for (int ai = 0; ai < 2; ++ai)
#pragma unroll
            for (int m = 0; m < 4; ++m) sv[ai][m] = rm[r0 + ai * HALF + m * 16] * (1.0f / W8_SCALE);
#pragma unroll
        for (int ai = 0; ai < 2; ++ai)
#pragma unroll
            for (int mp = 0; mp < 2; ++mp) { u32x2 wv[2];
#pragma unroll
                for (int q = 0; q < 2; ++q) { const int m = 2 * mp + q; const float sz = sv[ai][m] * CZ, su = sv[ai][m] * ICZ;
                    f32x4 a[2];
#pragma unroll
                    for (int n = 0; n < 2; ++n) {
                        f32x4 z = acc[ai][0][m][n] * sz + (n ? bg1 : bg0), u1 = acc[ai][1][m][n] * su + (n ? bu1p : bu0p);
                        f32x4 e, rc;
#pragma unroll
                        for (int c = 0; c < 4; ++c) { z[c] = fmaxf(z[c], 7.0f * CZ); e[c] = __builtin_amdgcn_exp2f(z[c]); }
                        const f32x4 dn = e + 1.0f;
#pragma unroll
                        for (int c = 0; c < 4; ++c) { rc[c] = __builtin_amdgcn_rcpf(dn[c]); u1[c] = fminf(fmaxf(u1[c], 8.0f * ICZ), -6.0f * ICZ); }
                        a[n] = (z * rc) * u1; }
                    wv[q].x = pk4_fp8(a[0][0], a[0][1], a[0][2], a[0][3]); wv[q].y = pk4_fp8(a[1][0], a[1][1], a[1][2], a[1][3]); }
                const u32x4 w = pair16(wv[0], wv[1]); const int r = r0 + ai * HALF + (2 * mp + (fq & 1)) * 16;
                *(u32x4*)(act + (size_t)(u.pm * BM + r) * FF + c0 - 8 * (fq & 1)) = w; }
    }
};
struct EpiDown {
    static constexpr bool PERM = true, INIT = false, PRE = true; static constexpr int RM = 2, RM_SHIFT = 0;
    unsigned char* y; const float* rm_base  ; const float* bdn;
    __device__ __forceinline__ void pre(const Unit& u, int wid, int lane, LAS float* rm) const {
        if (wid == 0) __builtin_amdgcn_global_load_lds((const unsigned*)(bdn + (size_t)u.e * D + u.pn * BM + lane * 4), (LAS unsigned*)(rm + 256), 16, 0, 0);
    }
    __device__ __forceinline__ void operator()(const f32x4 (&acc)[2][2][4][2], const Unit& u, int wr, int wc, int fr, int fq, const LAS int* idx, const LAS float* rm) const {
        const int r0 = wr * 64 + fr, cw = u.pn * BM + wc * 64 + 8 * fq;
        const LAS float* bp = rm + 256 + wc * 64 + 8 * fq;
        f32x4 bv[2][2];
#pragma unroll
        for (int bj = 0; bj < 2; ++bj)
#pragma unroll
            for (int n = 0; n < 2; ++n) bv[bj][n] = *(const LAS f32x4*)(bp + 32 * bj + 4 * n);
        float gv[2][4];
#pragma unroll
        for (int ai = 0; ai < 2; ++ai)
#pragma unroll
            for (int m = 0; m < 4; ++m) gv[ai][m] = rm[r0 + ai * HALF + m * 16];
        const int cst = u.pn * BM + wc * 64 + ((fq & 1) ? 32 + 8 * (fq - 1) : 8 * fq);
#pragma unroll
        for (int ai = 0; ai < 2; ++ai)
#pragma unroll
            for (int m = 0; m < 4; ++m) { const int r = r0 + ai * HALF + m * 16; const float g = gv[ai][m] * Y8_SCALE; u32x2 wv[2];
#pragma unroll
                for (int bj = 0; bj < 2; ++bj) {
                    const f32x4 y0 = (acc[ai][bj][m][0] * (1.0f / W8_SCALE) + bv[bj][0]) * g, y1 = (acc[ai][bj][m][1] * (1.0f / W8_SCALE) + bv[bj][1]) * g;
                    wv[bj].x = pk4_fp8(y0[0], y0[1], y0[2], y0[3]); wv[bj].y = pk4_fp8(y1[0], y1[1], y1[2], y1[3]); }
                const u32x4 w = pair16(wv[0], wv[1]);
                *(u32x4*)(y + (size_t)(u.pm * BM + r) * D + cst) = w; }
    }
};
struct EpiNull { static constexpr bool PERM = true, INIT = false, PRE = false; static constexpr int RM = 0, RM_SHIFT = 0;
    __device__ __forceinline__ void operator()(const f32x4 (&acc)[2][2][4][2], const Unit& u, int, int, int, int, const LAS int*, const LAS float*) const {
#pragma unroll
        for (int a = 0; a < 2; ++a)
#pragma unroll
            for (int b = 0; b < 2; ++b)
#pragma unroll
                for (int m = 0; m < 4; ++m)
#pragma unroll
                    for (int n = 0; n < 2; ++n) asm volatile("" :: "v"(acc[a][b][m][n])); } };
}

struct Frame {
    LAS unsigned char* lds;
    int tid, lane, wave, G, gw, NGW;
};

__device__ __forceinline__ float wave_sum(float v) {
#pragma unroll
    for (int o = 1; o < 64; o <<= 1) v += __shfl_xor(v, o);
    return v;
}

template <int KQ, bool F8>
__device__ __forceinline__ void p0_tile(const float* W, int ldw, int scolA, int scolB, int k0, const float* ks, float sc, void* WT, int ldk, int drow0, int lane) {
    const int nl = (lane & 15) * 4, kq = lane >> 4, kb = k0 + KQ * kq;
    const char* ub = (const char*)(W + (size_t)k0 * ldw);
    const unsigned voff = (unsigned)(KQ * kq * ldw + ((nl & 32) ? scolB : scolA) + (nl & 31)) * 4u;
    f32x4 v[KQ];
#pragma unroll
    for (int i = 0; i < KQ; ++i) v[i] = *(const f32x4*)(ub + (size_t)i * ldw * 4 + voff);
    if (ks) {
#pragma unroll
        for (int i = 0; i < KQ; i += 4) { const f32x4 kv = *(const f32x4*)(ks + kb + i);
#pragma unroll
            for (int j = 0; j < 4; ++j) v[i + j] = v[i + j] * (kv[j] * sc); }
    } else if (sc != 1.0f) {
#pragma unroll
        for (int i = 0; i < KQ; ++i) v[i] = v[i] * sc;
    }
#pragma unroll
    for (int c = 0; c < 4; ++c) {
        if (F8) { unsigned char* dst = (unsigned char*)WT + (size_t)(drow0 + nl + c) * ldk + kb;
#pragma unroll
            for (int i = 0; i < KQ; i += 16) { u32x4 o; o.x = pk4_fp8(v[i][c], v[i + 1][c], v[i + 2][c], v[i + 3][c]); o.y = pk4_fp8(v[i + 4][c], v[i + 5][c], v[i + 6][c], v[i + 7][c]);
                o.z = pk4_fp8(v[i + 8][c], v[i + 9][c], v[i + 10][c], v[i + 11][c]); o.w = pk4_fp8(v[i + 12][c], v[i + 13][c], v[i + 14][c], v[i + 15][c]); *(GAS u32x4*)(dst + i) = o; } }
        else { bf16_t* dst = (bf16_t*)WT + (size_t)(drow0 + nl + c) * ldk + kb;
#pragma unroll
            for (int i = 0; i < KQ; i += 8) { u32x4 o; o.x = pk2(v[i][c], v[i + 1][c]); o.y = pk2(v[i + 2][c], v[i + 3][c]); o.z = pk2(v[i + 4][c], v[i + 5][c]); o.w = pk2(v[i + 6][c], v[i + 7][c]); *(GAS u32x4*)(dst + i) = o; } }
    }
}
__device__ __forceinline__ int win_src(int rho0) {
    const int pn = rho0 >> 8, within = rho0 & 255, bj = within >> 7, wc = (within & 127) >> 5;
    if (pn < 2) return 64 * (4 * pn + wc) + 32 * bj;
    if (pn == 2) return 512 + 64 * wc + 32 * bj;
    return rho0;
}

struct Args { const void* in[17]; float* out; unsigned char* ws; int ph_lo, ph_hi; float invf[8]; };

__device__ __forceinline__ int crow(int r, int hi) { return (r & 3) + 8 * (r >> 2) + 4 * hi; }
typedef short v4i16_t __attribute__((ext_vector_type(4)));
__device__ __forceinline__ s16x4 vtr(const LAS unsigned char* p) { return __builtin_bit_cast(s16x4, __builtin_amdgcn_ds_read_tr16_b64_v4i16((LAS v4i16_t*)p)); }

template <int C0, int C1>
__device__ __forceinline__ void attn_tile(const LAS unsigned char* kb, const LAS unsigned char* vp, const bf16x8 (&qr)[4], int kbase, int qi, int klo, int hi, float& mrun, float& l, f32x16 (&o)[2]) {
    f32x16 p0 = {}, p1 = {};
#pragma unroll
    for (int d0 = 0; d0 < 4; ++d0) {
        if (C0 != 3) { const bf16x8 k0 = *(const LAS bf16x8*)(kb + d0 * 2048); p0 = __builtin_amdgcn_mfma_f32_32x32x16_bf16(k0, qr[d0], p0, 0, 0, 0); }
        if (C1 != 3) { const bf16x8 k1 = *(const LAS bf16x8*)(kb + d0 * 2048 + 512); p1 = __builtin_amdgcn_mfma_f32_32x32x16_bf16(k1, qr[d0], p1, 0, 0, 0); }
    }
    float mx = mrun;
#pragma unroll
    for (int r = 0; r < 16; ++r) { const int kj = kbase + crow(r, hi);
        if (C0 == 1) p0[r] = (kj > qi) ? p0[r] : -INFINITY; else if (C0 == 2) p0[r] = (kj <= qi + 128) ? p0[r] : -INFINITY; else if (C0 == 4) p0[r] = ((kj > klo) && (kj <= qi + 128)) ? p0[r] : -INFINITY;
        if (C1 == 1) p1[r] = (kj + 32 > qi) ? p1[r] : -INFINITY; else if (C1 == 2) p1[r] = (kj + 32 <= qi + 128) ? p1[r] : -INFINITY; else if (C1 == 4) p1[r] = ((kj + 32 > klo) && (kj + 32 <= qi + 128)) ? p1[r] : -INFINITY;
        if (C0 != 3 && C1 != 3) mx = fmaxf(mx, fmaxf(p0[r], p1[r])); else if (C0 != 3) mx = fmaxf(mx, p0[r]); else mx = fmaxf(mx, p1[r]); }
    mx = fmaxf(mx, __shfl_xor(mx, 32));
    const float alpha = __builtin_amdgcn_exp2f(mrun - mx); mrun = mx;
    float ls = 0.f;
#pragma unroll
    for (int r = 0; r < 16; ++r) { if (C0 != 3) p0[r] = __builtin_amdgcn_exp2f(p0[r] - mx); if (C1 != 3) p1[r] = __builtin_amdgcn_exp2f(p1[r] - mx);
        if (C0 != 3 && C1 != 3) ls += p0[r] + p1[r]; else if (C0 != 3) ls += p0[r]; else ls += p1[r]; }
    ls += __shfl_xor(ls, 32);
    l = l * alpha + ls;
#pragma unroll
    for (int d0 = 0; d0 < 2; ++d0)
#pragma unroll
        for (int r = 0; r < 16; ++r) o[d0][r] *= alpha;
#pragma unroll
    for (int ks = 0; ks < 4; ++ks) {
        if ((ks < 2 ? C0 : C1) == 3) continue;
        const f32x16& P = (ks < 2) ? p0 : p1; const int rb = (ks & 1) * 8;
        u32x4 pw; pw.x = cvt_pk_bf16(P[rb + 0], P[rb + 1]); pw.y = cvt_pk_bf16(P[rb + 2], P[rb + 3]); pw.z = cvt_pk_bf16(P[rb + 4], P[rb + 5]); pw.w = cvt_pk_bf16(P[rb + 6], P[rb + 7]);
        const bf16x8 pb = __builtin_bit_cast(bf16x8, pw);
#pragma unroll
        for (int d0 = 0; d0 < 2; ++d0) {
            const s16x4 lo = vtr(vp + d0 * 4096 + ks * 1024), hv = vtr(vp + d0 * 4096 + ks * 1024 + 512);
            const bf16x8 vf = (bf16x8){lo[0], lo[1], lo[2], lo[3], hv[0], hv[1], hv[2], hv[3]};
            o[d0] = __builtin_amdgcn_mfma_f32_32x32x16_bf16(vf, pb, o[d0], 0, 0, 0);
        }
    }
}
template <int MODE>
__device__ __forceinline__ void attn_sub(LAS unsigned char* lds, LAS bf16_t* stg, const bf16_t* Q, bf16_t* O, long rowq0, int q0, int t0, int head, float sinkl, int qblk, int vboff, int lane) {
    const int r32 = lane & 31, hi = lane >> 5;
    const bf16_t* Qw = Q + (size_t)(rowq0 + q0 + r32) * 512 + head * 64 + hi * 8;
    bf16x8 qr[4];
#pragma unroll
    for (int d0 = 0; d0 < 4; ++d0) qr[d0] = *(const bf16x8*)(Qw + d0 * 16);
    const int qi = q0 + r32; const int klo = (qblk == 0) ? (qi > 127 ? qi : 127) : qi;
    float mrun = sinkl, l = 1.0f;
    f32x16 o[2]; o[0] = f32x16{}; o[1] = f32x16{};
#define ATT_T(jt, C0, C1) attn_tile<C0, C1>(lds + (t0 + (jt)) * 8192 + hi * 1024 + r32 * 16, lds + 32768 + (t0 + (jt)) * 8192 + vboff, qr, 64 * (t0 + (jt)), qi, klo, hi, mrun, l, o)
    if (MODE == 0) {
#pragma unroll 1
        for (int jt = 0; jt < 3; ++jt) ATT_T(jt, 4, 4);
    } else if (MODE == 1) { ATT_T(0, 1, 0); ATT_T(1, 0, 0); ATT_T(2, 2, 3); }
    else { ATT_T(0, 3, 1); ATT_T(1, 0, 0); ATT_T(2, 0, 2); }
#undef ATT_T
    const float rl = 1.0f / l;
#pragma unroll
    for (int d0 = 0; d0 < 2; ++d0)
#pragma unroll
        for (int g4 = 0; g4 < 4; ++g4) { u32x2 w; w.x = cvt_pk_bf16(o[d0][4 * g4] * rl, o[d0][4 * g4 + 1] * rl); w.y = cvt_pk_bf16(o[d0][4 * g4 + 2] * rl, o[d0][4 * g4 + 3] * rl);
            *(LAS u32x2*)(stg + r32 * 64 + 32 * d0 + 8 * g4 + 4 * hi) = w; }
    LDS_WAIT();
    bf16_t* Ow = O + (size_t)(rowq0 + q0) * D + head * 64;
#pragma unroll
    for (int i = 0; i < 4; ++i) { const int row = i * 8 + (lane >> 3), ch = lane & 7; const u32x4 v = *(const LAS u32x4*)(stg + row * 64 + ch * 8); *(u32x4*)(Ow + (size_t)row * D + ch * 8) = v; }
    LDS_WAIT();
}
template <bool FAST>
__device__ __forceinline__ void attn_unit(const Frame& F, int b, int kvh, int qblk, const bf16_t* Q, const bf16_t* Kb, const bf16_t* Vb, bf16_t* O, const float* sinks) {
    const int lane = F.lane, wid = F.wave;
    LAS unsigned char* lds = F.lds;
    const int s0 = qblk * 128; const long rowq0 = (long)b * SEQ + s0;
    {
        u32x4 kv[4], vv[4];
#pragma unroll
        for (int jt = 0; jt < 4; ++jt) {
            long rt = (long)b * SEQ + s0 - 128 + 64 * jt; if (qblk == 0 && jt < 2) rt = (long)b * SEQ;
            kv[jt] = *(const u32x4*)(Kb + (rt + lane) * 128 + kvh * 64 + wid * 8);
            vv[jt] = *(const u32x4*)(Vb + (rt + 16 * (wid & 3) + (lane >> 2)) * 128 + kvh * 64 + (wid >> 2) * 32 + (lane & 3) * 8);
        }
#pragma unroll
        for (int jt = 0; jt < 4; ++jt) { *(LAS u32x4*)(lds + jt * 8192 + wid * 1024 + lane * 16) = kv[jt]; *(LAS u32x4*)(lds + 32768 + jt * 8192 + wid * 1024 + lane * 16) = vv[jt]; }
    }
    __syncthreads();
    const int g = wid >> 1, rh = wid & 1, head = kvh * 4 + g, t0 = rh;
    const float sinkl = sinks[head] * LOG2E;
    LAS bf16_t* stg = (LAS bf16_t*)(lds + 65536) + wid * 2048;
    const int vboff = ((lane >> 4) & 1) * 32 + (lane & 3) * 8 + (4 * (lane >> 5) + ((lane & 15) >> 2)) * 64;
    if (!FAST || qblk == 0) {
#pragma unroll 1
        for (int s = 0; s < 2; ++s) attn_sub<0>(lds, stg, Q, O, rowq0, 64 * rh + 32 * s, t0, head, sinkl, qblk, vboff, lane);
    } else {
        attn_sub<1>(lds, stg, Q, O, rowq0, 64 * rh, t0, head, sinkl, qblk, vboff, lane);
        attn_sub<2>(lds, stg, Q, O, rowq0, 64 * rh + 32, t0, head, sinkl, qblk, vboff, lane);
    }
    __syncthreads();
}

template <int W, int NT>
__device__ __forceinline__ void pool_item(const bf16_t* UB, bf16_t* MIXED, int tbase, int g, int lane) {
    const int c8 = g * 128 + (lane & 15) * 8, t0 = tbase + (lane >> 4) * NT, s0 = t0 & (SEQ - 1);
    u32x4 rows[W + NT - 1];
    const unsigned voff = (unsigned)(t0 * 512 + c8) * 2u;
#pragma unroll
    for (int i = 0; i < W + NT - 1; ++i) { const int dt = i - (W - 1);
        if (dt >= 0) rows[i] = *(const u32x4*)((const char*)UB + dt * 1024 + voff);
        else { const bool ok = (s0 + dt >= 0); const u32x4 r = *(const u32x4*)((const char*)UB + (ok ? dt * 1024 : 0) + voff); rows[i] = ok ? r : (u32x4){0u, 0u, 0u, 0u}; } }
    float S[8];
#pragma unroll
    for (int c = 0; c < 8; ++c) S[c] = 0.f;
#pragma unroll
    for (int i = 0; i < W - 1; ++i)
#pragma unroll
        for (int c = 0; c < 4; ++c) { S[2 * c] += __builtin_bit_cast(float, rows[i][c] << 16); S[2 * c + 1] += __builtin_bit_cast(float, rows[i][c] & 0xffff0000u); }
#pragma unroll
    for (int j = 0; j < NT; ++j) {
        const u32x4 cur = rows[j + W - 1]; float self[8];
#pragma unroll
        for (int c = 0; c < 4; ++c) { self[2 * c] = __builtin_bit_cast(float, cur[c] << 16); self[2 * c + 1] = __builtin_bit_cast(float, cur[c] & 0xffff0000u); S[2 * c] += self[2 * c]; S[2 * c + 1] += self[2 * c + 1]; }
        const int cnt = (s0 + j + 1 < W) ? s0 + j + 1 : W; const float ic = 1.0f / (float)cnt;
        u32x4 o;
#pragma unroll
        for (int c = 0; c < 4; ++c) o[c] = pk2(S[2 * c] * ic - self[2 * c], S[2 * c + 1] * ic - self[2 * c + 1]);
        *(u32x4*)(MIXED + (size_t)(t0 + j) * D + 512 + c8) = o;
        const u32x4 old = rows[j];
#pragma unroll
        for (int c = 0; c < 4; ++c) { S[2 * c] -= __builtin_bit_cast(float, old[c] << 16); S[2 * c + 1] -= __builtin_bit_cast(float, old[c] & 0xffff0000u); }
    }
}

__device__ __forceinline__ void moe_weight_items(const float* w_gu, const float* w_down, const float* norm2_w, unsigned char* WGU, unsigned char* WDN, int part, int nparts, int gw, int ngw, int lane) {
    constexpr int I_GU = 32 * 8 * 32, I_DN = 32 * 8 * 16;
#pragma unroll 1
    for (int j = gw; j * nparts + part < I_GU + I_DN; j += ngw) {
        int r = j * nparts + part;
        if (r < I_GU) { const int e = r >> 8, q = r & 255, kb = q >> 5, nb = q & 31; const int rho0 = 64 * nb, pn = rho0 >> 8, rr = rho0 & 255;
            const int sc = (rr < 128) ? 128 * pn + rr : 1024 + 128 * pn + (rr - 128);
            p0_tile<32, true>(w_gu + (size_t)e * D * 2048, 2048, sc, sc + 32, 128 * kb, norm2_w, W8_SCALE, WGU + (size_t)e * 2048 * D, D, rho0, lane); continue; } r -= I_GU;
        { const int e = r >> 7, q = r & 127, kb = q >> 4, nb = q & 15;
            const int sA = 256 * (nb >> 2) + 128 * (nb & 1) + 32 * ((nb >> 1) & 1);
            p0_tile<32, true>(w_down + (size_t)e * FF * D, D, sA, sA + 64, 128 * kb, nullptr, W8_SCALE, WDN + (size_t)e * D * FF, FF, 64 * nb, lane); }
    }
}

__global__ void __launch_bounds__(NWAVES * 64, 2) hymba_fwd(Args args) {
    extern __shared__ __attribute__((aligned(16))) unsigned char lds_raw[];
    Frame F;
    F.lds = (LAS unsigned char*)lds_raw;
    F.tid = threadIdx.x; F.lane = F.tid & 63; F.wave = __builtin_amdgcn_readfirstlane(F.tid >> 6);
    F.G = gridDim.x; F.gw = blockIdx.x * NWAVES + F.wave; F.NGW = F.G * NWAVES;
    volatile LAS unsigned* MISC = (volatile LAS unsigned*)(F.lds + L_MISC);
#define AS4 __attribute__((address_space(4)))
    const AS4 char* kbase = (const AS4 char*)__builtin_amdgcn_kernarg_segment_ptr();
#define KP_FRESH() const AS4 char* kp = kbase; asm volatile("" : "+s"(kp))
#define KIN(T, i) ((T)(*(const void* const AS4*)(kp + 8 * (i))))
#define KOUT() (*(float* const AS4*)(kp + 136))
#define KWS() (*(unsigned char* const AS4*)(kp + 144))
    gu32* ctl;
    { KP_FRESH(); ctl = (gu32*)(KWS() + WS_CTL); }
    for (int u = F.tid; u < 512 / 4; u += NWAVES * 64) ((LAS unsigned*)(F.lds + L_MISC))[u] = 0u;
    __syncthreads();
    int lmode = 0, grp = 0, Gg = F.G, cg = (int)blockIdx.x, nxcd = 8;
    unsigned lgen = 0u, lnloc = 1u; unsigned* lcnt = (unsigned*)(ctl + CW_LBAR);
    XcdBarrier bar; bar.bar = (unsigned*)(ctl + CW_BAR); bar.x = 0; bar.st = MISC + 8;
    if (N_LAUNCHES == 1) {
        const unsigned x = xb_xcc_id(); unsigned* cen = (unsigned*)(ctl + CW_CEN);
        if (F.tid == 0) {
            const unsigned r = xb_add(&cen[64 * x], 1u);
            unsigned sum, npop, mine, reg, sp = 0u;
            for (;;) {
                sum = 0u; npop = 0u; mine = 0u; reg = 1u;
#pragma unroll
                for (unsigned j = 0; j < 16; ++j) { const unsigned c_ = xb_ld(&cen[64 * j]); sum += c_; npop += (c_ > 0u) ? 1u : 0u; mine = (j == x) ? c_ : mine; reg &= (c_ == (j < 8u ? (unsigned)(F.G >> 3) : 0u)) ? 1u : 0u; }
                if (sum == (unsigned)F.G) break;
                __builtin_amdgcn_s_sleep(1);
                if (++sp > XB_SPIN_CAP) { reg = 0u; break; }
            }
            MISC[10] = r; MISC[11] = (MK_XLOCAL && reg && (F.G & 7) == 0 && ((T / 8) / 256) % (F.G >> 3) == 0) ? 1u : 0u;
            MISC[8] = mine > 0u ? mine : 1u;
            MISC[9] = npop > 0u ? npop : 1u;
        }
        __syncthreads();
        bar.x = x;
        if (__builtin_amdgcn_readfirstlane(MISC[11]) != 0u) { lmode = 1; grp = (int)x; Gg = F.G >> 3; cg = (int)__builtin_amdgcn_readfirstlane(MISC[10]); nxcd = 1; lnloc = (unsigned)Gg; lcnt += 64 * x; }
    }
    lmode = __builtin_amdgcn_readfirstlane(lmode); grp = __builtin_amdgcn_readfirstlane(grp); cg = __builtin_amdgcn_readfirstlane(cg);
    const int ngrp = lmode ? 8 : 1, Tg = T / ngrp, tokb = grp * Tg;
    const int ggw = cg * NWAVES + F.wave, GNGW = Gg * NWAVES;
    int lo, hi; { KP_FRESH(); lo = *(const int AS4*)(kp + 152); hi = *(const int AS4*)(kp + 156); }
#define IN(k) (lo <= (k) && (k) < hi)
#define SEAM(k) do { if (IN(k) && IN((k) + 1)) xcd_barrier(bar); } while (0)
#define SEAM_L(k) do { if (IN(k) && IN((k) + 1)) { if (lmode) xcc_barrier(lcnt, lnloc, lgen); else xcd_barrier(bar); } } while (0)
#ifndef DUPMASK
#define DUPMASK 0
#endif
#define REP(k) for (int rep_ = 0; rep_ < (((DUPMASK >> (k)) & 1) ? 2 : 1); ++rep_)
#ifndef TPROBE
#define TPROBE -1
#endif
    unsigned long long tp0_ = 0, tp1_ = 0;
#define PH_BEGIN(k) do { if ((k) == TPROBE) tp0_ = __builtin_amdgcn_s_memrealtime(); } while (0)
#define PH_END(k) do { if ((k) == TPROBE) tp1_ = __builtin_amdgcn_s_memrealtime(); } while (0)
#define REPSEAM(k) do { if (((DUPMASK >> (k)) & 1) && rep_ == 0) xcd_barrier(bar); } while (0)
    LAS int* idxring = (LAS int*)(F.lds + L_IDX);
    LAS int* utab = (LAS int*)(F.lds + L_UTAB);
    LAS float* rmeta = (LAS float*)(F.lds + L_RSCR);

    PH_BEGIN(0);
    if (IN(0)) REP(0) {
        KP_FRESH(); unsigned char* ws = KWS();
        const float* x = KIN(const float*, 0); const int* positions = KIN(const int*, 1); const float* norm1_w = KIN(const float*, 2); const float* w_in = KIN(const float*, 3);
        const float* pool_w = KIN(const float*, 7); const float* pool_scale = KIN(const float*, 8); const float* w_out = KIN(const float*, 9); const float* norm2_w = KIN(const float*, 10);
        const float* w_router = KIN(const float*, 11);
        bf16_t* WIN = (bf16_t*)(ws + WS_WIN + grp * WIN_GS); bf16_t* WOUT = (bf16_t*)(ws + WS_WOUT + grp * WOUT_GS); float* WR = (float*)(ws + WS_WR + grp * WR_GS); float* ROPE = (float*)(ws + WS_ROPE) + (size_t)tokb * 16;
        float* RS1 = (float*)(ws + WS_RS1) + tokb;
        bf16_t* XB = (bf16_t*)(ws + WS_XB) + (size_t)tokb * D;
        x += (size_t)tokb * D; positions += tokb;
        if (F.wave < 6) {
            const int xw = cg * 6 + F.wave, NXW = Gg * 6;
            for (int m = 2 * xw; m < Tg; m += 2 * NXW) {
                const GAS f32x4* xr = (const GAS f32x4*)(x + (size_t)m * D) + F.lane;
                f32x4 v[2][4]; float s2[2] = {0.f, 0.f};
#pragma unroll
                for (int q = 0; q < 2; ++q)
#pragma unroll
                    for (int j = 0; j < 4; ++j) v[q][j] = xr[q * (D / 4) + 64 * j];
#pragma unroll
                for (int q = 0; q < 2; ++q)
#pragma unroll
                    for (int j = 0; j < 4; ++j) s2[q] += (v[q][j].x * v[q][j].x + v[q][j].y * v[q][j].y) + (v[q][j].z * v[q][j].z + v[q][j].w * v[q][j].w);
                s2[0] = wave_sum(s2[0]); s2[1] = wave_sum(s2[1]);
                if (F.lane < 2) RS1[m + F.lane] = 1.0f / sqrtf((F.lane ? s2[1] : s2[0]) * (1.0f / D) + NORM_EPS);
#pragma unroll
                for (int q = 0; q < 2; ++q) { GAS unsigned long long* o8 = (GAS unsigned long long*)(XB + (size_t)(m + q) * D) + F.lane;
#pragma unroll
                    for (int j = 0; j < 4; ++j) o8[64 * j] = (unsigned long long)pk2(v[q][j].x, v[q][j].y) | ((unsigned long long)pk2(v[q][j].z, v[q][j].w) << 32); }
            }
        } else {
            const int sw = (grp * Gg + cg) * 2 + (F.wave - 6), NSW = F.G * 2, gt = sw * 64 + F.lane, NGT = NSW * 64;
            constexpr int I_IN = 16 * 20, I_OUT = 8 * 16, NITEMS = I_IN + I_OUT;
#pragma unroll 1
            for (int it = sw; it < NITEMS; it += NSW) {
                int r = it;
                if (r < I_IN) { const int kb = r / 20, nb = r % 20; p0_tile<16, false>(w_in, NIN, win_src(64 * nb), win_src(64 * nb + 32), 64 * kb, norm1_w, 1.0f, WIN, D, 64 * nb, F.lane); continue; } r -= I_IN;
                { const int kb = r >> 4, nb = r & 15; p0_tile<16, false>(w_out, D, 64 * nb, 64 * nb + 32, 64 * kb, nullptr, 1.0f, WOUT, D, 64 * nb, F.lane); }
            }
            for (int it = gt; it < 512 * 256; it += NGT) { const int cp = it >> 8, n4 = (it & 255) * 4, g = cp >> 7;
                const float* pw = pool_w + (size_t)cp * 128; const float* ps = pool_scale + g * 128; const float* wo = w_out + (size_t)(512 + g * 128) * D + n4;
                f32x4 a = {0.f, 0.f, 0.f, 0.f};
#pragma unroll 16
                for (int d = 0; d < 128; ++d) a += *(const f32x4*)(wo + (size_t)d * D) * (pw[d] * ps[d]);
#pragma unroll
                for (int c = 0; c < 4; ++c) WOUT[(size_t)(n4 + c) * D + 512 + cp] = (bf16_t)f2bf(a[c]); }
            for (int it = gt; it < D * NE; it += NGT) { const int k = it >> 5, e = it & 31; const float w = norm2_w[k] * w_router[it]; const unsigned hi = f2bf(w), lo = f2bf(w - __builtin_bit_cast(float, hi << 16));
                bf16_t* wp = (bf16_t*)WR + e * 2048 + (((k >> 3) ^ (e & 15)) << 3) + (k & 7); wp[0] = (bf16_t)hi; wp[1024] = (bf16_t)lo; }
            for (int it = (cg * 2 + (F.wave - 6)) * 64 + F.lane; it < Tg * 8; it += Gg * 128) { const int t = it >> 3, p = it & 7; const float ang = (float)positions[t] * (*(const float AS4*)(kp + 160 + 4 * p)); float sn, cs; sincosf(ang, &sn, &cs); ROPE[(size_t)t * 16 + p] = cs; ROPE[(size_t)t * 16 + 8 + p] = sn; }
        }
        REPSEAM(0);
    }
    SEAM(0);
    PH_END(0);

    PH_BEGIN(1);
    if (IN(1)) REP(1) {
        KP_FRESH(); unsigned char* ws = KWS(); unsigned char* ob = (unsigned char*)KOUT() + (size_t)tokb * 4096;
        pg8::TabOrder S; S.tab = utab; S.list = nullptr; S.lcap = 0; S.nU = pg8::build_units(utab, Tg / 256, NIN / 256, Gg, cg, nxcd, nullptr, nullptr);
        pg8::EpiInProj E{(bf16_t*)ob, (bf16_t*)(ob + (size_t)Tg * 1024), (bf16_t*)(ob + (size_t)Tg * 1280), (bf16_t*)(ws + WS_GRP + (size_t)grp * Tg * 3072), (const float*)(ws + WS_RS1) + tokb, (const float*)(ws + WS_ROPE) + (size_t)tokb * 16, KIN(const float*, 4), KIN(const float*, 5), (LAS float*)(F.lds + L_RSCR)};
        pg8::gemm_phase<pg8::EpiInProj, pg8::TabOrder, 0, false, 1024, false>(F.lds, idxring, (LAS float*)(F.lds + L_TINFO)  , (const bf16_t*)(ws + WS_XB) + (size_t)tokb * D, (const bf16_t*)(ws + WS_WIN + grp * WIN_GS), S, E);
        REPSEAM(1);
    }
    SEAM_L(1);
    PH_END(1);

    PH_BEGIN(2);
    if (IN(2)) REP(2) {
#pragma unroll 1
        for (int step = 0; step < 2; ++step) {
            if ((step == 0) == ((cg & 1) == 0)) {
                KP_FRESH(); unsigned char* ws = KWS();
                moe_weight_items(KIN(const float*, 13), KIN(const float*, 15), KIN(const float*, 10), ws + WS_WGU, ws + WS_WDN, 0, 1, (grp * Gg + cg) * NWAVES + F.wave, F.G * NWAVES, F.lane);
            } else {
                KP_FRESH(); unsigned char* ws = KWS(); unsigned char* ob = (unsigned char*)KOUT() + (size_t)tokb * 4096; const float* sinks = KIN(const float*, 6);
                const bf16_t* QB = (const bf16_t*)ob; const bf16_t* KB = (const bf16_t*)(ob + (size_t)Tg * 1024); const bf16_t* VB = (const bf16_t*)(ob + (size_t)Tg * 1280);
                const bf16_t* UB = (const bf16_t*)(ws + WS_GRP + (size_t)grp * Tg * 3072); bf16_t* MIXED = (bf16_t*)(ws + WS_GRP + (size_t)grp * Tg * 3072 + (size_t)Tg * 1024);
                for (int uid = cg; uid < (NB / ngrp) * 2 * 32; uid += Gg) { const int qblk = uid & 31, kvh = (uid >> 5) & 1, b = uid >> 6; attn_unit<true>(F, b, kvh, qblk, QB, KB, VB, MIXED, sinks);
#if defined(ATTN_SELFCHECK)
                    bf16_t* CHK = (bf16_t*)(ws + WS_Y);
                    attn_unit<false>(F, b, kvh, qblk, QB, KB, VB, CHK, sinks);
                    VM_WAIT(); __syncthreads();
                    { int bad = 0; const int r0_ = b * SEQ + qblk * 128;
                      for (int i = F.tid; i < 128 * 32; i += NWAVES * 64) { const int row = r0_ + (i >> 5), c8 = kvh * 256 + (i & 31) * 8;
                          const u32x4 a_ = *(const u32x4*)(MIXED + (size_t)row * D + c8), b_ = *(const u32x4*)(CHK + (size_t)row * D + c8);
                          bad |= (a_[0] != b_[0]) | (a_[1] != b_[1]) | (a_[2] != b_[2]) | (a_[3] != b_[3]); }
                      if (bad) __hip_atomic_store(ctl + CW_CHK, 1u, RLX_AGENT); }
                    __syncthreads();
#endif
                }
#pragma unroll 1
                for (int it = ggw; it < (Tg / 64) * 4; it += GNGW) { const int g = it & 3, tb = it >> 2;
                    if (g == 0) pool_item<2, 16>(UB, MIXED, 64 * tb, 0, F.lane); else if (g == 1) pool_item<4, 16>(UB, MIXED, 64 * tb, 1, F.lane); else if (g == 2) pool_item<8, 16>(UB, MIXED, 64 * tb, 2, F.lane);
                    else { pool_item<16, 8>(UB, MIXED, 64 * tb, 3, F.lane); pool_item<16, 8>(UB, MIXED, 64 * tb + 32, 3, F.lane); } }
            }
        }
        REPSEAM(2);
    }
    SEAM_L(2);
    PH_END(2);

    PH_BEGIN(3);
    if (IN(3)) REP(3) {
        KP_FRESH(); unsigned char* ws = KWS();
        pg8::TabOrder S; S.tab = utab; S.list = nullptr; S.lcap = 0;
        S.nU = lmode ? pg8::build_units<false>(utab, Tg / 256, D / 256, Gg, cg, nxcd, nullptr, nullptr) : pg8::build_units<true>(utab, Tg / 256, D / 256, Gg, cg, nxcd, nullptr, nullptr);
        pg8::EpiOutProj E{(bf16_t*)(ws + WS_HM) + (size_t)tokb * D, ws + WS_H8 + (size_t)tokb * D, (const bf16_t*)(ws + WS_XB) + (size_t)tokb * D};
        pg8::gemm_phase<pg8::EpiOutProj, pg8::TabOrder, 0, false, 1024, false>(F.lds, idxring, rmeta, (const bf16_t*)(ws + WS_GRP + (size_t)grp * Tg * 3072 + (size_t)Tg * 1024), (const bf16_t*)(ws + WS_WOUT + grp * WOUT_GS), S, E);
        REPSEAM(3);
    }
    if (IN(4)) {
        KP_FRESH(); const float* WR = (const float*)(KWS() + WS_WR + grp * WR_GS);
        __syncthreads();
        for (int i = F.tid; i < D * NE / 4; i += NWAVES * 64) ((LAS f32x4*)F.lds)[i] = ((const f32x4*)WR)[i];
    }
    if (IN(3) && IN(4)) { if (lmode) xcc_barrier(lcnt, lnloc, lgen); else { VM_WAIT(); __syncthreads(); } }
    PH_END(3);

    PH_BEGIN(4);
    if (IN(4)) {
        KP_FRESH(); unsigned char* ws = KWS(); const float* b_router = KIN(const float*, 12);
        const bf16_t* HM = (const bf16_t*)(ws + WS_HM);
        const float* WR = (const float*)(ws + WS_WR + grp * WR_GS); float* RS2 = (float*)(ws + WS_RS2); float* GATE = (float*)(ws + WS_GATE); int* LIST = (int*)(ws + WS_LIST); int* EP = (int*)(ws + WS_EP);
        LAS float* wr = (LAS float*)F.lds;
        LAS int* hist = (LAS int*)(F.lds + L_RH); LAS int* hbase = hist + 32; LAS float* bl = (LAS float*)(hist + 64);
        if (F.tid < 32) bl[F.tid] = b_router[F.tid];
        LAS float* lg = (LAS float*)(F.lds + L_RSCR + F.wave * 2112);
        const int r32 = F.lane & 31, hh = F.lane >> 5;
        for (int blk = cg; blk < Tg / 256; blk += Gg) {
            if (F.tid < 32) hist[F.tid] = 0;
            __syncthreads();
            const int tok0 = tokb + blk * 256 + F.wave * 32;
            const size_t roff = (size_t)(tok0 + r32) * D + 32 * hh;
            const bf16_t* mrow = HM + roff;
            const LAS unsigned char* wrb = (const LAS unsigned char*)wr + r32 * 4096;
            int woff[2][4];
#pragma unroll
            for (int b_ = 0; b_ < 2; ++b_)
#pragma unroll
                for (int q = 0; q < 4; ++q) woff[b_][q] = ((8 * b_ + 4 * hh + q) ^ (r32 & 15)) << 4;
            f32x16 acc = {}, acc1 = {}; float ss = 0.f, ss1 = 0.f;
            u32x4 ma[4][4];
#define RT_LOAD(B, IT) do { _Pragma("unroll") for (int q = 0; q < 4; ++q) ma[B][q] = *(const u32x4*)(mrow + 64 * (IT) + 8 * q); } while (0)
#define RT_COMP(B, IT) do { _Pragma("unroll") for (int q = 0; q < 4; ++q) { const u32x4 w_ = ma[B][q]; const bf16x8 av = __builtin_bit_cast(bf16x8, w_); \
                    const LAS unsigned char* bp = wrb + woff[(B) & 1][q] + ((IT) >> 1) * 256; \
                    const bf16x8 bh = *(const LAS bf16x8*)bp, bl = *(const LAS bf16x8*)(bp + 2048); \
                    acc = __builtin_amdgcn_mfma_f32_32x32x16_bf16(av, bh, acc, 0, 0, 0); acc1 = __builtin_amdgcn_mfma_f32_32x32x16_bf16(av, bl, acc1, 0, 0, 0); \
                    _Pragma("unroll") for (int c = 0; c < 4; ++c) { const float l_ = __builtin_bit_cast(float, w_[c] << 16), h_ = __builtin_bit_cast(float, w_[c] & 0xffff0000u); ss += l_ * l_; ss1 += h_ * h_; } } } while (0)
            RT_LOAD(0, 0); RT_LOAD(1, 1); RT_LOAD(2, 2); RT_LOAD(3, 3);
#pragma unroll 1
            for (int it = 0; it < 16; it += 4) {
                const int itn = (it + 4 < 16) ? it + 4 : it;
                RT_COMP(0, it); RT_LOAD(0, itn);
                __builtin_amdgcn_sched_barrier(0);
                RT_COMP(1, it + 1); RT_LOAD(1, itn + 1);
                __builtin_amdgcn_sched_barrier(0);
                RT_COMP(2, it + 2); RT_LOAD(2, itn + 2);
                __builtin_amdgcn_sched_barrier(0);
                RT_COMP(3, it + 3); RT_LOAD(3, itn + 3);
                __builtin_amdgcn_sched_barrier(0);
            }
#undef RT_LOAD
#undef RT_COMP
            acc = acc + acc1; ss += ss1;
            ss += __shfl_xor(ss, 32);
            const float rs = 1.0f / sqrtf(ss * (1.0f / D) + NORM_EPS);
            const int tok = tok0 + r32;
            if (hh == 0) RS2[tok] = rs;
            int sel[4]; float gv[4]; int lpos[4];
#pragma unroll
            for (int pass = 0; pass < 2; ++pass) {
#pragma unroll
                for (int r = 0; r < 8; ++r) { const int rr = 8 * pass + r; const int i = crow(rr, hh) - 16 * pass; lg[i * 33 + r32] = acc[rr]; }
                LDS_WAIT(); asm volatile("" ::: "memory");
                if ((r32 >> 4) == pass && hh == 0) {
                    const int i = r32 & 15; float v[32];
#pragma unroll
                    for (int e = 0; e < 32; ++e) v[e] = lg[i * 33 + e] * rs + bl[e];
                    unsigned taken = 0u;
#pragma unroll
                    for (int k = 0; k < 4; ++k) { float best = -INFINITY; int bi = 0;
#pragma unroll
                        for (int e = 0; e < 32; ++e) { const bool ok = !((taken >> e) & 1u) && v[e] > best; best = ok ? v[e] : best; bi = ok ? e : bi; }
                        taken |= 1u << bi; sel[k] = bi; gv[k] = best; }
                    const float e1 = __expf(gv[1] - gv[0]), e2 = __expf(gv[2] - gv[0]), e3 = __expf(gv[3] - gv[0]); const float inv = 1.0f / (1.0f + e1 + e2 + e3);
                    gv[0] = inv; gv[1] = e1 * inv; gv[2] = e2 * inv; gv[3] = e3 * inv;
#pragma unroll
                    for (int k = 0; k < 4; ++k) lpos[k] = __hip_atomic_fetch_add(&hist[sel[k]], 1, __ATOMIC_RELAXED, __HIP_MEMORY_SCOPE_WORKGROUP);
                }
                LDS_WAIT(); asm volatile("" ::: "memory");
            }
            __syncthreads();
            if (F.tid < 32) hbase[F.tid] = (int)__hip_atomic_fetch_add((unsigned*)(ctl + CW_CNT + F.tid), (unsigned)hist[F.tid], RLX_AGENT);
            __syncthreads();
            if (hh == 0) {
#pragma unroll
                for (int k = 0; k < 4; ++k) { const int aid = tok * 4 + k, pos = hbase[sel[k]] + lpos[k]; GATE[aid] = gv[k]; EP[aid] = sel[k] | (pos << 5); LIST[(size_t)sel[k] * T + pos] = aid; }
            }
            __syncthreads();
        }
    }
    SEAM(4);
    PH_END(4);

    {
        LAS int* cntl = (LAS int*)(F.lds + L_CNT); LAS int* tinfo = (LAS int*)(F.lds + L_TINFO); LAS int* pref = (LAS int*)(F.lds + L_PREF);
        const int grp = 0, Gg = F.G, cg = (int)blockIdx.x, nxcd = 8, Tg = T, tokb = 0;
        int nMt = 0;
        if (IN(5) || IN(6)) {
            __syncthreads();
            if (F.tid < 32) cntl[F.tid] = (int)__hip_atomic_load((unsigned*)(ctl + CW_CNT + grp * 32 + F.tid), RLX_AGENT);
            __syncthreads();
            if (F.tid == 0) { int a = 0; for (int e = 0; e < 32; ++e) { pref[e] = a; a += (cntl[e] + 255) >> 8; } pref[32] = a; }
            __syncthreads();
            nMt = pref[32];
            for (int e = 0; e < 32; ++e) { const int p0 = pref[e], n = pref[e + 1] - p0; for (int j = F.tid; j < n; j += NWAVES * 64) tinfo[p0 + j] = e | (j << 8); }
            __syncthreads();
        }
        PH_BEGIN(5);
        if (IN(5)) REP(5) {
            KP_FRESH(); unsigned char* ws = KWS();
            pg8::TabOrder S; S.tab = utab; S.list = (const int*)(ws + WS_LIST) + (size_t)grp * NE * Tg; S.lcap = Tg; S.nU = pg8::build_units(utab, nMt, 8, Gg, cg, nxcd, tinfo, cntl, 4);
            pg8::EpiGU E{ws + WS_GRP + grp * GRP_GS, (const float*)(ws + WS_RS2) + tokb, KIN(const float*, 14)};
#if defined(NULLDUP)
            if (rep_ == 1) { pg8::EpiNull EN; pg8::gemm_phase<pg8::EpiNull, pg8::TabOrder, 1, true, 512, true>(F.lds, idxring, rmeta, ws + WS_H8 + (size_t)tokb * D, ws + WS_WGU, S, EN); } else
#endif
            pg8::gemm_phase<pg8::EpiGU, pg8::TabOrder, 1, true, 512, true>(F.lds, idxring, rmeta, ws + WS_H8 + (size_t)tokb * D, ws + WS_WGU, S, E);
            REPSEAM(5);
        }
        SEAM(5);
        PH_END(5);
        PH_BEGIN(6);
        if (IN(6)) REP(6) {
            KP_FRESH(); unsigned char* ws = KWS();
            pg8::TabOrder S; S.tab = utab; S.list = (const int*)(ws + WS_LIST) + (size_t)grp * NE * Tg; S.lcap = Tg; S.nU = pg8::build_units(utab, nMt, 4, Gg, cg, nxcd, tinfo, cntl);
            pg8::EpiDown E{ws + WS_Y + grp * GRP_GS, (const float*)(ws + WS_GATE) + (size_t)tokb * 4, KIN(const float*, 16)};
            pg8::gemm_phase<pg8::EpiDown, pg8::TabOrder, 0, true, 512, true>(F.lds, idxring, rmeta, ws + WS_GRP + grp * GRP_GS, ws + WS_WDN, S, E);
            REPSEAM(6);
        }
        SEAM(6);
        PH_END(6);
        PH_BEGIN(7);
        if (IN(7)) {
            KP_FRESH(); float* out = KOUT() + (size_t)tokb * D; unsigned char* ws = KWS(); const unsigned char* Y8 = ws + WS_Y + grp * GRP_GS; const bf16_t* HM = (const bf16_t*)(ws + WS_HM) + (size_t)tokb * D;
            const int gt = cg * (NWAVES * 64) + F.tid, NGT = Gg * NWAVES * 64; const int* EP = (const int*)(ws + WS_EP) + (size_t)tokb * 4;
            if (!(IN(5) || IN(6))) {
                __syncthreads();
                if (F.tid < 32) cntl[F.tid] = (int)__hip_atomic_load((unsigned*)(ctl + CW_CNT + grp * 32 + F.tid), RLX_AGENT);
                __syncthreads();
                if (F.tid == 0) { int a = 0; for (int e = 0; e < 32; ++e) { pref[e] = a; a += (cntl[e] + 255) >> 8; } pref[32] = a; }
                __syncthreads();
            }
            for (int it = gt; it < Tg * 64; it += NGT) { const int tl = it >> 6, c16 = (it & 63) * 16; const size_t o = (size_t)tl * D + c16;
                const u32x4 epv = *(const u32x4*)(EP + tl * 4);
                const u32x4 hma = *(const u32x4*)(HM + o), hmb = *(const u32x4*)(HM + o + 8);
                u32x4 yv[4];
#pragma unroll
                for (int k = 0; k < 4; ++k) { const int slot = pref[epv[k] & 31] * 256 + (int)(epv[k] >> 5); yv[k] = *(const u32x4*)(Y8 + (size_t)slot * D + c16); }
                f32x4 hq[4], sq[4];
#pragma unroll
                for (int j = 0; j < 2; ++j) { const unsigned w0 = j ? hma[2] : hma[0], w1 = j ? hma[3] : hma[1], w2 = j ? hmb[2] : hmb[0], w3 = j ? hmb[3] : hmb[1];
                    hq[j][0] = __builtin_bit_cast(float, w0 << 16); hq[j][1] = __builtin_bit_cast(float, w0 & 0xffff0000u); hq[j][2] = __builtin_bit_cast(float, w1 << 16); hq[j][3] = __builtin_bit_cast(float, w1 & 0xffff0000u);
                    hq[2 + j][0] = __builtin_bit_cast(float, w2 << 16); hq[2 + j][1] = __builtin_bit_cast(float, w2 & 0xffff0000u); hq[2 + j][2] = __builtin_bit_cast(float, w3 << 16); hq[2 + j][3] = __builtin_bit_cast(float, w3 & 0xffff0000u); }
#pragma unroll
                for (int q = 0; q < 4; ++q) sq[q] = (f32x4){0.f, 0.f, 0.f, 0.f};
#pragma unroll
                for (int k = 0; k < 4; ++k)
#pragma unroll
                    for (int q = 0; q < 4; ++q) { const f32x2 a = __builtin_amdgcn_cvt_pk_f32_fp8((int)yv[k][q], false), b = __builtin_amdgcn_cvt_pk_f32_fp8((int)yv[k][q], true);
                        sq[q][0] += a[0]; sq[q][1] += a[1]; sq[q][2] += b[0]; sq[q][3] += b[1]; }
#if defined(ATTN_SELFCHECK)
                if (__hip_atomic_load(ctl + CW_CHK, RLX_AGENT) != 0u) {
#pragma unroll
                    for (int q = 0; q < 4; ++q) hq[q] = hq[q] * 3.0f; }
#endif
#pragma unroll
                for (int q = 0; q < 4; ++q) *(f32x4*)(out + o + 4 * q) = hq[q] + sq[q] * (1.0f / Y8_SCALE); }
        }
    }
    PH_END(7);
    if (TPROBE >= 0 && blockIdx.x == 0 && F.tid == 0) { const unsigned long long te = __builtin_amdgcn_s_memrealtime(); while (__builtin_amdgcn_s_memrealtime() - te < tp1_ - tp0_) __builtin_amdgcn_s_sleep(8); }
#undef IN
#undef SEAM
}

extern "C" void kernel_launch(void* const* d_in, const int* in_sizes, int n_in, void* d_out, int out_size, void* d_ws, size_t ws_size, hipStream_t stream) {
    static int grid = 0;
    if (grid == 0) {
        if (n_in != 17 || out_size != T * D || ws_size < WS_END) { fprintf(stderr, "kernel_launch: unexpected shapes (n_in %d out %d ws %zu)\n", n_in, out_size, ws_size); grid = -1; return; }
        int dev = 0, cus = 0, per_cu = 0;
        if (hipGetDevice(&dev) != hipSuccess || hipDeviceGetAttribute(&cus, hipDeviceAttributeMultiprocessorCount, dev) != hipSuccess) { grid = -1; return; }
        if (hipFuncSetAttribute((const void*)hymba_fwd, hipFuncAttributeMaxDynamicSharedMemorySize, LDS_BYTES) != hipSuccess) { fprintf(stderr, "kernel_launch: hipFuncSetAttribute failed\n"); grid = -1; return; }
        if (hipOccupancyMaxActiveBlocksPerMultiprocessor(&per_cu, (const void*)hymba_fwd, NWAVES * 64, LDS_BYTES) != hipSuccess || per_cu < 1) { fprintf(stderr, "kernel_launch: occupancy query says %d\n", per_cu); }
        (void)hipGetLastError();
        grid = cus;
    }
    if (grid < 0) return;
    (void)hipMemsetAsync((char*)d_ws + WS_CTL, 0, CTL_ZERO_BYTES, stream);
    Args a{};
    for (int i = 0; i < 17; ++i) a.in[i] = d_in[i];
    a.out = (float*)d_out; a.ws = (unsigned char*)d_ws;
    for (int p = 0; p < 8; ++p) a.invf[p] = (float)pow(500000.0, -(double)p / 8.0);
    if (N_LAUNCHES == 1) { a.ph_lo = 0; a.ph_hi = NPH; hipLaunchKernelGGL(hymba_fwd, dim3(grid), dim3(NWAVES * 64), LDS_BYTES, stream, a); }
    else for (int li = 0; li < NPH; ++li) { a.ph_lo = li; a.ph_hi = li + 1; hipLaunchKernelGGL(hymba_fwd, dim3(grid), dim3(NWAVES * 64), LDS_BYTES, stream, a); }
}
```

```cpp
#include <hip/hip_runtime.h>
#include <cstdio>
#include <cstdint>
#include <cmath>

#ifndef MK_XLOCAL
#define MK_XLOCAL 1
#endif
#ifndef MK_N_LAUNCHES
#define MK_N_LAUNCHES 1
#endif

#define LAS __attribute__((address_space(3)))
#define GAS __attribute__((address_space(1)))
typedef unsigned short bf16_t;
typedef short bf16x8 __attribute__((ext_vector_type(8)));
typedef __bf16 bf16x2_t __attribute__((ext_vector_type(2)));
typedef short s16x4 __attribute__((ext_vector_type(4)));
typedef float f32x4 __attribute__((ext_vector_type(4)));
typedef float f32x2 __attribute__((ext_vector_type(2)));
typedef float f32x16 __attribute__((ext_vector_type(16)));
typedef unsigned u32x4 __attribute__((ext_vector_type(4)));
typedef unsigned u32x2 __attribute__((ext_vector_type(2)));
typedef GAS unsigned gu32;
typedef int v4i32 __attribute__((ext_vector_type(4)));
typedef int v8i32 __attribute__((ext_vector_type(8)));

constexpr int NB = 16, SEQ = 4096, T = NB * SEQ, D = 1024, NIN = 1280, NE = 32, FF = 1024;
constexpr float NORM_EPS = 1e-5f, QK_EPS = 1e-6f;
constexpr float LOG2E = 1.4426950408889634f;
constexpr float C2 = 0.125f * LOG2E;
constexpr int NWAVES = 8;
constexpr int NPH = 8;
constexpr int N_LAUNCHES = MK_N_LAUNCHES;
constexpr float W8_SCALE = 64.0f;
constexpr int SCALE_ONE = 0x7F7F7F7F, SCALE_W = 0x79797979;
constexpr float Y8_SCALE = 16.0f;

constexpr size_t MiB = 1u << 20;
constexpr size_t WS_CTL = 0, CTL_ZERO_BYTES = 32 * 1024;
constexpr size_t WS_WIN = 1 * MiB, WIN_GS = 0;
constexpr size_t WS_WOUT = 25 * MiB, WOUT_GS = 0;
constexpr size_t WS_WR = 41 * MiB, WR_GS = 0;
constexpr size_t WS_ROPE = 45 * MiB;
constexpr size_t WS_RS1 = 49 * MiB;
constexpr size_t WS_RS2 = 49 * MiB + 512 * 1024;
constexpr size_t WS_GATE = 50 * MiB;
constexpr size_t WS_LIST = 51 * MiB;
constexpr size_t WS_WGU = 59 * MiB;
constexpr size_t WS_WDN = 123 * MiB;
constexpr size_t WS_H8 = 155 * MiB;
constexpr size_t WS_GRP = 219 * MiB;
constexpr size_t WS_Y = 483 * MiB;
constexpr size_t WS_HM = 747 * MiB;
constexpr size_t WS_EP = 875 * MiB;
constexpr size_t WS_XB = 876 * MiB;
constexpr size_t WS_END = 1004 * MiB;
constexpr size_t GRP_GS = 0;
static_assert((size_t)(T * 4 + NE * 256) * 1024 <= 264 * MiB, "act / y regions");
constexpr int CW_CNT = 64;
constexpr int CW_LBAR = 2048;
constexpr int CW_CEN = 1024;
constexpr int CW_CHK = 200;
constexpr int CW_BAR = 4096;

constexpr int RING_BYTES = 131072;
constexpr int L_MISC = RING_BYTES;
constexpr int L_CNT = RING_BYTES + 512;
constexpr int L_PREF = RING_BYTES + 640;
constexpr int L_IDX = RING_BYTES + 1024;
constexpr int L_TINFO = RING_BYTES + 4096;
constexpr int L_RSCR = RING_BYTES + 8704;
constexpr int L_RH = RING_BYTES + 25600;
constexpr int L_UTAB = RING_BYTES + 26624;
constexpr int LDS_BYTES = RING_BYTES + 27648;

#define RLX_AGENT __ATOMIC_RELAXED, __HIP_MEMORY_SCOPE_AGENT
#define LDS_WAIT() asm volatile("s_waitcnt lgkmcnt(0)" ::: "memory")
#define VM_WAIT() asm volatile("s_waitcnt vmcnt(0)" ::: "memory")

__device__ __forceinline__ unsigned f2bf(float f) { unsigned u = __builtin_bit_cast(unsigned, f); return (u + 0x7fffu + ((u >> 16) & 1u)) >> 16; }
__device__ __forceinline__ unsigned pk2(float lo, float hi) { return f2bf(lo) | (f2bf(hi) << 16); }
__device__ __forceinline__ unsigned cvt_pk_bf16(float lo, float hi) { unsigned r; asm volatile("v_cvt_pk_bf16_f32 %0, %1, %2" : "=v"(r) : "v"(lo), "v"(hi)); return r; }
__device__ __forceinline__ unsigned pk4_fp8(float a, float b, float c, float d) { unsigned w = 0; w = __builtin_amdgcn_cvt_pk_fp8_f32(a, b, w, false); w = __builtin_amdgcn_cvt_pk_fp8_f32(c, d, w, true); return w; }
__device__ __forceinline__ float bf2f(unsigned short b) { return __builtin_bit_cast(float, (unsigned)b << 16); }

#define XB_TMO      128
#define XB_XCNT(j)  (256  + 64 * (j))
#define XB_XSUB(j)  (1280 + 64 * (j))
#define XB_XGEN(j)  (2304 + 64 * (j))
#define XB_TOP      3328
#define XB_TOPGEN   3392
#define XCD_BAR_WORDS 3456
#define XB_SPIN_CAP (1u << 23)
__device__ __forceinline__ unsigned xb_ld(unsigned* p)              { return __hip_atomic_load(p, __ATOMIC_RELAXED, __HIP_MEMORY_SCOPE_AGENT); }
__device__ __forceinline__ unsigned xb_add(unsigned* p, unsigned v) { return __hip_atomic_fetch_add(p, v, __ATOMIC_RELAXED, __HIP_MEMORY_SCOPE_AGENT); }
__device__ __forceinline__ unsigned xb_xcc_id() { return (unsigned)__builtin_amdgcn_s_getreg((3 << 11) | 20) & 0xFu; }
#define XB_SPIN(cond, bar) do { unsigned _sp = 0; while (cond) { __builtin_amdgcn_s_sleep(1); \
    if ((++_sp & 255u) == 0u) { if (xb_ld(&(bar)[XB_TMO])) break; if (_sp > XB_SPIN_CAP) { atomicAdd(&(bar)[XB_TMO], 1u); break; } } } } while (0)
struct XcdBarrier { unsigned* bar; unsigned x; volatile LAS unsigned* st; };
__device__ __forceinline__ XcdBarrier xcd_barrier_post(unsigned* bar, volatile LAS unsigned* st) {
    XcdBarrier b; b.bar = bar; b.x = xb_xcc_id(); b.st = st;
    if (threadIdx.x == 0) (void)xb_add(&bar[XB_XCNT(b.x)], 1u);
    return b;
}
__device__ __forceinline__ void xcd_barrier_complete(unsigned* bar, unsigned x, unsigned& nloc, unsigned& nx) {
    const unsigned G = gridDim.x * gridDim.y * gridDim.z;
    unsigned sum, cnt, mine, sp = 0u;
    for (;;) {
        sum = 0u; cnt = 0u; mine = 0u;
#pragma unroll
        for (unsigned j = 0; j < 16; ++j) { const unsigned c = xb_ld(&bar[XB_XCNT(j)]); sum += c; cnt += (c > 0u) ? 1u : 0u; mine = (j == x) ? c : mine; }
        if (sum == G) break;
        __builtin_amdgcn_s_sleep(1);
        if ((++sp & 255u) == 0u) { if (xb_ld(&bar[XB_TMO])) break; if (sp > XB_SPIN_CAP) { atomicAdd(&bar[XB_TMO], 1u); break; } }
    }
    nloc = mine > 0u ? mine : 1u; nx = cnt > 0u ? cnt : 1u;
}
__device__ __forceinline__ void xcd_barrier(const XcdBarrier& b) {
    asm volatile("s_waitcnt vmcnt(0)" ::: "memory");
    __syncthreads();
    if (threadIdx.x == 0) {
        unsigned* bar = b.bar;
        __builtin_amdgcn_s_waitcnt(0);
        unsigned nloc = b.st[0], nx = b.st[1];
        if (nloc == 0u) { xcd_barrier_complete(bar, b.x, nloc, nx); b.st[0] = nloc; b.st[1] = nx; }
        const unsigned old = xb_add(&bar[XB_XSUB(b.x)], 1u);
        const unsigned gen = old / nloc;
        if (old + 1u == (gen + 1u) * nloc) {
            __builtin_amdgcn_fence(__ATOMIC_RELEASE, "agent");
            asm volatile("s_waitcnt vmcnt(0)" ::: "memory");
            const unsigned og = xb_add(&bar[XB_TOP], 1u);
            const unsigned tg = og / nx;
            if (og + 1u == (tg + 1u) * nx) xb_add(&bar[XB_TOPGEN], 1u);
            else XB_SPIN(xb_ld(&bar[XB_TOPGEN]) == tg, bar);
            __builtin_amdgcn_fence(__ATOMIC_ACQUIRE, "agent");
            xb_add(&bar[XB_XGEN(b.x)], 1u);
            asm volatile("s_waitcnt vmcnt(0)" ::: "memory");
        } else {
            XB_SPIN(xb_ld(&bar[XB_XGEN(b.x)]) == gen, bar);
            __builtin_amdgcn_fence(__ATOMIC_ACQUIRE, "agent");
            asm volatile("s_waitcnt vmcnt(0)" ::: "memory");
        }
    }
    __syncthreads();
}

__device__ __forceinline__ void xcc_barrier(unsigned* cnt, unsigned nloc, unsigned& gen) {
    asm volatile("s_waitcnt vmcnt(0)" ::: "memory");
    __syncthreads();
    ++gen;
    if (threadIdx.x == 0) {
        __builtin_amdgcn_s_waitcnt(0);
        (void)xb_add(cnt, 1u);
        unsigned sp = 0u; while (xb_ld(cnt) < gen * nloc) { __builtin_amdgcn_s_sleep(1); if (++sp > XB_SPIN_CAP) break; }
        __builtin_amdgcn_fence(__ATOMIC_ACQUIRE, "agent");
        asm volatile("s_waitcnt vmcnt(0)" ::: "memory");
    }
    __syncthreads();
}

namespace pg8 {
constexpr int BM = 256, BK = 64, HALF = 128, HTB = HALF * BK * 2;
__host__ __device__ __forceinline__ int lds_byte(int r, int c) { const int st = (r >> 4) * 2 + (c >> 5), rr = r & 15, cc = c & 31, ob = rr * 64 + cc * 2; return st * 1024 + (ob ^ (((ob >> 9) & 1) << 5)); }
__host__ __device__ __forceinline__ void stage_rc(int b, int& R, int& C) { const int st = b / 1024, sb = b % 1024, swz = sb ^ (((sb >> 9) & 1) << 5); R = (st >> 1) * 16 + swz / 64; C = (st & 1) * 32 + (swz % 64) / 2; }
__host__ __device__ __forceinline__ int perm32(int rho) { const int n = rho >> 4, i = rho & 15; return 8 * (i >> 2) + 4 * n + (i & 3); }

union Frag { v8i32 v; bf16x8 pc[2]; };
struct Unit { int pm, pn, bt, e, j, nvalid; };

__device__ __forceinline__ bool order_tile(int i, int nM, int nN, int G, int c, int& pm, int& pn, const int WGM, const int NXCD) {
    const int nwg = nM * nN; const long L = (long)i * G + c; if (L >= nwg) return false;
    int wgid = (int)L; { const int q = nwg / NXCD, r = nwg % NXCD, xcd = wgid % NXCD, off = wgid / NXCD; wgid = (xcd < r ? xcd * (q + 1) : r * (q + 1) + (xcd - r) * q) + off; }
    const int nig = WGM * nN, gid = wgid / nig, fm = gid * WGM, gsz = (nM - fm) < WGM ? (nM - fm) : WGM;
    pm = fm + ((wgid % nig) % gsz); pn = (wgid % nig) / gsz; return true;
}
constexpr int MAX_UNITS = 64;
template <bool OWNROWS = false>
__device__ __forceinline__ int build_units(LAS int* tab, int nM, int nN, int G, int c, int nxcd, const LAS int* tinfo, const LAS int* cnt, const int wgm = 8) {
    const int nwg = nM * nN; int nU = (nwg > c) ? (nwg - c + G - 1) / G : 0;
    if (OWNROWS) nU = (nM > c) ? ((nM - c + G - 1) / G) * nN : 0;
    __syncthreads();
    const int i = threadIdx.x;
    if (i < nU && i < MAX_UNITS) { int pm = 0, pn = 0; if (OWNROWS) { pm = c + G * (i / nN); pn = i % nN; } else order_tile(i, nM, nN, G, c, pm, pn, wgm, nxcd);
        int e = 0, j = 0, nv = 256;
        if (tinfo) { const int ti = tinfo[pm]; e = ti & 255; j = ti >> 8; const int c_ = cnt[e] - 256 * j; nv = c_ < 256 ? c_ : 256; }
        tab[4 * i] = pm; tab[4 * i + 1] = pn; tab[4 * i + 2] = e * nN + pn; tab[4 * i + 3] = e | (j << 8) | (nv << 20); }
    __syncthreads();
    return nU < MAX_UNITS ? nU : MAX_UNITS;
}
struct TabOrder {
    const LAS int* tab; int nU; const int* list; int lcap;
    __device__ __forceinline__ bool next(int i, Unit& u) const {
        if (i >= nU) return false;
        const int w3 = __builtin_amdgcn_readfirstlane(tab[4 * i + 3]);
        u.pm = __builtin_amdgcn_readfirstlane(tab[4 * i]); u.pn = __builtin_amdgcn_readfirstlane(tab[4 * i + 1]); u.bt = __builtin_amdgcn_readfirstlane(tab[4 * i + 2]);
        u.e = w3 & 255; u.j = (w3 >> 8) & 4095; u.nvalid = w3 >> 20; return true;
    }
    __device__ __forceinline__ const int* idx_src(const Unit& u) const { return list + (size_t)u.e * lcap + 256 * u.j; }
};

template <class Epi, class Sched, int AMODE, bool HAS_IDX, int K, bool F8, bool ALIGN_EPI = true>
__device__ __forceinline__ void gemm_phase(LAS unsigned char* lds, LAS int* idxring, LAS float* rmeta, const void* Ag, const void* Btg, const Sched& S, const Epi& E) {
    const int tid = threadIdx.x, wid = __builtin_amdgcn_readfirstlane(tid >> 6), lane = tid & 63, wr = wid >> 2, wc = wid & 3, fr = lane & 15, fq = lane >> 4;
    const int nt = K / BK;
    unsigned voffB[2];
#pragma unroll
    for (int i = 0; i < 2; ++i) { int R, C; stage_rc(tid * 16 + i * 8192, R, C); const int Rb = Epi::PERM ? ((R & ~31) + perm32(R & 31)) : R; voffB[i] = (unsigned)(Rb * K + C) * 2u; }
    const size_t kstep = (size_t)(BK * 2);
    const size_t hstep = (size_t)HALF * K * 2;
    const size_t tstep = 2 * hstep;
    const unsigned ldsw = (unsigned)wid * 1024u;
    const int aoff = lds_byte(wr * 64 + fr, fq * 8), boff = lds_byte(wc * 32 + fr, fq * 8);
#define PG8_SA(b, h) (((b) * 2 + (h)) * HTB)
#define PG8_SB(b, h) ((4 + (b) * 2 + (h)) * HTB)
#define PG8_STAGE_B(bufoff, gbase) do { _Pragma("unroll") for (int _i = 0; _i < 2; ++_i) \
        __builtin_amdgcn_global_load_lds((const unsigned*)((const char*)(gbase) + voffB[_i]), (LAS unsigned*)(lds + (bufoff) + ldsw + _i * 8192), 16, 0, 0); } while (0)
#define PG8_STAGE_A(bufoff, kb, AO, h) do { _Pragma("unroll") for (int _i = 0; _i < 2; ++_i) \
        __builtin_amdgcn_global_load_lds((const unsigned*)((const char*)Ag + (kb) + (AO)[h][_i]), (LAS unsigned*)(lds + (bufoff) + ldsw + _i * 8192), 16, 0, 0); } while (0)
#define PG8_LDA(dst, b, h) do { _Pragma("unroll") for (int m = 0; m < 4; ++m) _Pragma("unroll") for (int k = 0; k < 2; ++k) dst[m][k] = *(const LAS bf16x8*)(lds + PG8_SA(b, h) + aoff + m * 2048 + k * 1024); } while (0)
#define PG8_LDB(dst, b, h) do { _Pragma("unroll") for (int n = 0; n < 2; ++n) _Pragma("unroll") for (int k = 0; k < 2; ++k) dst[n][k] = *(const LAS bf16x8*)(lds + PG8_SB(b, h) + boff + n * 2048 + k * 1024); } while (0)
#define PG8_MMA_G(ai, bj, At, Bt, ZERO) do { __builtin_amdgcn_s_setprio(1); _Pragma("unroll") for (int m = 0; m < 4; ++m) _Pragma("unroll") for (int n = 0; n < 2; ++n) { \
        if constexpr (F8) { \
            const v8i32 bv_ = __builtin_shufflevector(__builtin_bit_cast(v4i32, Bt[n][0]), __builtin_bit_cast(v4i32, Bt[n][1]), 0, 1, 2, 3, 4, 5, 6, 7); \
            const v8i32 av_ = __builtin_shufflevector(__builtin_bit_cast(v4i32, At[m][0]), __builtin_bit_cast(v4i32, At[m][1]), 0, 1, 2, 3, 4, 5, 6, 7); \
            acc[ai][bj][m][n] = __builtin_amdgcn_mfma_scale_f32_16x16x128_f8f6f4(bv_, av_, (ZERO) ? (f32x4){0.f, 0.f, 0.f, 0.f} : acc[ai][bj][m][n], 0, 0, 0, 0, 0, 0);   } \
        else { acc[ai][bj][m][n] = __builtin_amdgcn_mfma_f32_16x16x32_bf16(Bt[n][0], At[m][0], (ZERO) ? (f32x4){0.f, 0.f, 0.f, 0.f} : acc[ai][bj][m][n], 0, 0, 0); \
               acc[ai][bj][m][n] = __builtin_amdgcn_mfma_f32_16x16x32_bf16(Bt[n][1], At[m][1], acc[ai][bj][m][n], 0, 0, 0); } } \
        __builtin_amdgcn_s_setprio(0); } while (0)
#define PG8_MMA(ai, bj, At, Bt) PG8_MMA_G(ai, bj, At, Bt, 0)
#define PG8_MMA2(ai, At) do { if (!Epi::INIT && t == 0) { PG8_MMA_G(ai, 0, At, B0, 1); PG8_MMA_G(ai, 1, At, B1, 1); } else { PG8_MMA_G(ai, 0, At, B0, 0); PG8_MMA_G(ai, 1, At, B1, 0); } } while (0)
#define PG8_WAIT_V(n) asm volatile("s_waitcnt vmcnt(" #n ")" ::: "memory")
#define PG8_WAIT_L(n) asm volatile("s_waitcnt lgkmcnt(" #n ")" ::: "memory")
#define PG8_BAR __builtin_amdgcn_s_barrier()
#define PG8_SCHED __builtin_amdgcn_sched_barrier(0)
#define PG8_AOFF(dst, U, islot) do { int _t = tid; asm volatile("" : "+v"(_t)); _Pragma("unroll") for (int _i = 0; _i < 2; ++_i) { int _R, _C; stage_rc(_t * 16 + _i * 8192, _R, _C); \
        _Pragma("unroll") for (int _h = 0; _h < 2; ++_h) { \
        int _row; if (AMODE == 0) _row = (U).pm * BM + _h * HALF + _R; else _row = (idxring[(islot) * 256 + _h * HALF + _R] >> 2) & (T - 1);   \
        dst[_h][_i] = ((unsigned)_row * (unsigned)K + (unsigned)_C) * 2u; } } } while (0)
    Unit cur, nxt; int ui = 0, islot = 0;
    if (!S.next(0, cur)) return;
    if (HAS_IDX) {
        if (wid == 0) { __builtin_amdgcn_global_load_lds((const unsigned*)(S.idx_src(cur) + lane * 4), (LAS unsigned*)(idxring), 16, 0, 0); PG8_WAIT_V(0); }
        __syncthreads();
    }
    f32x4 acc[2][2][4][2];
#define PG8_ACC_INIT(U) do { if constexpr (Epi::INIT) E.init(acc, U, wr, wc, fr, fq); } while (0)
    PG8_ACC_INIT(cur);
    bf16x8 At[4][2], B0[2][2], B1[2][2];
    unsigned ao[2][2];
    PG8_AOFF(ao, cur, 0);
    const char* cB = (const char*)Btg + (size_t)cur.bt * tstep;
    PG8_STAGE_B(PG8_SB(0, 0), cB); PG8_STAGE_B(PG8_SB(0, 1), cB + hstep); PG8_STAGE_A(PG8_SA(0, 0), 0, ao, 0); PG8_STAGE_A(PG8_SA(0, 1), 0, ao, 1);
    if (wr == 1) PG8_BAR;
    PG8_WAIT_V(2); PG8_BAR;
    PG8_STAGE_B(PG8_SB(1, 0), cB + kstep); PG8_STAGE_A(PG8_SA(1, 0), kstep, ao, 0); PG8_STAGE_B(PG8_SB(1, 1), cB + hstep + kstep);
    PG8_WAIT_V(6); PG8_BAR;
    for (;;) {
        const bool has_next = S.next(ui + 1, nxt);
        const int nslot = (islot == 2) ? 0 : islot + 1;
        if (HAS_IDX && has_next && wid == 0)
            __builtin_amdgcn_global_load_lds((const unsigned*)(S.idx_src(nxt) + lane * 4), (LAS unsigned*)(idxring + nslot * 256), 16, 0, 0);
        const char* nB = has_next ? (const char*)Btg + (size_t)nxt.bt * tstep : cB;
#pragma unroll 1
        for (int t = 0; t < nt; t += 2) {
            const bool last = (t == nt - 2);
            if (last) {
                if constexpr (Epi::RM == 1) { if (wid == 0) __builtin_amdgcn_global_load_lds((const unsigned*)(E.rm_base + (size_t)cur.pm * BM + lane * 4), (LAS unsigned*)rmeta, 16, 0, 0);
                }
                if constexpr (Epi::PRE) E.pre(cur, wid, lane, rmeta);
                if constexpr (Epi::RM == 2) { if (wid < 4) { const int id_ = idxring[islot * 256 + 64 * wid + lane];
                    __builtin_amdgcn_global_load_lds((const unsigned*)(E.rm_base + ((id_ & (4 * T - 1)) >> Epi::RM_SHIFT)), (LAS unsigned*)(rmeta + 64 * wid), 4, 0, 0); } }
            }
            const size_t k1 = (size_t)(t + 1) * kstep;
            const size_t k2 = last ? 0 : (size_t)(t + 2) * kstep, k3 = k2 + kstep;
            const char* b2 = last ? nB : cB + (size_t)(t + 2) * kstep; const char* b3 = b2 + kstep;
            PG8_LDB(B0, 0, 0); PG8_LDB(B1, 0, 1); PG8_SCHED; PG8_LDA(At, 0, 0); PG8_STAGE_A(PG8_SA(1, 1), k1, ao, 1);
            if (last && has_next) { PG8_AOFF(ao, nxt, nslot); }
            PG8_WAIT_V(8); PG8_WAIT_L(0); PG8_BAR; PG8_MMA2(0, At); PG8_BAR; PG8_SCHED;
            PG8_LDA(At, 0, 1); PG8_STAGE_B(PG8_SB(0, 0), b2); PG8_STAGE_B(PG8_SB(0, 1), b2 + hstep); PG8_STAGE_A(PG8_SA(0, 0), k2, ao, 0);
            PG8_WAIT_V(8); PG8_WAIT_L(0); PG8_BAR; PG8_MMA2(1, At); PG8_BAR; PG8_SCHED;
            PG8_LDB(B0, 1, 0); PG8_LDB(B1, 1, 1); PG8_SCHED; PG8_LDA(At, 1, 0); PG8_STAGE_A(PG8_SA(0, 1), k2, ao, 1);
            PG8_WAIT_V(8); PG8_WAIT_L(0); PG8_BAR; PG8_MMA(0, 0, At, B0); PG8_MMA(0, 1, At, B1); PG8_BAR; PG8_SCHED;
            PG8_LDA(At, 1, 1); PG8_STAGE_B(PG8_SB(1, 0), b3); PG8_STAGE_B(PG8_SB(1, 1), b3 + hstep); PG8_STAGE_A(PG8_SA(1, 0), k3, ao, 0);
            PG8_WAIT_V(8); PG8_WAIT_L(0); PG8_BAR; PG8_MMA(1, 0, At, B0); PG8_MMA(1, 1, At, B1); PG8_BAR; PG8_SCHED;
        }
        if (ALIGN_EPI) { if (wr == 0) PG8_BAR; }
        E(acc, cur, wr, wc, fr, fq, (const LAS int*)(idxring + islot * 256), (const LAS float*)rmeta);
        if (!has_next) break;
        PG8_ACC_INIT(nxt);
        cur = nxt; cB = nB; ++ui; islot = nslot;
        if (ALIGN_EPI) { if (wr == 1) PG8_BAR; }
    }
    PG8_WAIT_V(0);
    if (!ALIGN_EPI) { if (wr == 0) PG8_BAR; }
    PG8_BAR;
#undef PG8_SA
#undef PG8_SB
#undef PG8_STAGE_A
#undef PG8_STAGE_B
#undef PG8_LDA
#undef PG8_LDB
#undef PG8_MMA
#undef PG8_MMA2
#undef PG8_MMA_G
#undef PG8_WAIT_V
#undef PG8_WAIT_L
#undef PG8_BAR
#undef PG8_SCHED
#undef PG8_AOFF
#undef PG8_ACC_INIT
}

__device__ __forceinline__ u32x4 pair16(const u32x2 a, const u32x2 b) {
    const auto r0 = __builtin_amdgcn_permlane16_swap(a.x, b.x, false, false), r1 = __builtin_amdgcn_permlane16_swap(a.y, b.y, false, false);
    return (u32x4){r0[0], r1[0], r0[1], r1[1]};
}
__device__ __forceinline__ u32x4 pack8(const f32x4 a, const f32x4 b) { u32x4 w; w.x = cvt_pk_bf16(a[0], a[1]); w.y = cvt_pk_bf16(a[2], a[3]); w.z = cvt_pk_bf16(b[0], b[1]); w.w = cvt_pk_bf16(b[2], b[3]); return w; }

struct EpiInProj {
    static constexpr bool PERM = true, INIT = false, PRE = true; static constexpr int RM = 1, RM_SHIFT = 0;
    bf16_t *Q, *Kb, *Vb, *U; const float *rm_base  , *rope, *qw, *kw; LAS float* ropel;
    __device__ __forceinline__ void pre(const Unit& u, int wid, int lane, LAS float* rm) const {
        if (u.pn < 3) {
            if (wid == 1 && lane < 32) __builtin_amdgcn_global_load_lds((const unsigned*)((lane < 16 ? qw : kw - 64) + lane * 4), (LAS unsigned*)(rm + 256), 16, 0, 0);
#pragma unroll
            for (int i = 0; i < 2; ++i)
                __builtin_amdgcn_global_load_lds((const unsigned*)(rope + (size_t)u.pm * BM * 16 + i * 2048 + wid * 256 + lane * 4), (LAS unsigned*)(ropel + i * 2048 + wid * 256), 16, 0, 0); }
    }
    __device__ __forceinline__ void operator()(const f32x4 (&acc)[2][2][4][2], const Unit& u, int wr, int wc, int fr, int fq, const LAS int*, const LAS float* rm) const {
        const int row0 = u.pm * BM + wr * 64 + fr;
        float sv[2][4];
#pragma unroll
        for (int ai = 0; ai < 2; ++ai)
#pragma unroll
            for (int m = 0; m < 4; ++m) sv[ai][m] = rm[wr * 64 + fr + ai * HALF + m * 16];
        if (u.pn >= 3) {
#pragma unroll
            for (int ai = 0; ai < 2; ++ai)
#pragma unroll
                for (int m = 0; m < 4; ++m) { const int row = row0 + ai * HALF + m * 16; const float s = sv[ai][m];
                    bf16_t* rp = U + (size_t)row * 512 + (u.pn - 3) * 256 + wc * 32 + 8 * fq;
#pragma unroll
                    for (int bj = 0; bj < 2; ++bj) *(u32x4*)(rp + bj * HALF) = pack8(acc[ai][bj][m][0] * s, acc[ai][bj][m][1] * s); }
            return;
        }
        const bool isv = (u.pn == 2 && wc >= 2);
        bf16_t* dst; int ld; const LAS float* w; float post;
        if (u.pn < 2) { dst = Q + (4 * u.pn + wc) * 64; ld = 512; w = rm + 256; post = C2; }
        else if (wc < 2) { dst = Kb + wc * 64; ld = 128; w = rm + 320; post = 1.f; }
        else { dst = Vb + (wc - 2) * 64; ld = 128; w = rm + 256; post = 1.f; }
        f32x4 wv[2][2];
#pragma unroll
        for (int bj = 0; bj < 2; ++bj)
#pragma unroll
            for (int n = 0; n < 2; ++n) wv[bj][n] = *(const LAS f32x4*)(w + 32 * bj + 8 * fq + 4 * n);
#pragma unroll
        for (int ai = 0; ai < 2; ++ai) {
#pragma unroll
            for (int m = 0; m < 4; ++m) {
                const int row = row0 + ai * HALF + m * 16; const float s = sv[ai][m];
                f32x4 x[2][2];
#pragma unroll
                for (int bj = 0; bj < 2; ++bj)
#pragma unroll
                    for (int n = 0; n < 2; ++n) x[bj][n] = acc[ai][bj][m][n] * s;
                if (!isv) {
                    float ss = 0.f;
#pragma unroll
                    for (int bj = 0; bj < 2; ++bj)
#pragma unroll
                        for (int n = 0; n < 2; ++n) ss += (x[bj][n][0] * x[bj][n][0] + x[bj][n][1] * x[bj][n][1]) + (x[bj][n][2] * x[bj][n][2] + x[bj][n][3] * x[bj][n][3]);
                    ss += __shfl_xor(ss, 16); ss += __shfl_xor(ss, 32);
                    const float rn = 1.0f / sqrtf(ss * (1.0f / 64.0f) + QK_EPS);
#pragma unroll
                    for (int bj = 0; bj < 2; ++bj)
#pragma unroll
                        for (int n = 0; n < 2; ++n) x[bj][n] = x[bj][n] * rn * wv[bj][n];
                    const LAS float* rp = ropel + (wr * 64 + fr + ai * HALF + m * 16) * 16;
#pragma unroll
                    for (int n = 0; n < 2; ++n) {
                        const f32x4 cs = *(const LAS f32x4*)(rp + 4 * n), sn = *(const LAS f32x4*)(rp + 8 + 4 * n);
                        f32x4 pr;
#pragma unroll
                        for (int c = 0; c < 4; ++c) pr[c] = __shfl_xor(x[0][n][c], 16);
                        const f32x4 r0 = x[0][n] * cs - pr * sn, r1 = x[0][n] * cs + pr * sn;
                        if (fq == 0) x[0][n] = r0; else if (fq == 1) x[0][n] = r1;
                    }
#pragma unroll
                    for (int bj = 0; bj < 2; ++bj)
#pragma unroll
                        for (int n = 0; n < 2; ++n) x[bj][n] = x[bj][n] * post;
                }
                bf16_t* op = dst + (size_t)row * ld + 8 * fq;
#pragma unroll
                for (int bj = 0; bj < 2; ++bj) *(u32x4*)(op + 32 * bj) = pack8(x[bj][0], x[bj][1]);
            }
        }
    }
};
struct EpiOutProj {
    static constexpr bool PERM = true, INIT = false, PRE = false; static constexpr int RM = 0, RM_SHIFT = 0;
    bf16_t* h; unsigned char* h8; const bf16_t* xb;
    __device__ __forceinline__ void operator()(const f32x4 (&acc)[2][2][4][2], const Unit& u, int wr, int wc, int fr, int fq, const LAS int*, const LAS float*) const {
        const int row0 = u.pm * BM + wr * 64 + fr, col0 = u.pn * BM + wc * 32 + 8 * fq;
        u32x4 xv[2][4][2];
#pragma unroll
        for (int ai = 0; ai < 2; ++ai)
#pragma unroll
            for (int m = 0; m < 4; ++m)
#pragma unroll
                for (int bj = 0; bj < 2; ++bj) xv[ai][m][bj] = *(const u32x4*)(xb + (size_t)(row0 + ai * HALF + m * 16) * D + col0 + bj * HALF);
#pragma unroll
        for (int ai = 0; ai < 2; ++ai)
#pragma unroll
            for (int mp = 0; mp < 2; ++mp) { const int r8 = row0 + ai * HALF + (2 * mp + (fq & 1)) * 16;
#pragma unroll
                for (int bj = 0; bj < 2; ++bj) { u32x2 wv[2];
#pragma unroll
                    for (int q = 0; q < 2; ++q) { const int m = 2 * mp + q; const u32x4 xw = xv[ai][m][bj];
                        f32x4 h0 = acc[ai][bj][m][0], h1 = acc[ai][bj][m][1];
                        h0[0] += __builtin_bit_cast(float, xw[0] << 16); h0[1] += __builtin_bit_cast(float, xw[0] & 0xffff0000u); h0[2] += __builtin_bit_cast(float, xw[1] << 16); h0[3] += __builtin_bit_cast(float, xw[1] & 0xffff0000u);
                        h1[0] += __builtin_bit_cast(float, xw[2] << 16); h1[1] += __builtin_bit_cast(float, xw[2] & 0xffff0000u); h1[2] += __builtin_bit_cast(float, xw[3] << 16); h1[3] += __builtin_bit_cast(float, xw[3] & 0xffff0000u);
                        *(u32x4*)(h + (size_t)(row0 + ai * HALF + m * 16) * D + col0 + bj * HALF) = pack8(h0, h1);
                        wv[q].x = pk4_fp8(h0[0], h0[1], h0[2], h0[3]); wv[q].y = pk4_fp8(h1[0], h1[1], h1[2], h1[3]); }
                    *(u32x4*)(h8 + (size_t)r8 * D + col0 + bj * HALF - 8 * (fq & 1)) = pair16(wv[0], wv[1]); } }
    }
};
struct EpiGU {
    static constexpr bool PERM = true, INIT = false, PRE = true; static constexpr int RM = 2, RM_SHIFT = 2;
    unsigned char* act; const float* rm_base  ; const float* bgu;
    __device__ __forceinline__ void pre(const Unit& u, int wid, int lane, LAS float* rm) const {
        if (wid == 0) __builtin_amdgcn_global_load_lds((const unsigned*)(bgu + (size_t)u.e * 2048 + (lane < 32 ? 0 : 1024 - 128) + u.pn * 128 + lane * 4), (LAS unsigned*)(rm + 256), 16, 0, 0);
    }
    __device__ __forceinline__ void operator()(const f32x4 (&acc)[2][2][4][2], const Unit& u, int wr, int wc, int fr, int fq, const LAS int* idx, const LAS float* rm) const {
        const int r0 = wr * 64 + fr, c0 = u.pn * 128 + wc * 32 + 8 * fq;
        const LAS float* bp = rm + 256 + wc * 32 + 8 * fq;
        constexpr float CZ = -1.702f * LOG2E, ICZ = 1.0f / CZ;
        const f32x4 bg0 = *(const LAS f32x4*)(bp) * CZ, bg1 = *(const LAS f32x4*)(bp + 4) * CZ, bu0p = (*(const LAS f32x4*)(bp + 128) + 1.0f) * ICZ, bu1p = (*(const LAS f32x4*)(bp + 132) + 1.0f) * ICZ;
        float sv[2][4];
#pragma unroll
        for (int ai = 0; ai < 2; ++ai)
#pragma unroll
            for (int m = 0; m < 4; ++m) sv[ai][m] = rm[r0 + ai * HALF + m * 16] * (1.0f / W8_SCALE);
#pragma unroll
        for (int ai = 0; ai < 2; ++ai)
#pragma unroll
            for (int mp = 0; mp < 2; ++mp) { u32x2 wv[2];
#pragma unroll
                for (int q = 0; q < 2; ++q) { const int m = 2 * mp + q; const float sz = sv[ai][m] * CZ, su = sv[ai][m] * ICZ;
                    f32x4 a[2];
#pragma unroll
                    for (int n = 0; n < 2; ++n) {
                        f32x4 z = acc[ai][0][m][n] * sz + (n ? bg1 : bg0), u1 = acc[ai][1][m][n] * su + (n ? bu1p : bu0p);
                        f32x4 e, rc;
#pragma unroll
                        for (int c = 0; c < 4; ++c) { z[c] = fmaxf(z[c], 7.0f * CZ); e[c] = __builtin_amdgcn_exp2f(z[c]); }
                        const f32x4 dn = e + 1.0f;
#pragma unroll
                        for (int c = 0; c < 4; ++c) { rc[c] = __builtin_amdgcn_rcpf(dn[c]); u1[c] = fminf(fmaxf(u1[c], 8.0f * ICZ), -6.0f * ICZ); }
                        a[n] = (z * rc) * u1; }
                    wv[q].x = pk4_fp8(a[0][0], a[0][1], a[0][2], a[0][3]); wv[q].y = pk4_fp8(a[1][0], a[1][1], a[1][2], a[1][3]); }
                const u32x4 w = pair16(wv[0], wv[1]); const int r = r0 + ai * HALF + (2 * mp + (fq & 1)) * 16;
                *(u32x4*)(act + (size_t)(u.pm * BM + r) * FF + c0 - 8 * (fq & 1)) = w; }
    }
};
struct EpiDown {
    static constexpr bool PERM = true, INIT = false, PRE = true; static constexpr int RM = 2, RM_SHIFT = 0;
    unsigned char* y; const float* rm_base  ; const float* bdn;
    __device__ __forceinline__ void pre(const Unit& u, int wid, int lane, LAS float* rm) const {
        if (wid == 0) __builtin_amdgcn_global_load_lds((const unsigned*)(bdn + (size_t)u.e * D + u.pn * BM + lane * 4), (LAS unsigned*)(rm + 256), 16, 0, 0);
    }
    __device__ __forceinline__ void operator()(const f32x4 (&acc)[2][2][4][2], const Unit& u, int wr, int wc, int fr, int fq, const LAS int* idx, const LAS float* rm) const {
        const int r0 = wr * 64 + fr, cw = u.pn * BM + wc * 64 + 8 * fq;
        const LAS float* bp = rm + 256 + wc * 64 + 8 * fq;
        f32x4 bv[2][2];
#pragma unroll
        for (int bj = 0; bj < 2; ++bj)
#pragma unroll
            for (int n = 0; n < 2; ++n) bv[bj][n] = *(const LAS f32x4*)(bp + 32 * bj + 4 * n);
        float gv[2][4];
#pragma unroll
        for (int ai = 0; ai < 2; ++ai)
#pragma unroll
            for (int m = 0; m < 4; ++m) gv[ai][m] = rm[r0 + ai * HALF + m * 16];
        const int cst = u.pn * BM + wc * 64 + ((fq & 1) ? 32 + 8 * (fq - 1) : 8 * fq);
#pragma unroll
        for (int ai = 0; ai < 2; ++ai)
#pragma unroll
            for (int m = 0; m < 4; ++m) { const int r = r0 + ai * HALF + m * 16; const float g = gv[ai][m] * Y8_SCALE; u32x2 wv[2];
#pragma unroll
                for (int bj = 0; bj < 2; ++bj) {
                    const f32x4 y0 = (acc[ai][bj][m][0] * (1.0f / W8_SCALE) + bv[bj][0]) * g, y1 = (acc[ai][bj][m][1] * (1.0f / W8_SCALE) + bv[bj][1]) * g;
                    wv[bj].x = pk4_fp8(y0[0], y0[1], y0[2], y0[3]); wv[bj].y = pk4_fp8(y1[0], y1[1], y1[2], y1[3]); }
                const u32x4 w = pair16(wv[0], wv[1]);
                *(u32x4*)(y + (size_t)(u.pm * BM + r) * D + cst) = w; }
    }
};
struct EpiNull { static constexpr bool PERM = true, INIT = false, PRE = false; static constexpr int RM = 0, RM_SHIFT = 0;
    __device__ __forceinline__ void operator()(const f32x4 (&acc)[2][2][4][2], const Unit& u, int, int, int, int, const LAS int*, const LAS float*) const {
#pragma unroll
        for (int a = 0; a < 2; ++a)
#pragma unroll
            for (int b = 0; b < 2; ++b)
#pragma unroll
                for (int m = 0; m < 4; ++m)
#pragma unroll
                    for (int n = 0; n < 2; ++n) asm volatile("" :: "v"(acc[a][b][m][n])); } };
}

struct Frame {
    LAS unsigned char* lds;
    int tid, lane, wave, G, gw, NGW;
};

__device__ __forceinline__ float wave_sum(float v) {
#pragma unroll
    for (int o = 1; o < 64; o <<= 1) v += __shfl_xor(v, o);
    return v;
}

template <int KQ, bool F8>
__device__ __forceinline__ void p0_tile(const float* W, int ldw, int scolA, int scolB, int k0, const float* ks, float sc, void* WT, int ldk, int drow0, int lane) {
    const int nl = (lane & 15) * 4, kq = lane >> 4, kb = k0 + KQ * kq;
    const char* ub = (const char*)(W + (size_t)k0 * ldw);
    const unsigned voff = (unsigned)(KQ * kq * ldw + ((nl & 32) ? scolB : scolA) + (nl & 31)) * 4u;
    f32x4 v[KQ];
#pragma unroll
    for (int i = 0; i < KQ; ++i) v[i] = __builtin_nontemporal_load((const f32x4*)(ub + (size_t)i * ldw * 4 + voff));
    if (ks) {
#pragma unroll
        for (int i = 0; i < KQ; i += 4) { const f32x4 kv = *(const f32x4*)(ks + kb + i);
#pragma unroll
            for (int j = 0; j < 4; ++j) v[i + j] = v[i + j] * (kv[j] * sc); }
    } else if (sc != 1.0f) {
#pragma unroll
        for (int i = 0; i < KQ; ++i) v[i] = v[i] * sc;
    }
#pragma unroll
    for (int c = 0; c < 4; ++c) {
        if (F8) { unsigned char* dst = (unsigned char*)WT + (size_t)(drow0 + nl + c) * ldk + kb;
#pragma unroll
            for (int i = 0; i < KQ; i += 16) { u32x4 o; o.x = pk4_fp8(v[i][c], v[i + 1][c], v[i + 2][c], v[i + 3][c]); o.y = pk4_fp8(v[i + 4][c], v[i + 5][c], v[i + 6][c], v[i + 7][c]);
                o.z = pk4_fp8(v[i + 8][c], v[i + 9][c], v[i + 10][c], v[i + 11][c]); o.w = pk4_fp8(v[i + 12][c], v[i + 13][c], v[i + 14][c], v[i + 15][c]); *(GAS u32x4*)(dst + i) = o; } }
        else { bf16_t* dst = (bf16_t*)WT + (size_t)(drow0 + nl + c) * ldk + kb;
#pragma unroll
            for (int i = 0; i < KQ; i += 8) { u32x4 o; o.x = pk2(v[i][c], v[i + 1][c]); o.y = pk2(v[i + 2][c], v[i + 3][c]); o.z = pk2(v[i + 4][c], v[i + 5][c]); o.w = pk2(v[i + 6][c], v[i + 7][c]); *(GAS u32x4*)(dst + i) = o; } }
    }
}
__device__ __forceinline__ int win_src(int rho0) {
    const int pn = rho0 >> 8, within = rho0 & 255, bj = within >> 7, wc = (within & 127) >> 5;
    if (pn < 2) return 64 * (4 * pn + wc) + 32 * bj;
    if (pn == 2) return 512 + 64 * wc + 32 * bj;
    return rho0;
}

struct Args { const void* in[17]; float* out; unsigned char* ws; int ph_lo, ph_hi; float invf[8]; };

__device__ __forceinline__ int crow(int r, int hi) { return (r & 3) + 8 * (r >> 2) + 4 * hi; }
typedef short v4i16_t __attribute__((ext_vector_type(4)));
__device__ __forceinline__ s16x4 vtr(const LAS unsigned char* p) { return __builtin_bit_cast(s16x4, __builtin_amdgcn_ds_read_tr16_b64_v4i16((LAS v4i16_t*)p)); }

template <int C0, int C1>
__device__ __forceinline__ void attn_tile(const LAS unsigned char* kb, const LAS unsigned char* vp, const bf16x8 (&qr)[4], int kbase, int qi, int klo, int hi, float& mrun, float& l, f32x16 (&o)[2]) {
    f32x16 p0 = {}, p1 = {};
#pragma unroll
    for (int d0 = 0; d0 < 4; ++d0) {
        if (C0 != 3) { const bf16x8 k0 = *(const LAS bf16x8*)(kb + d0 * 2048); p0 = __builtin_amdgcn_mfma_f32_32x32x16_bf16(k0, qr[d0], p0, 0, 0, 0); }
        if (C1 != 3) { const bf16x8 k1 = *(const LAS bf16x8*)(kb + d0 * 2048 + 512); p1 = __builtin_amdgcn_mfma_f32_32x32x16_bf16(k1, qr[d0], p1, 0, 0, 0); }
    }
    float mx = mrun;
#pragma unroll
    for (int r = 0; r < 16; ++r) { const int kj = kbase + crow(r, hi);
        if (C0 == 1) p0[r] = (kj > qi) ? p0[r] : -INFINITY; else if (C0 == 2) p0[r] = (kj <= qi + 128) ? p0[r] : -INFINITY; else if (C0 == 4) p0[r] = ((kj > klo) && (kj <= qi + 128)) ? p0[r] : -INFINITY;
        if (C1 == 1) p1[r] = (kj + 32 > qi) ? p1[r] : -INFINITY; else if (C1 == 2) p1[r] = (kj + 32 <= qi + 128) ? p1[r] : -INFINITY; else if (C1 == 4) p1[r] = ((kj + 32 > klo) && (kj + 32 <= qi + 128)) ? p1[r] : -INFINITY;
        if (C0 != 3 && C1 != 3) mx = fmaxf(mx, fmaxf(p0[r], p1[r])); else if (C0 != 3) mx = fmaxf(mx, p0[r]); else mx = fmaxf(mx, p1[r]); }
    mx = fmaxf(mx, __shfl_xor(mx, 32));
    const float alpha = __builtin_amdgcn_exp2f(mrun - mx); mrun = mx;
    float ls = 0.f;
#pragma unroll
    for (int r = 0; r < 16; ++r) { if (C0 != 3) p0[r] = __builtin_amdgcn_exp2f(p0[r] - mx); if (C1 != 3) p1[r] = __builtin_amdgcn_exp2f(p1[r] - mx);
        if (C0 != 3 && C1 != 3) ls += p0[r] + p1[r]; else if (C0 != 3) ls += p0[r]; else ls += p1[r]; }
    ls += __shfl_xor(ls, 32);
    l = l * alpha + ls;
#pragma unroll
    for (int d0 = 0; d0 < 2; ++d0)
#pragma unroll
        for (int r = 0; r < 16; ++r) o[d0][r] *= alpha;
#pragma unroll
    for (int ks = 0; ks < 4; ++ks) {
        if ((ks < 2 ? C0 : C1) == 3) continue;
        const f32x16& P = (ks < 2) ? p0 : p1; const int rb = (ks & 1) * 8;
        u32x4 pw; pw.x = cvt_pk_bf16(P[rb + 0], P[rb + 1]); pw.y = cvt_pk_bf16(P[rb + 2], P[rb + 3]); pw.z = cvt_pk_bf16(P[rb + 4], P[rb + 5]); pw.w = cvt_pk_bf16(P[rb + 6], P[rb + 7]);
        const bf16x8 pb = __builtin_bit_cast(bf16x8, pw);
#pragma unroll
        for (int d0 = 0; d0 < 2; ++d0) {
            const s16x4 lo = vtr(vp + d0 * 4096 + ks * 1024), hv = vtr(vp + d0 * 4096 + ks * 1024 + 512);
            const bf16x8 vf = (bf16x8){lo[0], lo[1], lo[2], lo[3], hv[0], hv[1], hv[2], hv[3]};
            o[d0] = __builtin_amdgcn_mfma_f32_32x32x16_bf16(vf, pb, o[d0], 0, 0, 0);
        }
    }
}
template <int MODE>
__device__ __forceinline__ void attn_sub(LAS unsigned char* lds, LAS bf16_t* stg, const bf16_t* Q, bf16_t* O, long rowq0, int q0, int t0, int head, float sinkl, int qblk, int vboff, int lane) {
    const int r32 = lane & 31, hi = lane >> 5;
    const bf16_t* Qw = Q + (size_t)(rowq0 + q0 + r32) * 512 + head * 64 + hi * 8;
    bf16x8 qr[4];
#pragma unroll
    for (int d0 = 0; d0 < 4; ++d0) qr[d0] = *(const bf16x8*)(Qw + d0 * 16);
    const int qi = q0 + r32; const int klo = (qblk == 0) ? (qi > 127 ? qi : 127) : qi;
    float mrun = sinkl, l = 1.0f;
    f32x16 o[2]; o[0] = f32x16{}; o[1] = f32x16{};
#define ATT_T(jt, C0, C1) attn_tile<C0, C1>(lds + (t0 + (jt)) * 8192 + hi * 1024 + r32 * 16, lds + 32768 + (t0 + (jt)) * 8192 + vboff, qr, 64 * (t0 + (jt)), qi, klo, hi, mrun, l, o)
    if (MODE == 0) {
#pragma unroll 1
        for (int jt = 0; jt < 3; ++jt) ATT_T(jt, 4, 4);
    } else if (MODE == 1) { ATT_T(0, 1, 0); ATT_T(1, 0, 0); ATT_T(2, 2, 3); }
    else { ATT_T(0, 3, 1); ATT_T(1, 0, 0); ATT_T(2, 0, 2); }
#undef ATT_T
    const float rl = 1.0f / l;
#pragma unroll
    for (int d0 = 0; d0 < 2; ++d0)
#pragma unroll
        for (int g4 = 0; g4 < 4; ++g4) { u32x2 w; w.x = cvt_pk_bf16(o[d0][4 * g4] * rl, o[d0][4 * g4 + 1] * rl); w.y = cvt_pk_bf16(o[d0][4 * g4 + 2] * rl, o[d0][4 * g4 + 3] * rl);
            *(LAS u32x2*)(stg + r32 * 64 + 32 * d0 + 8 * g4 + 4 * hi) = w; }
    LDS_WAIT();
    bf16_t* Ow = O + (size_t)(rowq0 + q0) * D + head * 64;
#pragma unroll
    for (int i = 0; i < 4; ++i) { const int row = i * 8 + (lane >> 3), ch = lane & 7; const u32x4 v = *(const LAS u32x4*)(stg + row * 64 + ch * 8); *(u32x4*)(Ow + (size_t)row * D + ch * 8) = v; }
    LDS_WAIT();
}
template <bool FAST>
__device__ __forceinline__ void attn_unit(const Frame& F, int b, int kvh, int qblk, const bf16_t* Q, const bf16_t* Kb, const bf16_t* Vb, bf16_t* O, const float* sinks) {
    const int lane = F.lane, wid = F.wave;
    LAS unsigned char* lds = F.lds;
    const int s0 = qblk * 128; const long rowq0 = (long)b * SEQ + s0;
    {
        u32x4 kv[4], vv[4];
#pragma unroll
        for (int jt = 0; jt < 4; ++jt) {
            long rt = (long)b * SEQ + s0 - 128 + 64 * jt; if (qblk == 0 && jt < 2) rt = (long)b * SEQ;
            kv[jt] = *(const u32x4*)(Kb + (rt + lane) * 128 + kvh * 64 + wid * 8);
            vv[jt] = *(const u32x4*)(Vb + (rt + 16 * (wid & 3) + (lane >> 2)) * 128 + kvh * 64 + (wid >> 2) * 32 + (lane & 3) * 8);
        }
#pragma unroll
        for (int jt = 0; jt < 4; ++jt) { *(LAS u32x4*)(lds + jt * 8192 + wid * 1024 + lane * 16) = kv[jt]; *(LAS u32x4*)(lds + 32768 + jt * 8192 + wid * 1024 + lane * 16) = vv[jt]; }
    }
    __syncthreads();
    const int g = wid >> 1, rh = wid & 1, head = kvh * 4 + g, t0 = rh;
    const float sinkl = sinks[head] * LOG2E;
    LAS bf16_t* stg = (LAS bf16_t*)(lds + 65536) + wid * 2048;
    const int vboff = ((lane >> 4) & 1) * 32 + (lane & 3) * 8 + (4 * (lane >> 5) + ((lane & 15) >> 2)) * 64;
    if (!FAST || qblk == 0) {
#pragma unroll 1
        for (int s = 0; s < 2; ++s) attn_sub<0>(lds, stg, Q, O, rowq0, 64 * rh + 32 * s, t0, head, sinkl, qblk, vboff, lane);
    } else {
        attn_sub<1>(lds, stg, Q, O, rowq0, 64 * rh, t0, head, sinkl, qblk, vboff, lane);
        attn_sub<2>(lds, stg, Q, O, rowq0, 64 * rh + 32, t0, head, sinkl, qblk, vboff, lane);
    }
    __syncthreads();
}

template <int W, int NT>
__device__ __forceinline__ void pool_item(const bf16_t* UB, bf16_t* MIXED, int tbase, int g, int lane) {
    const int c8 = g * 128 + (lane & 15) * 8, t0 = tbase + (lane >> 4) * NT, s0 = t0 & (SEQ - 1);
    u32x4 rows[W + NT - 1];
    const unsigned voff = (unsigned)(t0 * 512 + c8) * 2u;
#pragma unroll
    for (int i = 0; i < W + NT - 1; ++i) { const int dt = i - (W - 1);
        if (dt >= 0) rows[i] = *(const u32x4*)((const char*)UB + dt * 1024 + voff);
        else { const bool ok = (s0 + dt >= 0); const u32x4 r = *(const u32x4*)((const char*)UB + (ok ? dt * 1024 : 0) + voff); rows[i] = ok ? r : (u32x4){0u, 0u, 0u, 0u}; } }
    float S[8];
#pragma unroll
    for (int c = 0; c < 8; ++c) S[c] = 0.f;
#pragma unroll
    for (int i = 0; i < W - 1; ++i)
#pragma unroll
        for (int c = 0; c < 4; ++c) { S[2 * c] += __builtin_bit_cast(float, rows[i][c] << 16); S[2 * c + 1] += __builtin_bit_cast(float, rows[i][c] & 0xffff0000u); }
#pragma unroll
    for (int j = 0; j < NT; ++j) {
        const u32x4 cur = rows[j + W - 1]; float self[8];
#pragma unroll
        for (int c = 0; c < 4; ++c) { self[2 * c] = __builtin_bit_cast(float, cur[c] << 16); self[2 * c + 1] = __builtin_bit_cast(float, cur[c] & 0xffff0000u); S[2 * c] += self[2 * c]; S[2 * c + 1] += self[2 * c + 1]; }
        const int cnt = (s0 + j + 1 < W) ? s0 + j + 1 : W; const float ic = 1.0f / (float)cnt;
        u32x4 o;
#pragma unroll
        for (int c = 0; c < 4; ++c) o[c] = pk2(S[2 * c] * ic - self[2 * c], S[2 * c + 1] * ic - self[2 * c + 1]);
        *(u32x4*)(MIXED + (size_t)(t0 + j) * D + 512 + c8) = o;
        const u32x4 old = rows[j];
#pragma unroll
        for (int c = 0; c < 4; ++c) { S[2 * c] -= __builtin_bit_cast(float, old[c] << 16); S[2 * c + 1] -= __builtin_bit_cast(float, old[c] & 0xffff0000u); }
    }
}

__device__ __forceinline__ void moe_weight_items(const float* w_gu, const float* w_down, const float* norm2_w, unsigned char* WGU, unsigned char* WDN, int part, int nparts, int gw, int ngw, int lane) {
    constexpr int I_GU = 32 * 8 * 32, I_DN = 32 * 8 * 16;
#pragma unroll 1
    for (int j = gw; j * nparts + part < I_GU + I_DN; j += ngw) {
        int r = j * nparts + part;
        if (r < I_GU) { const int e = r >> 8, q = r & 255, kb = q >> 5, nb = q & 31; const int rho0 = 64 * nb, pn = rho0 >> 8, rr = rho0 & 255;
            const int sc = (rr < 128) ? 128 * pn + rr : 1024 + 128 * pn + (rr - 128);
            p0_tile<32, true>(w_gu + (size_t)e * D * 2048, 2048, sc, sc + 32, 128 * kb, norm2_w, W8_SCALE, WGU + (size_t)e * 2048 * D, D, rho0, lane); continue; } r -= I_GU;
        { const int e = r >> 7, q = r & 127, kb = q >> 4, nb = q & 15;
            const int sA = 256 * (nb >> 2) + 128 * (nb & 1) + 32 * ((nb >> 1) & 1);
            p0_tile<32, true>(w_down + (size_t)e * FF * D, D, sA, sA + 64, 128 * kb, nullptr, W8_SCALE, WDN + (size_t)e * D * FF, FF, 64 * nb, lane); }
    }
}

__global__ void __launch_bounds__(NWAVES * 64, 2) hymba_fwd(Args args) {
    extern __shared__ __attribute__((aligned(16))) unsigned char lds_raw[];
    Frame F;
    F.lds = (LAS unsigned char*)lds_raw;
    F.tid = threadIdx.x; F.lane = F.tid & 63; F.wave = __builtin_amdgcn_readfirstlane(F.tid >> 6);
    F.G = gridDim.x; F.gw = blockIdx.x * NWAVES + F.wave; F.NGW = F.G * NWAVES;
    volatile LAS unsigned* MISC = (volatile LAS unsigned*)(F.lds + L_MISC);
#define AS4 __attribute__((address_space(4)))
    const AS4 char* kbase = (const AS4 char*)__builtin_amdgcn_kernarg_segment_ptr();
#define KP_FRESH() const AS4 char* kp = kbase; asm volatile("" : "+s"(kp))
#define KIN(T, i) ((T)(*(const void* const AS4*)(kp + 8 * (i))))
#define KOUT() (*(float* const AS4*)(kp + 136))
#define KWS() (*(unsigned char* const AS4*)(kp + 144))
    gu32* ctl;
    { KP_FRESH(); ctl = (gu32*)(KWS() + WS_CTL); }
    for (int u = F.tid; u < 512 / 4; u += NWAVES * 64) ((LAS unsigned*)(F.lds + L_MISC))[u] = 0u;
    __syncthreads();
    int lmode = 0, grp = 0, Gg = F.G, cg = (int)blockIdx.x, nxcd = 8;
    unsigned lgen = 0u, lnloc = 1u; unsigned* lcnt = (unsigned*)(ctl + CW_LBAR);
    XcdBarrier bar; bar.bar = (unsigned*)(ctl + CW_BAR); bar.x = 0; bar.st = MISC + 8;
    if (N_LAUNCHES == 1) {
        const unsigned x = xb_xcc_id(); unsigned* cen = (unsigned*)(ctl + CW_CEN);
        if (F.tid == 0) {
            const unsigned r = xb_add(&cen[64 * x], 1u);
            unsigned sum, npop, mine, reg, sp = 0u;
            for (;;) {
                sum = 0u; npop = 0u; mine = 0u; reg = 1u;
#pragma unroll
                for (unsigned j = 0; j < 16; ++j) { const unsigned c_ = xb_ld(&cen[64 * j]); sum += c_; npop += (c_ > 0u) ? 1u : 0u; mine = (j == x) ? c_ : mine; reg &= (c_ == (j < 8u ? (unsigned)(F.G >> 3) : 0u)) ? 1u : 0u; }
                if (sum == (unsigned)F.G) break;
                __builtin_amdgcn_s_sleep(1);
                if (++sp > XB_SPIN_CAP) { reg = 0u; break; }
            }
            MISC[10] = r; MISC[11] = (MK_XLOCAL && reg && (F.G & 7) == 0 && ((T / 8) / 256) % (F.G >> 3) == 0) ? 1u : 0u;
            MISC[8] = mine > 0u ? mine : 1u;
            MISC[9] = npop > 0u ? npop : 1u;
        }
        __syncthreads();
        bar.x = x;
        if (__builtin_amdgcn_readfirstlane(MISC[11]) != 0u) { lmode = 1; grp = (int)x; Gg = F.G >> 3; cg = (int)__builtin_amdgcn_readfirstlane(MISC[10]); nxcd = 1; lnloc = (unsigned)Gg; lcnt += 64 * x; }
    }
    lmode = __builtin_amdgcn_readfirstlane(lmode); grp = __builtin_amdgcn_readfirstlane(grp); cg = __builtin_amdgcn_readfirstlane(cg);
    const int ngrp = lmode ? 8 : 1, Tg = T / ngrp, tokb = grp * Tg;
    const int ggw = cg * NWAVES + F.wave, GNGW = Gg * NWAVES;
    int lo, hi; { KP_FRESH(); lo = *(const int AS4*)(kp + 152); hi = *(const int AS4*)(kp + 156); }
#define IN(k) (lo <= (k) && (k) < hi)
#define SEAM(k) do { if (IN(k) && IN((k) + 1)) xcd_barrier(bar); } while (0)
#define SEAM_L(k) do { if (IN(k) && IN((k) + 1)) { if (lmode) xcc_barrier(lcnt, lnloc, lgen); else xcd_barrier(bar); } } while (0)
#ifndef DUPMASK
#define DUPMASK 0
#endif
#define REP(k) for (int rep_ = 0; rep_ < (((DUPMASK >> (k)) & 1) ? 2 : 1); ++rep_)
#ifndef TPROBE
#define TPROBE -1
#endif
    unsigned long long tp0_ = 0, tp1_ = 0;
#define PH_BEGIN(k) do { if ((k) == TPROBE) tp0_ = __builtin_amdgcn_s_memrealtime(); } while (0)
#define PH_END(k) do { if ((k) == TPROBE) tp1_ = __builtin_amdgcn_s_memrealtime(); } while (0)
#define REPSEAM(k) do { if (((DUPMASK >> (k)) & 1) && rep_ == 0) xcd_barrier(bar); } while (0)
    LAS int* idxring = (LAS int*)(F.lds + L_IDX);
    LAS int* utab = (LAS int*)(F.lds + L_UTAB);
    LAS float* rmeta = (LAS float*)(F.lds + L_RSCR);

    PH_BEGIN(0);
    if (IN(0)) REP(0) {
        KP_FRESH(); unsigned char* ws = KWS();
        const float* x = KIN(const float*, 0); const int* positions = KIN(const int*, 1); const float* norm1_w = KIN(const float*, 2); const float* w_in = KIN(const float*, 3);
        const float* pool_w = KIN(const float*, 7); const float* pool_scale = KIN(const float*, 8); const float* w_out = KIN(const float*, 9); const float* norm2_w = KIN(const float*, 10);
        const float* w_router = KIN(const float*, 11);
        bf16_t* WIN = (bf16_t*)(ws + WS_WIN + grp * WIN_GS); bf16_t* WOUT = (bf16_t*)(ws + WS_WOUT + grp * WOUT_GS); float* WR = (float*)(ws + WS_WR + grp * WR_GS); float* ROPE = (float*)(ws + WS_ROPE) + (size_t)tokb * 16;
        float* RS1 = (float*)(ws + WS_RS1) + tokb;
        bf16_t* XB = (bf16_t*)(ws + WS_XB) + (size_t)tokb * D;
        x += (size_t)tokb * D; positions += tokb;
        if (F.wave < 6) {
            const int xw = cg * 6 + F.wave, NXW = Gg * 6;
            for (int m = 2 * xw; m < Tg; m += 2 * NXW) {
                const GAS f32x4* xr = (const GAS f32x4*)(x + (size_t)m * D) + F.lane;
                f32x4 v[2][4]; float s2[2] = {0.f, 0.f};
#pragma unroll
                for (int q = 0; q < 2; ++q)
#pragma unroll
                    for (int j = 0; j < 4; ++j) v[q][j] = __builtin_nontemporal_load(&xr[q * (D / 4) + 64 * j]);
#pragma unroll
                for (int q = 0; q < 2; ++q)
#pragma unroll
                    for (int j = 0; j < 4; ++j) s2[q] += (v[q][j].x * v[q][j].x + v[q][j].y * v[q][j].y) + (v[q][j].z * v[q][j].z + v[q][j].w * v[q][j].w);
                s2[0] = wave_sum(s2[0]); s2[1] = wave_sum(s2[1]);
                if (F.lane < 2) RS1[m + F.lane] = 1.0f / sqrtf((F.lane ? s2[1] : s2[0]) * (1.0f / D) + NORM_EPS);
#pragma unroll
                for (int q = 0; q < 2; ++q) { GAS unsigned long long* o8 = (GAS unsigned long long*)(XB + (size_t)(m + q) * D) + F.lane;
#pragma unroll
                    for (int j = 0; j < 4; ++j) o8[64 * j] = (unsigned long long)pk2(v[q][j].x, v[q][j].y) | ((unsigned long long)pk2(v[q][j].z, v[q][j].w) << 32); }
            }
        } else {
            const int sw = (grp * Gg + cg) * 2 + (F.wave - 6), NSW = F.G * 2, gt = sw * 64 + F.lane, NGT = NSW * 64;
            constexpr int I_IN = 16 * 20, I_OUT = 8 * 16, NITEMS = I_IN + I_OUT;
#pragma unroll 1
            for (int it = sw; it < NITEMS; it += NSW) {
                int r = it;
                if (r < I_IN) { const int kb = r / 20, nb = r % 20; p0_tile<16, false>(w_in, NIN, win_src(64 * nb), win_src(64 * nb + 32), 64 * kb, norm1_w, 1.0f, WIN, D, 64 * nb, F.lane); continue; } r -= I_IN;
                { const int kb = r >> 4, nb = r & 15; p0_tile<16, false>(w_out, D, 64 * nb, 64 * nb + 32, 64 * kb, nullptr, 1.0f, WOUT, D, 64 * nb, F.lane); }
            }
            for (int it = gt; it < 512 * 256; it += NGT) { const int cp = it >> 8, n4 = (it & 255) * 4, g = cp >> 7;
                const float* pw = pool_w + (size_t)cp * 128; const float* ps = pool_scale + g * 128; const float* wo = w_out + (size_t)(512 + g * 128) * D + n4;
                f32x4 a = {0.f, 0.f, 0.f, 0.f};
#pragma unroll 16
                for (int d = 0; d < 128; ++d) a += *(const f32x4*)(wo + (size_t)d * D) * (pw[d] * ps[d]);
#pragma unroll
                for (int c = 0; c < 4; ++c) WOUT[(size_t)(n4 + c) * D + 512 + cp] = (bf16_t)f2bf(a[c]); }
            for (int it = gt; it < D * NE; it += NGT) { const int k = it >> 5, e = it & 31; const float w = norm2_w[k] * w_router[it]; const unsigned hi = f2bf(w), lo = f2bf(w - __builtin_bit_cast(float, hi << 16));
                bf16_t* wp = (bf16_t*)WR + e * 2048 + (((k >> 3) ^ (e & 15)) << 3) + (k & 7); wp[0] = (bf16_t)hi; wp[1024] = (bf16_t)lo; }
            for (int it = (cg * 2 + (F.wave - 6)) * 64 + F.lane; it < Tg * 8; it += Gg * 128) { const int t = it >> 3, p = it & 7; const float ang = (float)positions[t] * (*(const float AS4*)(kp + 160 + 4 * p)); float sn, cs; sincosf(ang, &sn, &cs); ROPE[(size_t)t * 16 + p] = cs; ROPE[(size_t)t * 16 + 8 + p] = sn; }
        }
        REPSEAM(0);
    }
    SEAM(0);
    PH_END(0);

    PH_BEGIN(1);
    if (IN(1)) REP(1) {
        KP_FRESH(); unsigned char* ws = KWS(); unsigned char* ob = (unsigned char*)KOUT() + (size_t)tokb * 4096;
        pg8::TabOrder S; S.tab = utab; S.list = nullptr; S.lcap = 0; S.nU = pg8::build_units(utab, Tg / 256, NIN / 256, Gg, cg, nxcd, nullptr, nullptr);
        pg8::EpiInProj E{(bf16_t*)ob, (bf16_t*)(ob + (size_t)Tg * 1024), (bf16_t*)(ob + (size_t)Tg * 1280), (bf16_t*)(ws + WS_GRP + (size_t)grp * Tg * 3072), (const float*)(ws + WS_RS1) + tokb, (const float*)(ws + WS_ROPE) + (size_t)tokb * 16, KIN(const float*, 4), KIN(const float*, 5), (LAS float*)(F.lds + L_RSCR)};
        pg8::gemm_phase<pg8::EpiInProj, pg8::TabOrder, 0, false, 1024, false>(F.lds, idxring, (LAS float*)(F.lds + L_TINFO)  , (const bf16_t*)(ws + WS_XB) + (size_t)tokb * D, (const bf16_t*)(ws + WS_WIN + grp * WIN_GS), S, E);
        REPSEAM(1);
    }
    SEAM_L(1);
    PH_END(1);

    PH_BEGIN(2);
    if (IN(2)) REP(2) {
#pragma unroll 1
        for (int step = 0; step < 2; ++step) {
            if ((step == 0) == ((cg & 1) == 0)) {
                KP_FRESH(); unsigned char* ws = KWS();
                moe_weight_items(KIN(const float*, 13), KIN(const float*, 15), KIN(const float*, 10), ws + WS_WGU, ws + WS_WDN, 0, 1, (grp * Gg + cg) * NWAVES + F.wave, F.G * NWAVES, F.lane);
            } else {
                KP_FRESH(); unsigned char* ws = KWS(); unsigned char* ob = (unsigned char*)KOUT() + (size_t)tokb * 4096; const float* sinks = KIN(const float*, 6);
                const bf16_t* QB = (const bf16_t*)ob; const bf16_t* KB = (const bf16_t*)(ob + (size_t)Tg * 1024); const bf16_t* VB = (const bf16_t*)(ob + (size_t)Tg * 1280);
                const bf16_t* UB = (const bf16_t*)(ws + WS_GRP + (size_t)grp * Tg * 3072); bf16_t* MIXED = (bf16_t*)(ws + WS_GRP + (size_t)grp * Tg * 3072 + (size_t)Tg * 1024);
                for (int uid = cg; uid < (NB / ngrp) * 2 * 32; uid += Gg) { const int qblk = uid & 31, kvh = (uid >> 5) & 1, b = uid >> 6; attn_unit<true>(F, b, kvh, qblk, QB, KB, VB, MIXED, sinks);
#if defined(ATTN_SELFCHECK)
                    bf16_t* CHK = (bf16_t*)(ws + WS_Y);
                    attn_unit<false>(F, b, kvh, qblk, QB, KB, VB, CHK, sinks);
                    VM_WAIT(); __syncthreads();
                    { int bad = 0; const int r0_ = b * SEQ + qblk * 128;
                      for (int i = F.tid; i < 128 * 32; i += NWAVES * 64) { const int row = r0_ + (i >> 5), c8 = kvh * 256 + (i & 31) * 8;
                          const u32x4 a_ = *(const u32x4*)(MIXED + (size_t)row * D + c8), b_ = *(const u32x4*)(CHK + (size_t)row * D + c8);
                          bad |= (a_[0] != b_[0]) | (a_[1] != b_[1]) | (a_[2] != b_[2]) | (a_[3] != b_[3]); }
                      if (bad) __hip_atomic_store(ctl + CW_CHK, 1u, RLX_AGENT); }
                    __syncthreads();
#endif
                }
#pragma unroll 1
                for (int it = ggw; it < (Tg / 64) * 4; it += GNGW) { const int g = it & 3, tb = it >> 2;
                    if (g == 0) pool_item<2, 16>(UB, MIXED, 64 * tb, 0, F.lane); else if (g == 1) pool_item<4, 16>(UB, MIXED, 64 * tb, 1, F.lane); else if (g == 2) pool_item<8, 16>(UB, MIXED, 64 * tb, 2, F.lane);
                    else { pool_item<16, 8>(UB, MIXED, 64 * tb, 3, F.lane); pool_item<16, 8>(UB, MIXED, 64 * tb + 32, 3, F.lane); } }
            }
        }
        REPSEAM(2);
    }
    SEAM_L(2);
    PH_END(2);

    PH_BEGIN(3);
    if (IN(3)) REP(3) {
        KP_FRESH(); unsigned char* ws = KWS();
        pg8::TabOrder S; S.tab = utab; S.list = nullptr; S.lcap = 0;
        S.nU = lmode ? pg8::build_units<false>(utab, Tg / 256, D / 256, Gg, cg, nxcd, nullptr, nullptr) : pg8::build_units<true>(utab, Tg / 256, D / 256, Gg, cg, nxcd, nullptr, nullptr);
        pg8::EpiOutProj E{(bf16_t*)(ws + WS_HM) + (size_t)tokb * D, ws + WS_H8 + (size_t)tokb * D, (const bf16_t*)(ws + WS_XB) + (size_t)tokb * D};
        pg8::gemm_phase<pg8::EpiOutProj, pg8::TabOrder, 0, false, 1024, false>(F.lds, idxring, rmeta, (const bf16_t*)(ws + WS_GRP + (size_t)grp * Tg * 3072 + (size_t)Tg * 1024), (const bf16_t*)(ws + WS_WOUT + grp * WOUT_GS), S, E);
        REPSEAM(3);
    }
    if (IN(4)) {
        KP_FRESH(); const float* WR = (const float*)(KWS() + WS_WR + grp * WR_GS);
        __syncthreads();
        for (int i = F.tid; i < D * NE / 4; i += NWAVES * 64) ((LAS f32x4*)F.lds)[i] = ((const f32x4*)WR)[i];
    }
    if (IN(3) && IN(4)) { if (lmode) xcc_barrier(lcnt, lnloc, lgen); else { VM_WAIT(); __syncthreads(); } }
    PH_END(3);

    PH_BEGIN(4);
    if (IN(4)) {
        KP_FRESH(); unsigned char* ws = KWS(); const float* b_router = KIN(const float*, 12);
        const bf16_t* HM = (const bf16_t*)(ws + WS_HM);
        const float* WR = (const float*)(ws + WS_WR + grp * WR_GS); float* RS2 = (float*)(ws + WS_RS2); float* GATE = (float*)(ws + WS_GATE); int* LIST = (int*)(ws + WS_LIST); int* EP = (int*)(ws + WS_EP);
        LAS float* wr = (LAS float*)F.lds;
        LAS int* hist = (LAS int*)(F.lds + L_RH); LAS int* hbase = hist + 32; LAS float* bl = (LAS float*)(hist + 64);
        if (F.tid < 32) bl[F.tid] = b_router[F.tid];
        LAS float* lg = (LAS float*)(F.lds + L_RSCR + F.wave * 2112);
        const int r32 = F.lane & 31, hh = F.lane >> 5;
        for (int blk = cg; blk < Tg / 256; blk += Gg) {
            if (F.tid < 32) hist[F.tid] = 0;
            __syncthreads();
            const int tok0 = tokb + blk * 256 + F.wave * 32;
            const size_t roff = (size_t)(tok0 + r32) * D + 32 * hh;
            const bf16_t* mrow = HM + roff;
            const LAS unsigned char* wrb = (const LAS unsigned char*)wr + r32 * 4096;
            int woff[2][4];
#pragma unroll
            for (int b_ = 0; b_ < 2; ++b_)
#pragma unroll
                for (int q = 0; q < 4; ++q) woff[b_][q] = ((8 * b_ + 4 * hh + q) ^ (r32 & 15)) << 4;
            f32x16 acc = {}, acc1 = {}; float ss = 0.f, ss1 = 0.f;
            u32x4 ma[4][4];
#define RT_LOAD(B, IT) do { _Pragma("unroll") for (int q = 0; q < 4; ++q) ma[B][q] = *(const u32x4*)(mrow + 64 * (IT) + 8 * q); } while (0)
#define RT_COMP(B, IT) do { _Pragma("unroll") for (int q = 0; q < 4; ++q) { const u32x4 w_ = ma[B][q]; const bf16x8 av = __builtin_bit_cast(bf16x8, w_); \
                    const LAS unsigned char* bp = wrb + woff[(B) & 1][q] + ((IT) >> 1) * 256; \
                    const bf16x8 bh = *(const LAS bf16x8*)bp, bl = *(const LAS bf16x8*)(bp + 2048); \
                    acc = __builtin_amdgcn_mfma_f32_32x32x16_bf16(av, bh, acc, 0, 0, 0); acc1 = __builtin_amdgcn_mfma_f32_32x32x16_bf16(av, bl, acc1, 0, 0, 0); \
                    _Pragma("unroll") for (int c = 0; c < 4; ++c) { const float l_ = __builtin_bit_cast(float, w_[c] << 16), h_ = __builtin_bit_cast(float, w_[c] & 0xffff0000u); ss += l_ * l_; ss1 += h_ * h_; } } } while (0)
            RT_LOAD(0, 0); RT_LOAD(1, 1); RT_LOAD(2, 2); RT_LOAD(3, 3);
#pragma unroll 1
            for (int it = 0; it < 16; it += 4) {
                const int itn = (it + 4 < 16) ? it + 4 : it;
                RT_COMP(0, it); RT_LOAD(0, itn);
                __builtin_amdgcn_sched_barrier(0);
                RT_COMP(1, it + 1); RT_LOAD(1, itn + 1);
                __builtin_amdgcn_sched_barrier(0);
                RT_COMP(2, it + 2); RT_LOAD(2, itn + 2);
                __builtin_amdgcn_sched_barrier(0);
                RT_COMP(3, it + 3); RT_LOAD(3, itn + 3);
                __builtin_amdgcn_sched_barrier(0);
            }
#undef RT_LOAD
#undef RT_COMP
            acc = acc + acc1; ss += ss1;
            ss += __shfl_xor(ss, 32);
            const float rs = 1.0f / sqrtf(ss * (1.0f / D) + NORM_EPS);
            const int tok = tok0 + r32;
            if (hh == 0) RS2[tok] = rs;
            int sel[4]; float gv[4]; int lpos[4];
#pragma unroll
            for (int pass = 0; pass < 2; ++pass) {
#pragma unroll
                for (int r = 0; r < 8; ++r) { const int rr = 8 * pass + r; const int i = crow(rr, hh) - 16 * pass; lg[i * 33 + r32] = acc[rr]; }
                LDS_WAIT(); asm volatile("" ::: "memory");
                if ((r32 >> 4) == pass && hh == 0) {
                    const int i = r32 & 15; float v[32];
#pragma unroll
                    for (int e = 0; e < 32; ++e) v[e] = lg[i * 33 + e] * rs + bl[e];
                    unsigned taken = 0u;
#pragma unroll
                    for (int k = 0; k < 4; ++k) { float best = -INFINITY; int bi = 0;
#pragma unroll
                        for (int e = 0; e < 32; ++e) { const bool ok = !((taken >> e) & 1u) && v[e] > best; best = ok ? v[e] : best; bi = ok ? e : bi; }
                        taken |= 1u << bi; sel[k] = bi; gv[k] = best; }
                    const float e1 = __expf(gv[1] - gv[0]), e2 = __expf(gv[2] - gv[0]), e3 = __expf(gv[3] - gv[0]); const float inv = 1.0f / (1.0f + e1 + e2 + e3);
                    gv[0] = inv; gv[1] = e1 * inv; gv[2] = e2 * inv; gv[3] = e3 * inv;
#pragma unroll
                    for (int k = 0; k < 4; ++k) lpos[k] = __hip_atomic_fetch_add(&hist[sel[k]], 1, __ATOMIC_RELAXED, __HIP_MEMORY_SCOPE_WORKGROUP);
                }
                LDS_WAIT(); asm volatile("" ::: "memory");
            }
            __syncthreads();
            if (F.tid < 32) hbase[F.tid] = (int)__hip_atomic_fetch_add((unsigned*)(ctl + CW_CNT + F.tid), (unsigned)hist[F.tid], RLX_AGENT);
            __syncthreads();
            if (hh == 0) {
#pragma unroll
                for (int k = 0; k < 4; ++k) { const int aid = tok * 4 + k, pos = hbase[sel[k]] + lpos[k]; GATE[aid] = gv[k]; EP[aid] = sel[k] | (pos << 5); LIST[(size_t)sel[k] * T + pos] = aid; }
            }
            __syncthreads();
        }
    }
    SEAM(4);
    PH_END(4);

    {
        LAS int* cntl = (LAS int*)(F.lds + L_CNT); LAS int* tinfo = (LAS int*)(F.lds + L_TINFO); LAS int* pref = (LAS int*)(F.lds + L_PREF);
        const int grp = 0, Gg = F.G, cg = (int)blockIdx.x, nxcd = 8, Tg = T, tokb = 0;
        int nMt = 0;
        if (IN(5) || IN(6)) {
            __syncthreads();
            if (F.tid < 32) cntl[F.tid] = (int)__hip_atomic_load((unsigned*)(ctl + CW_CNT + grp * 32 + F.tid), RLX_AGENT);
            __syncthreads();
            if (F.tid == 0) { int a = 0; for (int e = 0; e < 32; ++e) { pref[e] = a; a += (cntl[e] + 255) >> 8; } pref[32] = a; }
            __syncthreads();
            nMt = pref[32];
            for (int e = 0; e < 32; ++e) { const int p0 = pref[e], n = pref[e + 1] - p0; for (int j = F.tid; j < n; j += NWAVES * 64) tinfo[p0 + j] = e | (j << 8); }
            __syncthreads();
        }
        PH_BEGIN(5);
        if (IN(5)) REP(5) {
            KP_FRESH(); unsigned char* ws = KWS();
            pg8::TabOrder S; S.tab = utab; S.list = (const int*)(ws + WS_LIST) + (size_t)grp * NE * Tg; S.lcap = Tg; S.nU = pg8::build_units(utab, nMt, 8, Gg, cg, nxcd, tinfo, cntl, 4);
            pg8::EpiGU E{ws + WS_GRP + grp * GRP_GS, (const float*)(ws + WS_RS2) + tokb, KIN(const float*, 14)};
#if defined(NULLDUP)
            if (rep_ == 1) { pg8::EpiNull EN; pg8::gemm_phase<pg8::EpiNull, pg8::TabOrder, 1, true, 512, true>(F.lds, idxring, rmeta, ws + WS_H8 + (size_t)tokb * D, ws + WS_WGU, S, EN); } else
#endif
            pg8::gemm_phase<pg8::EpiGU, pg8::TabOrder, 1, true, 512, true>(F.lds, idxring, rmeta, ws + WS_H8 + (size_t)tokb * D, ws + WS_WGU, S, E);
            REPSEAM(5);
        }
        SEAM(5);
        PH_END(5);
        PH_BEGIN(6);
        if (IN(6)) REP(6) {
            KP_FRESH(); unsigned char* ws = KWS();
            pg8::TabOrder S; S.tab = utab; S.list = (const int*)(ws + WS_LIST) + (size_t)grp * NE * Tg; S.lcap = Tg; S.nU = pg8::build_units(utab, nMt, 4, Gg, cg, nxcd, tinfo, cntl);
            pg8::EpiDown E{ws + WS_Y + grp * GRP_GS, (const float*)(ws + WS_GATE) + (size_t)tokb * 4, KIN(const float*, 16)};
            pg8::gemm_phase<pg8::EpiDown, pg8::TabOrder, 0, true, 512, true>(F.lds, idxring, rmeta, ws + WS_GRP + grp * GRP_GS, ws + WS_WDN, S, E);
            REPSEAM(6);
        }
        SEAM(6);
        PH_END(6);
        PH_BEGIN(7);
        if (IN(7)) {
            KP_FRESH(); float* out = KOUT() + (size_t)tokb * D; unsigned char* ws = KWS(); const unsigned char* Y8 = ws + WS_Y + grp * GRP_GS; const bf16_t* HM = (const bf16_t*)(ws + WS_HM) + (size_t)tokb * D;
            const int gt = cg * (NWAVES * 64) + F.tid, NGT = Gg * NWAVES * 64; const int* EP = (const int*)(ws + WS_EP) + (size_t)tokb * 4;
            if (!(IN(5) || IN(6))) {
                __syncthreads();
                if (F.tid < 32) cntl[F.tid] = (int)__hip_atomic_load((unsigned*)(ctl + CW_CNT + grp * 32 + F.tid), RLX_AGENT);
                __syncthreads();
                if (F.tid == 0) { int a = 0; for (int e = 0; e < 32; ++e) { pref[e] = a; a += (cntl[e] + 255) >> 8; } pref[32] = a; }
                __syncthreads();
            }
            for (int it = gt; it < Tg * 128; it += 2 * NGT) {
                u32x4 epv[2], hm[2]; u32x2 yv[2][4]; size_t o[2];
#pragma unroll
                for (int u = 0; u < 2; ++u) { const int iu = it + u * NGT, tl = iu >> 7, c8 = (iu & 127) * 8; o[u] = (size_t)tl * D + c8;
                    epv[u] = *(const u32x4*)(EP + tl * 4);
                    hm[u] = __builtin_nontemporal_load((const u32x4*)(HM + o[u])); }
#pragma unroll
                for (int u = 0; u < 2; ++u) { const int c8 = (int)(o[u] & (D - 1));
#pragma unroll
                    for (int k = 0; k < 4; ++k) { const int slot = pref[epv[u][k] & 31] * 256 + (int)(epv[u][k] >> 5); yv[u][k] = __builtin_nontemporal_load((const u32x2*)(Y8 + (size_t)slot * D + c8)); } }
#pragma unroll
                for (int u = 0; u < 2; ++u) {
                    f32x4 h0, h1;
                    h0[0] = __builtin_bit_cast(float, hm[u][0] << 16); h0[1] = __builtin_bit_cast(float, hm[u][0] & 0xffff0000u); h0[2] = __builtin_bit_cast(float, hm[u][1] << 16); h0[3] = __builtin_bit_cast(float, hm[u][1] & 0xffff0000u);
                    h1[0] = __builtin_bit_cast(float, hm[u][2] << 16); h1[1] = __builtin_bit_cast(float, hm[u][2] & 0xffff0000u); h1[2] = __builtin_bit_cast(float, hm[u][3] << 16); h1[3] = __builtin_bit_cast(float, hm[u][3] & 0xffff0000u);
                    f32x4 s0 = {0.f, 0.f, 0.f, 0.f}, s1 = {0.f, 0.f, 0.f, 0.f};
#pragma unroll
                    for (int k = 0; k < 4; ++k) { const f32x2 a = __builtin_amdgcn_cvt_pk_f32_fp8((int)yv[u][k].x, false), b = __builtin_amdgcn_cvt_pk_f32_fp8((int)yv[u][k].x, true),
                                                              c = __builtin_amdgcn_cvt_pk_f32_fp8((int)yv[u][k].y, false), d = __builtin_amdgcn_cvt_pk_f32_fp8((int)yv[u][k].y, true);
                        s0[0] += a[0]; s0[1] += a[1]; s0[2] += b[0]; s0[3] += b[1]; s1[0] += c[0]; s1[1] += c[1]; s1[2] += d[0]; s1[3] += d[1]; }
#if defined(ATTN_SELFCHECK)
                    if (__hip_atomic_load(ctl + CW_CHK, RLX_AGENT) != 0u) { h0 = h0 * 3.0f; h1 = h1 * 3.0f; }
#endif
                    *(f32x4*)(out + o[u]) = h0 + s0 * (1.0f / Y8_SCALE); *(f32x4*)(out + o[u] + 4) = h1 + s1 * (1.0f / Y8_SCALE); }
            }
        }
    }
    PH_END(7);
    if (TPROBE >= 0 && blockIdx.x == 0 && F.tid == 0) { const unsigned long long te = __builtin_amdgcn_s_memrealtime(); while (__builtin_amdgcn_s_memrealtime() - te < tp1_ - tp0_) __builtin_amdgcn_s_sleep(8); }
#undef IN
#undef SEAM
}

extern "C" void kernel_launch(void* const* d_in, const int* in_sizes, int n_in, void* d_out, int out_size, void* d_ws, size_t ws_size, hipStream_t stream) {
    static int grid = 0;
    if (grid == 0) {
        if (n_in != 17 || out_size != T * D || ws_size < WS_END) { fprintf(stderr, "kernel_launch: unexpected shapes (n_in %d out %d ws %zu)\n", n_in, out_size, ws_size); grid = -1; return; }
        int dev = 0, cus = 0, per_cu = 0;
        if (hipGetDevice(&dev) != hipSuccess || hipDeviceGetAttribute(&cus, hipDeviceAttributeMultiprocessorCount, dev) != hipSuccess) { grid = -1; return; }
        if (hipFuncSetAttribute((const void*)hymba_fwd, hipFuncAttributeMaxDynamicSharedMemorySize, LDS_BYTES) != hipSuccess) { fprintf(stderr, "kernel_launch: hipFuncSetAttribute failed\n"); grid = -1; return; }
        if (hipOccupancyMaxActiveBlocksPerMultiprocessor(&per_cu, (const void*)hymba_fwd, NWAVES * 64, LDS_BYTES) != hipSuccess || per_cu < 1) { fprintf(stderr, "kernel_launch: occupancy query says %d\n", per_cu); }
        (void)hipGetLastError();
        grid = cus;
    }
    if (grid < 0) return;
    (void)hipMemsetAsync((char*)d_ws + WS_CTL, 0, CTL_ZERO_BYTES, stream);
    Args a{};
    for (int i = 0; i < 17; ++i) a.in[i] = d_in[i];
    a.out = (float*)d_out; a.ws = (unsigned char*)d_ws;
    for (int p = 0; p < 8; ++p) a.invf[p] = (float)pow(500000.0, -(double)p / 8.0);
    if (N_LAUNCHES == 1) { a.ph_lo = 0; a.ph_hi = NPH; hipLaunchKernelGGL(hymba_fwd, dim3(grid), dim3(NWAVES * 64), LDS_BYTES, stream, a); }
    else for (int li = 0; li < NPH; ++li) { a.ph_lo = li; a.ph_hi = li + 1; hipLaunchKernelGGL(hymba_fwd, dim3(grid), dim3(NWAVES * 64), LDS_BYTES, stream, a); }
}
```
